# Optimizing an MI355X kernel written in HIP

```python
import math
import jax
import jax.numpy as jnp
from jax import lax
import numpy as np

D_MODEL = 1024
BATCH = 1
SEQ = 16384
DEPTH = 4

GRID_W = 64
CTX_LEN = 256
N_BRANCH = 4
CONF_D = 512
CONF_K = 31
SSD_D = 768
SSD_HEADS = 12
SSD_HEAD_DIM = 64
SSD_GROUPS = 4
SSD_HPG = SSD_HEADS // SSD_GROUPS
SSD_STATE = 128
SSD_CONV_K = 3
SSD_CHUNK = 128
SSD_BC = SSD_GROUPS * SSD_STATE
SSD_XBC = SSD_D + 2 * SSD_BC
SSD_PROJ = SSD_D + SSD_XBC + 2 * SSD_HEADS
HY_D = 512
HY_ORDER = 2
HY_SHORT_K = 3
HY_EMB = 33
HY_BANDS = (HY_EMB - 1) // 2
HY_HID = 64
HY_N_FILT = HY_ORDER * 2 * HY_D
HY_MIN_DECAY = math.log(1e-2) / 1.5
HY_MAX_DECAY = math.log(1e-2) / 0.3
SC_D = 512
SC_K = 3
OFF_A = 0
OFF_B = OFF_A + 2 * CONF_D
OFF_C = OFF_B + SSD_PROJ
OFF_D = OFF_C + 3 * HY_D
OFF_G = OFF_D + 3 * SC_D
PROJ_TOTAL = OFF_G + N_BRANCH * D_MODEL
MOE_GROUPS = 4
MOE_EPG = 8
MOE_EXPERTS = MOE_GROUPS * MOE_EPG
MOE_TOP_K = 2
MOE_FF = 512
MOE_BLOCK = 128
DN_ALPHA = (2 * DEPTH) ** 0.25
DN_BETA = (8 * DEPTH) ** -0.25
LN_EPS = 1e-5
F32 = jnp.float32

kernel_name = "hybrid_conv_ssd_hyena_moe_diffusion_block"


def layer_norm(x, g, b):
    xf = x.astype(F32)
    mu = jnp.mean(xf, -1, keepdims=True)
    var = jnp.mean(jnp.square(xf - mu), -1, keepdims=True)
    return ((xf - mu) * lax.rsqrt(var + LN_EPS) * g.astype(F32) + b.astype(F32)).astype(x.dtype)


def rms_norm(x, g):
    xf = x.astype(F32)
    return (xf * lax.rsqrt(jnp.mean(jnp.square(xf), -1, keepdims=True) + LN_EPS) * g.astype(F32)).astype(x.dtype)


def modulate(h, shift, scale):
    return h * (1 + scale) + shift


def dwconv_seq(x, w):
    k = w.shape[0]
    return lax.conv_general_dilated(x, w[:, None, :].astype(x.dtype), window_strides=(1,), padding=((k // 2, k // 2),), dimension_numbers=("NWC", "WIO", "NWC"), feature_group_count=x.shape[-1])


def dwconv_grid_cols(x, w, rows):
    bsz, n, ch = x.shape
    k = w.shape[0]
    y = lax.conv_general_dilated(x.reshape(bsz, rows, GRID_W, ch), w[:, None, None, :].astype(x.dtype), window_strides=(1, 1), padding=((k // 2, k // 2), (0, 0)), dimension_numbers=("NHWC", "HWIO", "NHWC"), feature_group_count=ch)
    return y.reshape(bsz, n, ch)


def conformer_branch(p_a, lp, rows):
    val, gate = jnp.split(p_a, 2, axis=-1)
    v = val * jax.nn.sigmoid(gate)
    v = dwconv_seq(v, lp["conf_dw_w"]) if rows is None else dwconv_grid_cols(v, lp["conf_dw_w"], rows)
    v = layer_norm(v + lp["conf_dw_b"], lp["conf_ln_g"], lp["conf_ln_b"])
    return jax.nn.silu(v)


def ssd_prepare(p_b, lp):
    bsz, n = p_b.shape[:2]
    z = p_b[..., :SSD_D]
    xbc = jax.nn.silu(dwconv_seq(p_b[..., SSD_D:SSD_D + SSD_XBC], lp["ssd_conv_w"]) + lp["ssd_conv_b"])
    xs = xbc[..., :SSD_D].reshape(bsz, n, SSD_GROUPS, SSD_HPG, SSD_HEAD_DIM)
    b_in = xbc[..., SSD_D:SSD_D + SSD_BC].reshape(bsz, n, SSD_GROUPS, SSD_STATE)
    c_out = xbc[..., SSD_D + SSD_BC:].reshape(bsz, n, SSD_GROUPS, SSD_STATE)
    dt_raw = p_b[..., SSD_D + SSD_XBC:].astype(F32).reshape(bsz, n, 2, SSD_HEADS)
    dt = jax.nn.softplus(dt_raw + lp["ssd_dt_bias"].astype(F32))
    a_rate = -jnp.exp(lp["ssd_a_log"].astype(F32))
    return z, xs, b_in, c_out, dt, a_rate


def _ssd_direction(xs, b_in, c_out, dt, a_rate, d):
    bsz, n = xs.shape[:2]
    dt_d = dt[:, :, d].reshape(bsz, n, SSD_GROUPS, SSD_HPG)
    log_decay = dt_d * a_rate[d].reshape(SSD_GROUPS, SSD_HPG)
    xdt = xs * dt_d[..., None].astype(xs.dtype)
    if d == 1:
        xdt, log_decay, b_in, c_out = (jnp.flip(t, axis=1) for t in (xdt, log_decay, b_in, c_out))
    return xdt, log_decay, b_in, c_out


def _ssd_blocks(xdt, log_decay, b_in):
    bsz, n = xdt.shape[:2]
    nc = n // SSD_CHUNK
    xc = xdt.reshape(bsz, nc, SSD_CHUNK, SSD_GROUPS, SSD_HPG, SSD_HEAD_DIM)
    a_cum = jnp.cumsum(log_decay.reshape(bsz, nc, SSD_CHUNK, SSD_GROUPS, SSD_HPG), axis=2).transpose(0, 3, 4, 1, 2)
    bc = b_in.reshape(bsz, nc, SSD_CHUNK, SSD_GROUPS, SSD_STATE)
    return xc, a_cum, bc


def _ssd_chunk_states(xc, a_cum, bc, init):
    decay_to_end = jnp.exp(a_cum[..., -1:] - a_cum)
    chunk_states = jnp.einsum("bclgn,bgecl,bclgep->cbgepn", bc.astype(F32), decay_to_end, xc.astype(F32))
    chunk_decay = jnp.moveaxis(jnp.exp(a_cum[..., -1]), -1, 0)[..., None, None]

    def step(h, inp):
        dec, s = inp
        return dec * h + s, h

    final, h_in = lax.scan(step, init, (chunk_decay, chunk_states))
    return h_in, final


def ssd_scan(xdt, log_decay, b_in, c_out, init):
    xc, a_cum, bc = _ssd_blocks(xdt, log_decay, b_in)
    cc = c_out.reshape(bc.shape).astype(F32)
    h_in, final = _ssd_chunk_states(xc, a_cum, bc, init)
    lower = jnp.tril(jnp.ones((SSD_CHUNK, SSD_CHUNK), dtype=bool))
    decay_in = jnp.exp(jnp.where(lower, a_cum[..., :, None] - a_cum[..., None, :], -jnp.inf))
    cb = jnp.einsum("bclgn,bcsgn->bgcls", cc, bc.astype(F32))
    y_diag = jnp.einsum("bgcls,bgecls,bcsgep->bclgep", cb, decay_in, xc.astype(F32))
    y_off = jnp.einsum("bclgn,cbgepn,bgecl->bclgep", cc, h_in, jnp.exp(a_cum))
    return (y_diag + y_off).reshape(xdt.shape).astype(xdt.dtype), final


def ssd_branch(p_b, init, lp):
    z, xs, b_in, c_out, dt, a_rate = ssd_prepare(p_b, lp)
    y = xs * lp["ssd_d"].reshape(SSD_GROUPS, SSD_HPG, 1).astype(xs.dtype)
    finals = []
    for d in range(2):
        xdt, log_decay, b_d, c_d = _ssd_direction(xs, b_in, c_out, dt, a_rate, d)
        y_d, f_d = ssd_scan(xdt, log_decay, b_d, c_d, init[d])
        y = y + (jnp.flip(y_d, axis=1) if d == 1 else y_d)
        finals.append(f_d)
    y = y.reshape(z.shape)
    return rms_norm(y * jax.nn.silu(z), lp["ssd_norm_g"]), jnp.stack(finals)


def ssd_context_states(p_b, init, lp):
    _, xs, b_in, c_out, dt, a_rate = ssd_prepare(p_b, lp)
    finals = []
    for d in range(2):
        xdt, log_decay, b_d, _ = _ssd_direction(xs, b_in, c_out, dt, a_rate, d)
        xc, a_cum, bc = _ssd_blocks(xdt, log_decay, b_d)
        finals.append(_ssd_chunk_states(xc, a_cum, bc, init[d])[1])
    return jnp.stack(finals)


def hyena_filters(n, lp):
    t01 = jnp.linspace(0.0, 1.0, n, dtype=F32)[:, None]
    omega = (2.0 * math.pi / n) * jnp.arange(n, dtype=F32)[:, None]
    bands = jnp.linspace(1e-4, HY_BANDS - 1, HY_BANDS, dtype=F32)
    feat = jnp.concatenate([t01, jnp.cos(bands * omega), -jnp.sin(bands * omega)], axis=-1)
    hid = jnp.sin(lp["hy_freq"][0].astype(F32) * (feat @ lp["hy_w1"].astype(F32) + lp["hy_b1"].astype(F32)))
    hid = jnp.sin(lp["hy_freq"][1].astype(F32) * (hid @ lp["hy_w2"].astype(F32) + lp["hy_b2"].astype(F32)))
    deltas = jnp.abs(jnp.linspace(HY_MIN_DECAY, HY_MAX_DECAY, HY_N_FILT, dtype=F32))
    filt = (hid @ lp["hy_w3"].astype(F32)) * jnp.exp(-t01 * deltas)
    filt = filt.reshape(n, HY_ORDER, 2, HY_D)
    fwd, bwd = filt[:, :, 0], filt[:, :, 1]
    k2 = jnp.concatenate([fwd, jnp.zeros((1, HY_ORDER, HY_D), F32), jnp.flip(bwd[1:], axis=0)], axis=0)
    return k2 / jnp.sum(jnp.abs(k2), axis=0, keepdims=True)


def fft_conv(z, k2):
    n = z.shape[1]
    zf = jnp.fft.rfft(z, n=2 * n, axis=1)
    kf = jnp.fft.rfft(k2, axis=0)
    return jnp.fft.irfft(zf * kf[None], n=2 * n, axis=1)[:, :n]


def hyena_branch(p_c, lp):
    q = dwconv_seq(p_c, lp["hy_short_w"]) + lp["hy_short_b"]
    v, x1, x2 = jnp.split(q, 3, axis=-1)
    k2 = hyena_filters(p_c.shape[1], lp)
    z = v.astype(F32)
    for o, gate in enumerate((x1, x2)):
        z = gate.astype(F32) * (fft_conv(z, k2[:, o]) + lp["hy_bias"][o].astype(F32) * z)
    return z.astype(p_c.dtype)


def short_conv_branch(p_d, lp):
    bg, cg, xv = jnp.split(p_d, 3, axis=-1)
    return bg * dwconv_seq(cg * xv, lp["sc_conv_w"])


def token_mixer(u, ssd_init, lp, rows):
    p = u @ lp["w_in"]
    y_a = conformer_branch(p[..., OFF_A:OFF_B], lp, rows)
    y_b, ssd_final = ssd_branch(p[..., OFF_B:OFF_C], ssd_init, lp)
    y_c = hyena_branch(p[..., OFF_C:OFF_D], lp)
    y_d = short_conv_branch(p[..., OFF_D:OFF_G], lp)
    gates = jax.nn.sigmoid(p[..., OFF_G:]).reshape(*u.shape[:-1], N_BRANCH, D_MODEL)
    merged = (gates[..., 0, :] * (y_a @ lp["w_branch_a"]) + gates[..., 1, :] * (y_b @ lp["w_branch_b"])
              + gates[..., 2, :] * (y_c @ lp["w_branch_c"]) + gates[..., 3, :] * (y_d @ lp["w_branch_d"]))
    return merged @ lp["w_out"], ssd_final


def moe_ffn(u, lp):
    shp = u.shape
    tok = u.reshape(-1, D_MODEL)
    n_tok = tok.shape[0]
    g_logits = (tok @ lp["rt_group_w"] + lp["rt_group_b"]).astype(F32)
    g_sel = jnp.argmax(g_logits, axis=-1).astype(jnp.int32)
    g_prob = jnp.take_along_axis(jax.nn.softmax(g_logits, axis=-1), g_sel[:, None], axis=-1)
    e_logits = (tok @ lp["rt_expert_w"] + lp["rt_expert_b"]).astype(F32).reshape(n_tok, MOE_GROUPS, MOE_EPG)
    e_logits = jnp.take_along_axis(e_logits, g_sel[:, None, None], axis=1)[:, 0]
    top_v, top_i = lax.top_k(e_logits, MOE_TOP_K)
    weights = jax.nn.softmax(top_v, axis=-1) * g_prob
    expert = g_sel[:, None] * MOE_EPG + top_i.astype(jnp.int32)
    n_assign = n_tok * MOE_TOP_K
    flat_e = expert.reshape(n_assign)
    order = jnp.argsort(flat_e)
    sorted_e = flat_e[order]
    counts = jnp.bincount(flat_e, length=MOE_EXPERTS)
    padded = (counts + MOE_BLOCK - 1) // MOE_BLOCK * MOE_BLOCK
    pad_end = jnp.cumsum(padded)
    pad_start = pad_end - padded
    start = jnp.cumsum(counts) - counts
    dest = pad_start[sorted_e] + jnp.arange(n_assign, dtype=jnp.int32) - start[sorted_e]
    n_blocks = (n_assign + MOE_EXPERTS * (MOE_BLOCK - 1) + MOE_BLOCK - 1) // MOE_BLOCK
    n_rows = n_blocks * MOE_BLOCK
    row_tok = jnp.full((n_rows,), n_tok, jnp.int32).at[dest].set((order // MOE_TOP_K).astype(jnp.int32))
    row_w = jnp.zeros((n_rows,), F32).at[dest].set(weights.reshape(n_assign)[order])
    block_e = jnp.minimum(jnp.searchsorted(pad_end, jnp.arange(n_blocks, dtype=jnp.int32) * MOE_BLOCK, side="right"), MOE_EXPERTS - 1)
    tok_pad = jnp.concatenate([tok, jnp.zeros((1, D_MODEL), tok.dtype)], axis=0)
    xin = tok_pad[row_tok].reshape(n_blocks, MOE_BLOCK, D_MODEL)

    def expert_block(args):
        xb, e = args
        hid = jax.nn.silu(xb @ lp["ex_w_gate"][e]) * (xb @ lp["ex_w_up"][e])
        return hid @ lp["ex_w_down"][e]

    y = lax.map(expert_block, (xin, block_e)).reshape(n_rows, D_MODEL)
    out = jnp.zeros((n_tok + 1, D_MODEL), F32).at[row_tok].add(y * row_w[:, None])
    return out[:n_tok].astype(u.dtype).reshape(shp)


def setup_inputs(seed: int = 0) -> dict:
    key = jax.random.key(seed)
    ks = iter(jax.random.split(key, 64))

    def nrm(shape, scale):
        return scale * jax.random.normal(next(ks), shape, F32)

    L = DEPTH
    dt0 = jnp.exp(jax.random.uniform(next(ks), (L, 2, SSD_HEADS), F32, math.log(1e-3), math.log(1e-1)))
    a0 = jax.random.uniform(next(ks), (L, 2, SSD_HEADS), F32, 1.0, 16.0)
    return {
        "x": nrm((BATCH, SEQ, D_MODEL), 1.0),
        "c": nrm((BATCH, D_MODEL), 1.0),
        "ctx": nrm((BATCH, CTX_LEN, D_MODEL), 1.0),
        "c_ctx": nrm((D_MODEL,), 1.0),
        "w_mod": nrm((L, D_MODEL, 6 * D_MODEL), D_MODEL ** -0.5),
        "b_mod": nrm((L, 6 * D_MODEL), 0.01),
        "ln_g": 1.0 + nrm((L, 2, D_MODEL), 0.01),
        "ln_b": nrm((L, 2, D_MODEL), 0.01),
        "w_in": nrm((L, D_MODEL, PROJ_TOTAL), D_MODEL ** -0.5),
        "conf_dw_w": nrm((L, CONF_K, CONF_D), CONF_K ** -0.5),
        "conf_dw_b": nrm((L, CONF_D), 0.01),
        "conf_ln_g": 1.0 + nrm((L, CONF_D), 0.01),
        "conf_ln_b": nrm((L, CONF_D), 0.01),
        "ssd_conv_w": nrm((L, SSD_CONV_K, SSD_XBC), SSD_CONV_K ** -0.5),
        "ssd_conv_b": nrm((L, SSD_XBC), 0.01),
        "ssd_a_log": jnp.log(a0),
        "ssd_dt_bias": dt0 + jnp.log(-jnp.expm1(-dt0)),
        "ssd_d": 1.0 + nrm((L, SSD_HEADS), 0.01),
        "ssd_norm_g": 1.0 + nrm((L, SSD_D), 0.01),
        "hy_short_w": nrm((L, HY_SHORT_K, 3 * HY_D), HY_SHORT_K ** -0.5),
        "hy_short_b": nrm((L, 3 * HY_D), 0.01),
        "hy_w1": nrm((L, HY_EMB, HY_HID), HY_EMB ** -0.5),
        "hy_b1": nrm((L, HY_HID), 0.1),
        "hy_w2": nrm((L, HY_HID, HY_HID), HY_HID ** -0.5),
        "hy_b2": nrm((L, HY_HID), 0.1),
        "hy_freq": 1.0 + nrm((L, 2, HY_HID), 0.01),
        "hy_w3": nrm((L, HY_HID, HY_N_FILT), HY_HID ** -0.5),
        "hy_bias": nrm((L, HY_ORDER, HY_D), 0.1),
        "sc_conv_w": nrm((L, SC_K, SC_D), SC_K ** -0.5),
        "w_branch_a": nrm((L, CONF_D, D_MODEL), CONF_D ** -0.5),
        "w_branch_b": nrm((L, SSD_D, D_MODEL), SSD_D ** -0.5),
        "w_branch_c": nrm((L, HY_D, D_MODEL), HY_D ** -0.5),
        "w_branch_d": nrm((L, SC_D, D_MODEL), SC_D ** -0.5),
        "w_out": nrm((L, D_MODEL, D_MODEL), DN_BETA * D_MODEL ** -0.5),
        "rt_group_w": nrm((L, D_MODEL, MOE_GROUPS), D_MODEL ** -0.5),
        "rt_group_b": nrm((L, MOE_GROUPS), 0.01),
        "rt_expert_w": nrm((L, D_MODEL, MOE_EXPERTS), D_MODEL ** -0.5),
        "rt_expert_b": nrm((L, MOE_EXPERTS), 0.01),
        "ex_w_gate": nrm((L, MOE_EXPERTS, D_MODEL, MOE_FF), D_MODEL ** -0.5),
        "ex_w_up": nrm((L, MOE_EXPERTS, D_MODEL, MOE_FF), D_MODEL ** -0.5),
        "ex_w_down": nrm((L, MOE_EXPERTS, MOE_FF, D_MODEL), DN_BETA * MOE_FF ** -0.5),
    }


def reference(x, c, ctx, c_ctx, w_mod, b_mod, ln_g, ln_b, w_in, conf_dw_w, conf_dw_b, conf_ln_g, conf_ln_b,
              ssd_conv_w, ssd_conv_b, ssd_a_log, ssd_dt_bias, ssd_d, ssd_norm_g, hy_short_w, hy_short_b,
              hy_w1, hy_b1, hy_w2, hy_b2, hy_freq, hy_w3, hy_bias, sc_conv_w, w_branch_a, w_branch_b,
              w_branch_c, w_branch_d, w_out, rt_group_w, rt_group_b, rt_expert_w, rt_expert_b,
              ex_w_gate, ex_w_up, ex_w_down):
    bsz, n_lat, _ = x.shape
    rows = n_lat // GRID_W
    ssd_zero = jnp.zeros((2, bsz, SSD_GROUPS, SSD_HPG, SSD_HEAD_DIM, SSD_STATE), F32)
    h_lat, h_ctx = x, ctx
    for l in range(DEPTH):
        lp = dict(w_in=w_in[l], conf_dw_w=conf_dw_w[l], conf_dw_b=conf_dw_b[l], conf_ln_g=conf_ln_g[l],
                  conf_ln_b=conf_ln_b[l], ssd_conv_w=ssd_conv_w[l], ssd_conv_b=ssd_conv_b[l],
                  ssd_a_log=ssd_a_log[l], ssd_dt_bias=ssd_dt_bias[l], ssd_d=ssd_d[l], ssd_norm_g=ssd_norm_g[l],
                  hy_short_w=hy_short_w[l], hy_short_b=hy_short_b[l], hy_w1=hy_w1[l], hy_b1=hy_b1[l],
                  hy_w2=hy_w2[l], hy_b2=hy_b2[l], hy_freq=hy_freq[l], hy_w3=hy_w3[l], hy_bias=hy_bias[l],
                  sc_conv_w=sc_conv_w[l], w_branch_a=w_branch_a[l], w_branch_b=w_branch_b[l],
                  w_branch_c=w_branch_c[l], w_branch_d=w_branch_d[l], w_out=w_out[l],
                  rt_group_w=rt_group_w[l], rt_group_b=rt_group_b[l], rt_expert_w=rt_expert_w[l],
                  rt_expert_b=rt_expert_b[l], ex_w_gate=ex_w_gate[l], ex_w_up=ex_w_up[l], ex_w_down=ex_w_down[l])
        last = l == DEPTH - 1
        mod_lat = jnp.split((jax.nn.silu(c) @ w_mod[l] + b_mod[l])[:, None, :], 6, axis=-1)
        mod_ctx = jnp.split(jax.nn.silu(c_ctx) @ w_mod[l] + b_mod[l], 6, axis=-1)
        u_ctx = modulate(h_ctx, mod_ctx[0], mod_ctx[1])
        if last:
            ctx_states = ssd_context_states(u_ctx @ w_in[l][:, OFF_B:OFF_C], ssd_zero, lp)
        else:
            mix_ctx, ctx_states = token_mixer(u_ctx, ssd_zero, lp, None)
        mix_lat, _ = token_mixer(modulate(h_lat, mod_lat[0], mod_lat[1]), ctx_states, lp, rows)
        h_lat = layer_norm(DN_ALPHA * h_lat + mod_lat[2] * mix_lat, ln_g[l, 0], ln_b[l, 0])
        ffn_lat = moe_ffn(modulate(h_lat, mod_lat[3], mod_lat[4]), lp)
        h_lat = layer_norm(DN_ALPHA * h_lat + mod_lat[5] * ffn_lat, ln_g[l, 1], ln_b[l, 1])
        if not last:
            h_ctx = layer_norm(DN_ALPHA * h_ctx + mod_ctx[2] * mix_ctx, ln_g[l, 0], ln_b[l, 0])
            ffn_ctx = moe_ffn(modulate(h_ctx, mod_ctx[3], mod_ctx[4]), lp)
            h_ctx = layer_norm(DN_ALPHA * h_ctx + mod_ctx[5] * ffn_ctx, ln_g[l, 1], ln_b[l, 1])
    return h_lat
```

```cpp
#ifndef CPU_EMU
#include <hip/hip_runtime.h>
#endif
#include <stdint.h>
#include <stdio.h>

#ifndef CFG_D
#define CFG_D 1024
#define CFG_SEQ 16384
#define CFG_DEPTH 4
#endif
#ifndef MK_MULTI
#define MK_MULTI 0
#endif

constexpr int D = CFG_D, SEQ = CFG_SEQ, DEPTH = CFG_DEPTH, CTX = 256, MT = SEQ + CTX;
constexpr int GRID_W = 64, ROWS = SEQ / GRID_W;
constexpr int CONF_D = 512, CONF_K = 31;
constexpr int SSD_D = 768, NH = 12, HD = 64, NG = 4, HPG = 3, NS = 128, XBC = 1792, SSD_PROJ = 2584, CHUNK = 128, NCH = MT / CHUNK, NCH_LAT = SEQ / CHUNK;
constexpr int HY_D = 512, SC_D = 512, HY_NF = 2048;
constexpr int OFF_A = 0, OFF_B = 1024, OFF_C = 3608, OFF_D = 5144, OFF_G = 6680, PROJ = OFF_G + 4 * D, NP = (PROJ + 255) / 256 * 256;
constexpr int NE = 32, FF = 512, NRMAX = ((2 * MT + NE * 255) / 256 + 1) * 256, NTMAX = NRMAX / 256;
constexpr float LN_EPS = 1e-5f;
constexpr int NTHR = 512, NWAVES = 8;
constexpr int LDS_BYTES = 163840, STAGE_REGION = 131072, MISC_OFF = 131072 + 16384;

enum { I_X = 0, I_C, I_CTX, I_CCTX, I_WMOD, I_BMOD, I_LNG, I_LNB, I_WIN, I_CDWW, I_CDWB, I_CLNG, I_CLNB, I_SCW, I_SCB, I_SALOG, I_SDTB, I_SD, I_SNG,
       I_HSW, I_HSB, I_HW1, I_HB1, I_HW2, I_HB2, I_HFREQ, I_HW3, I_HBIAS, I_SCCW, I_WBA, I_WBB, I_WBC, I_WBD, I_WOUT, I_RGW, I_RGB, I_REW, I_REB, I_EWG, I_EWU, I_EWD, N_IN };

constexpr size_t al256(size_t x) { return (x + 255) & ~(size_t)255; }
constexpr size_t WS_CTL = 0, CTL_BYTES = 1u << 20;
constexpr size_t WS_MODV = WS_CTL + CTL_BYTES;
constexpr size_t WS_WIN = al256(WS_MODV + (size_t)DEPTH * 2 * 6 * D * 4);
constexpr size_t WS_WCAT = al256(WS_WIN + (size_t)NP * D * 2);
constexpr size_t WS_WOUT = al256(WS_WCAT + (size_t)D * 2304 * 2);
constexpr size_t WS_WGU = al256(WS_WOUT + (size_t)D * D * 2);
constexpr size_t WS_WDN = al256(WS_WGU + (size_t)NE * 2 * FF * D * 2);
constexpr size_t WS_HC = al256(WS_WDN + (size_t)NE * D * FF * 2);
constexpr size_t WS_U = al256(WS_HC + (size_t)CTX * D * 4);
constexpr size_t WS_P = al256(WS_U + (size_t)MT * D * 2);
constexpr size_t P_BYTES = (size_t)MT * NP * 2;
constexpr size_t WS_XS = WS_P;
constexpr size_t WS_HS = al256(WS_XS + (size_t)NRMAX * D * 2);
constexpr size_t WS_YS = al256(WS_HS + (size_t)NRMAX * FF * 2);
constexpr size_t MOE_END = WS_YS + (size_t)NRMAX * D * 4;
constexpr size_t WS_Y = al256(WS_P + (P_BYTES > (MOE_END - WS_P) ? P_BYTES : (MOE_END - WS_P)));
constexpr int YK = 2304, YOFF_A = 0, YOFF_B = 512, YOFF_C = 1280, YOFF_D = 1792;
constexpr size_t WS_MG = al256(WS_Y + (size_t)MT * YK * 2);
constexpr size_t WS_TAPS = WS_MG;
constexpr size_t MG_BYTES = (size_t)MT * D * 4 > (size_t)2048 * MT * 2 ? (size_t)MT * D * 4 : (size_t)2048 * MT * 2;
constexpr size_t WS_XC = al256(WS_MG + MG_BYTES);
constexpr size_t WS_XCT = al256(WS_XC + (size_t)MT * XBC * 2);
constexpr size_t WS_DT = al256(WS_XCT + (size_t)1280 * MT * 2);
constexpr size_t WS_ACUM = al256(WS_DT + (size_t)MT * 24 * 4);
constexpr size_t WS_CDEC = al256(WS_ACUM + (size_t)2 * NH * MT * 4);
constexpr size_t WS_ST = al256(WS_CDEC + (size_t)2 * NCH * NH * 4);
constexpr size_t WS_HIN = al256(WS_ST + (size_t)2 * NCH * NH * HD * NS * 4);
constexpr size_t WS_SSQ = al256(WS_HIN + (size_t)2 * NCH * NH * HD * NS * 2);
constexpr size_t WS_QT = al256(WS_SSQ + (size_t)MT * 24 * 4);
constexpr size_t WS_HID2 = al256(WS_QT + (size_t)1536 * MT * 2);
constexpr size_t WS_YCT = al256(WS_HID2 + (size_t)MT * 64 * 4);
constexpr size_t WS_FSCR = al256(WS_YCT + (size_t)512 * MT * 2);
constexpr size_t WS_ZSCR = al256(WS_FSCR + (size_t)256 * (SEQ / 2 + 1) * 16);
constexpr size_t WS_ROUTE = al256(WS_ZSCR + (size_t)256 * (SEQ / 2) * 8);
constexpr size_t WS_POS = al256(WS_ROUTE + (size_t)MT * 16);
constexpr size_t WS_HIST = al256(WS_POS + (size_t)MT * 8);
constexpr size_t WS_TILEE = al256(WS_HIST + 256 * 32 * 4);
constexpr size_t WS_END = al256(WS_TILEE + (NTMAX + 64) * 4);
constexpr int CW_BAR = 0;
constexpr int CW_QUEUE = 4096;

#ifdef CPU_EMU
#define LAS
#define GAS
#else
#define LAS __attribute__((address_space(3)))
#define GAS __attribute__((address_space(1)))
#endif
typedef unsigned short bf16;
typedef unsigned v4u __attribute__((ext_vector_type(4)));
typedef unsigned v2u __attribute__((ext_vector_type(2)));
typedef float f32x4 __attribute__((ext_vector_type(4)));
typedef float f32x2 __attribute__((ext_vector_type(2)));
typedef short bf16x8 __attribute__((ext_vector_type(8)));
typedef float f32x16 __attribute__((ext_vector_type(16)));
#define MFMA32(a, b, c) __builtin_amdgcn_mfma_f32_32x32x16_bf16(a, b, c, 0, 0, 0)
#ifdef CPU_EMU
__device__ __forceinline__ unsigned f2bf(float f) { unsigned u = __builtin_bit_cast(unsigned, f); return (u + 0x7fffu + ((u >> 16) & 1u)) >> 16; }
__device__ __forceinline__ unsigned pk2(float lo, float hi) { return f2bf(lo) | (f2bf(hi) << 16); }
#else
__device__ __forceinline__ unsigned f2bf(float f) { unsigned r; asm("v_cvt_pk_bf16_f32 %0, %1, 0" : "=v"(r) : "v"(f)); return r; }
__device__ __forceinline__ unsigned pk2(float lo, float hi) { unsigned r; asm("v_cvt_pk_bf16_f32 %0, %1, %2" : "=v"(r) : "v"(lo), "v"(hi)); return r; }
#endif
__device__ __forceinline__ float bf2f(unsigned h) { return __builtin_bit_cast(float, (h & 0xffffu) << 16); }
__device__ __forceinline__ float u2f(unsigned u) { return __builtin_bit_cast(float, u); }
__device__ __forceinline__ unsigned f2u(float f) { return __builtin_bit_cast(unsigned, f); }
__device__ __forceinline__ float bflo(unsigned w) { return __builtin_bit_cast(float, w << 16); }
__device__ __forceinline__ float bfhi(unsigned w) { return __builtin_bit_cast(float, w & 0xffff0000u); }
#ifdef CPU_EMU
__device__ __forceinline__ float frcp(float x) { return 1.0f / x; }
__device__ __forceinline__ float frsq(float x) { return 1.0f / sqrtf(x); }
__device__ __forceinline__ float flog(float x) { return logf(x); }
#else
__device__ __forceinline__ float frcp(float x) { return __builtin_amdgcn_rcpf(x); }
__device__ __forceinline__ float frsq(float x) { return __builtin_amdgcn_rsqf(x); }
__device__ __forceinline__ float flog(float x) { return __logf(x); }
#endif
__device__ __forceinline__ float sigmoidf_(float x) { return frcp(1.0f + __expf(-x)); }
__device__ __forceinline__ float siluf_(float x) { return x * frcp(1.0f + __expf(-x)); }
#ifdef CPU_EMU
__device__ __forceinline__ float wave_sum(float v) {
#pragma unroll
    for (int o = 1; o < 64; o <<= 1) v += __shfl_xor(v, o);
    return v;
}
__device__ __forceinline__ float half_sum32(float v) {
#pragma unroll
    for (int o = 1; o < 32; o <<= 1) v += __shfl_xor(v, o);
    return v;
}
#else
template <int CTRL, int RMASK> __device__ __forceinline__ float dpp_add(float v) { return v + u2f((unsigned)__builtin_amdgcn_update_dpp(0, (int)f2u(v), CTRL, RMASK, 0xF, false)); }
__device__ __forceinline__ float row_sum16(float v) {
    v = dpp_add<0xB1, 0xF>(v);
    v = dpp_add<0x4E, 0xF>(v);
    v = dpp_add<0x141, 0xF>(v);
    v = dpp_add<0x140, 0xF>(v);
    return v;
}
__device__ __forceinline__ float half_sum32(float v) {
    v = row_sum16(v);
    return dpp_add<0x142, 0xA>(v);
}
__device__ __forceinline__ float wave_sum(float v) {
    v = half_sum32(v);
    v = dpp_add<0x143, 0xC>(v);
    return u2f((unsigned)__builtin_amdgcn_readlane((int)f2u(v), 63));
}
#endif
#ifdef CPU_EMU
#define LDS_WAIT()
#define VM_WAIT()
__device__ __forceinline__ void sincos_turns(float t, float& s, float& c) { s = sinf(6.283185307179586f * t); c = cosf(6.283185307179586f * t); }
#else
#define LDS_WAIT() asm volatile("s_waitcnt lgkmcnt(0)" ::: "memory")
#define VM_WAIT() asm volatile("s_waitcnt vmcnt(0)" ::: "memory")
__device__ __forceinline__ void sincos_turns(float t, float& s, float& c) { s = __builtin_amdgcn_sinf(t); c = __builtin_amdgcn_cosf(t); }
#endif

#ifndef CPU_EMU
#define XB_TMO      128
#define XB_XCNT(j)  (256  + 64 * (j))
#define XB_XSUB(j)  (1280 + 64 * (j))
#define XB_XGEN(j)  (2304 + 64 * (j))
#define XB_TOP      3328
#define XB_TOPGEN   3392
#define XCD_BAR_WORDS 3456
#define XB_SPIN_CAP (1u << 18)
__device__ __forceinline__ unsigned xb_ld(unsigned* p)              { return __hip_atomic_load(p, __ATOMIC_RELAXED, __HIP_MEMORY_SCOPE_AGENT); }
__device__ __forceinline__ unsigned xb_add(unsigned* p, unsigned v) { return __hip_atomic_fetch_add(p, v, __ATOMIC_RELAXED, __HIP_MEMORY_SCOPE_AGENT); }
__device__ __forceinline__ unsigned xb_xcc_id() { return (unsigned)__builtin_amdgcn_s_getreg((3 << 11) | 20) & 0xFu; }
#define XB_SPIN(cond, bar) do { unsigned _sp = 0; while (cond) { __builtin_amdgcn_s_sleep(1); \
    if ((++_sp & 255u) == 0u) { if (xb_ld(&(bar)[XB_TMO])) break; if (_sp > XB_SPIN_CAP) { atomicAdd(&(bar)[XB_TMO], 1u); break; } } } } while (0)
struct XcdBarrier { unsigned* bar; unsigned x; volatile LAS unsigned* st; };
__device__ __forceinline__ XcdBarrier xcd_barrier_post(unsigned* bar, volatile LAS unsigned* st) {
    XcdBarrier b; b.bar = bar; b.x = xb_xcc_id(); b.st = st;
    if (threadIdx.x == 0) (void)xb_add(&bar[XB_XCNT(b.x)], 1u);
    return b;
}
__device__ __forceinline__ void xcd_barrier_complete(unsigned* bar, unsigned x, unsigned& nloc, unsigned& nx) {
    const unsigned G = gridDim.x * gridDim.y * gridDim.z;
    unsigned sum, cnt, mine, sp = 0u;
    for (;;) {
        sum = 0u; cnt = 0u; mine = 0u;
#pragma unroll
        for (unsigned j = 0; j < 16; ++j) { const unsigned c = xb_ld(&bar[XB_XCNT(j)]); sum += c; cnt += (c > 0u) ? 1u : 0u; mine = (j == x) ? c : mine; }
        if (sum == G) break;
        __builtin_amdgcn_s_sleep(1);
        if ((++sp & 255u) == 0u) { if (xb_ld(&bar[XB_TMO])) break; if (sp > XB_SPIN_CAP) { atomicAdd(&bar[XB_TMO], 1u); break; } }
    }
    nloc = mine > 0u ? mine : 1u; nx = cnt > 0u ? cnt : 1u;
}
__device__ __forceinline__ void xcd_barrier(const XcdBarrier& b) {
    asm volatile("s_waitcnt vmcnt(0)" ::: "memory");
    __syncthreads();
    if (threadIdx.x == 0) {
        unsigned* bar = b.bar;
        __builtin_amdgcn_s_waitcnt(0);
        unsigned nloc = b.st[0], nx = b.st[1];
        if (nloc == 0u) { xcd_barrier_complete(bar, b.x, nloc, nx); b.st[0] = nloc; b.st[1] = nx; }
        const unsigned old = xb_add(&bar[XB_XSUB(b.x)], 1u);
        const unsigned gen = old / nloc;
        if (old + 1u == (gen + 1u) * nloc) {
            __builtin_amdgcn_fence(__ATOMIC_RELEASE, "agent");
            asm volatile("s_waitcnt vmcnt(0)" ::: "memory");
            const unsigned og = xb_add(&bar[XB_TOP], 1u);
            const unsigned tg = og / nx;
            if (og + 1u == (tg + 1u) * nx) xb_add(&bar[XB_TOPGEN], 1u);
            else XB_SPIN(xb_ld(&bar[XB_TOPGEN]) == tg, bar);
            __builtin_amdgcn_fence(__ATOMIC_ACQUIRE, "agent");
            xb_add(&bar[XB_XGEN(b.x)], 1u);
            asm volatile("s_waitcnt vmcnt(0)" ::: "memory");
        } else {
            XB_SPIN(xb_ld(&bar[XB_XGEN(b.x)]) == gen, bar);
            __builtin_amdgcn_fence(__ATOMIC_ACQUIRE, "agent");
            asm volatile("s_waitcnt vmcnt(0)" ::: "memory");
        }
    }
    __syncthreads();
}
#else
struct XcdBarrier { int dummy; };
__device__ __forceinline__ void xcd_barrier(const XcdBarrier&) { emu_grid_sync(); }
#endif

namespace pg8 {
constexpr int BM = 256, BK = 64, HALF = 128, HTB = HALF * BK * 2, STAGE_BYTES = 8 * HTB;
__host__ __device__ __forceinline__ int lds_byte(int r, int c) { const int st = (r >> 4) * 2 + (c >> 5), rr = r & 15, cc = c & 31, ob = rr * 64 + cc * 2; return st * 1024 + (ob ^ (((ob >> 9) & 1) << 5)); }
__host__ __device__ __forceinline__ void stage_rc(int b, int& R, int& C) { const int st = b / 1024, sb = b % 1024, swz = sb ^ (((sb >> 9) & 1) << 5); R = (st >> 1) * 16 + swz / 64; C = (st & 1) * 32 + (swz % 64) / 2; }
__host__ __device__ __forceinline__ int perm32(int rho) { const int n = rho >> 4, i = rho & 15; return 8 * (i >> 2) + 4 * n + (i & 3); }
struct Unit { int pm, pn; const char* A; const char* B; int tag; };
#ifndef CPU_EMU
__device__ __forceinline__ unsigned cvt_pk_bf16(float lo, float hi) { unsigned r; asm volatile("v_cvt_pk_bf16_f32 %0, %1, %2" : "=v"(r) : "v"(lo), "v"(hi)); return r; }
#else
__device__ __forceinline__ unsigned cvt_pk_bf16(float lo, float hi) { return pk2(lo, hi); }
#endif

template <class Epi, class Sched, bool ALIGN_EPI = false, bool SP2 = false>
__device__ __forceinline__ void gemm_phase(LAS unsigned char* lds, const int K, const Sched& S, const Epi& E, const int tid) {
    const int lane = tid & 63;
#ifdef CPU_EMU
    const int wid = tid >> 6, wr = wid >> 2, wc = wid & 3, fr = lane & 15, fq = lane >> 4;
    Unit cur;
    for (int ui = 0; S.next(ui, cur); ++ui) {
        f32x4 acc[2][2][4][2];
        const bf16* A = (const bf16*)cur.A; const bf16* B = (const bf16*)cur.B;
        for (int ai = 0; ai < 2; ++ai) for (int bj = 0; bj < 2; ++bj) for (int m = 0; m < 4; ++m) for (int n = 0; n < 2; ++n) for (int j = 0; j < 4; ++j) {
            const int r = 128 * ai + 64 * wr + 16 * m + fr;
            const int c = Epi::PERM ? (128 * bj + 32 * wc + 8 * fq + 4 * n + j) : (128 * bj + 32 * wc + 16 * n + 4 * fq + j);
            acc[ai][bj][m][n][j] = 0.f; }
        for (int t = 0; t < K / BK; ++t) {
            if constexpr (Epi::SEG) { if (t == Epi::S1 || t == Epi::S2 || t == Epi::S3) E.segment(acc, cur, t, wr, wc, fr, fq); }
            for (int ai = 0; ai < 2; ++ai) for (int bj = 0; bj < 2; ++bj) for (int m = 0; m < 4; ++m) for (int n = 0; n < 2; ++n) for (int j = 0; j < 4; ++j) {
                const int r = 128 * ai + 64 * wr + 16 * m + fr;
                const int c = Epi::PERM ? (128 * bj + 32 * wc + 8 * fq + 4 * n + j) : (128 * bj + 32 * wc + 16 * n + 4 * fq + j);
                float s = 0.f; const bf16* ar = A + (size_t)r * K + t * BK; const bf16* br = B + (size_t)c * K + t * BK;
                for (int k = 0; k < BK; ++k) s += bf2f(ar[k]) * bf2f(br[k]);
                acc[ai][bj][m][n][j] += s; }
        }
        E(acc, cur, wr, wc, fr, fq);
    }
    __syncthreads();
#else
    const int wid = __builtin_amdgcn_readfirstlane(tid >> 6), wr = wid >> 2, wc = wid & 3, fr = lane & 15, fq = lane >> 4;
    const int nt = K / BK;
    unsigned voffA[2], voffB[2];
#pragma unroll
    for (int i = 0; i < 2; ++i) { int R, C; stage_rc(tid * 16 + i * 8192, R, C); const int Rb = Epi::PERM ? ((R & ~31) + perm32(R & 31)) : R;
        voffA[i] = (unsigned)(R * K + C) * 2u; voffB[i] = (unsigned)(Rb * K + C) * 2u; }
    const size_t kstep = (size_t)(BK * 2);
    const size_t hstep = (size_t)HALF * K * 2;
    const unsigned ldsw = (unsigned)wid * 1024u;
    const int aoff = lds_byte(wr * 64 + fr, fq * 8), boff = lds_byte(wc * 32 + fr, fq * 8);
#define PG8_SA(b, h) (((b) * 2 + (h)) * HTB)
#define PG8_SB(b, h) ((4 + (b) * 2 + (h)) * HTB)
#define PG8_STAGE(bufoff, gbase, voff) do { _Pragma("unroll") for (int _i = 0; _i < 2; ++_i) \
        __builtin_amdgcn_global_load_lds((const unsigned*)((const char*)(gbase) + (voff)[_i]), (LAS unsigned*)(lds + (bufoff) + ldsw + _i * 8192), 16, 0, 0); } while (0)
#define PG8_LDA(dst, b, h) do { _Pragma("unroll") for (int m = 0; m < 4; ++m) _Pragma("unroll") for (int k = 0; k < 2; ++k) dst[m][k] = *(const LAS bf16x8*)(lds + PG8_SA(b, h) + aoff + m * 2048 + k * 1024); } while (0)
#define PG8_LDB(dst, b, h) do { _Pragma("unroll") for (int n = 0; n < 2; ++n) _Pragma("unroll") for (int k = 0; k < 2; ++k) dst[n][k] = *(const LAS bf16x8*)(lds + PG8_SB(b, h) + boff + n * 2048 + k * 1024); } while (0)
#define PG8_MMA(ai, bj, At, Bt) do { __builtin_amdgcn_s_setprio(1); _Pragma("unroll") for (int m = 0; m < 4; ++m) _Pragma("unroll") for (int n = 0; n < 2; ++n) _Pragma("unroll") for (int k = 0; k < 2; ++k) \
        acc[ai][bj][m][n] = __builtin_amdgcn_mfma_f32_16x16x32_bf16(Bt[n][k], At[m][k], acc[ai][bj][m][n], 0, 0, 0); __builtin_amdgcn_s_setprio(0); } while (0)
#define PG8_WAIT_V(n) asm volatile("s_waitcnt vmcnt(" #n ")" ::: "memory")
#define PG8_WAIT_L(n) asm volatile("s_waitcnt lgkmcnt(" #n ")" ::: "memory")
#define PG8_BAR __builtin_amdgcn_s_barrier()
#define PG8_SCHED __builtin_amdgcn_sched_barrier(0)
    Unit cur, nxt; int ui = 0;
    if (!S.next(0, cur)) return;
    f32x4 acc[2][2][4][2];
#pragma unroll
    for (int a = 0; a < 2; ++a)
#pragma unroll
        for (int b = 0; b < 2; ++b)
#pragma unroll
            for (int m = 0; m < 4; ++m)
#pragma unroll
                for (int n = 0; n < 2; ++n) acc[a][b][m][n] = (f32x4){0.f, 0.f, 0.f, 0.f};
    bf16x8 At[4][2], B0[2][2], B1[2][2];
    const char* cA = cur.A; const char* cB = cur.B;
    if constexpr (SP2) {
        PG8_STAGE(PG8_SB(0, 0), cB, voffB); PG8_STAGE(PG8_SB(0, 1), cB + hstep, voffB); PG8_STAGE(PG8_SA(0, 0), cA, voffA); PG8_STAGE(PG8_SA(0, 1), cA + hstep, voffA);
        if (wr == 1) PG8_BAR;
        PG8_WAIT_V(2); PG8_BAR;
        PG8_STAGE(PG8_SB(1, 0), cB + kstep, voffB); PG8_STAGE(PG8_SA(1, 0), cA + kstep, voffA); PG8_STAGE(PG8_SB(1, 1), cB + hstep + kstep, voffB);
        PG8_WAIT_V(6); PG8_BAR;
    } else {
        PG8_STAGE(PG8_SB(0, 0), cB, voffB); PG8_STAGE(PG8_SA(0, 0), cA, voffA); PG8_STAGE(PG8_SB(0, 1), cB + hstep, voffB); PG8_STAGE(PG8_SA(0, 1), cA + hstep, voffA);
        if (wr == 1) PG8_BAR;
        PG8_WAIT_V(4); PG8_BAR;
        PG8_STAGE(PG8_SB(1, 0), cB + kstep, voffB); PG8_STAGE(PG8_SA(1, 0), cA + kstep, voffA); PG8_STAGE(PG8_SB(1, 1), cB + hstep + kstep, voffB);
        PG8_WAIT_V(6); PG8_BAR;
    }
    for (;;) {
        const bool has_next = S.next(ui + 1, nxt);
        const char* nA = has_next ? nxt.A : cA; const char* nB = has_next ? nxt.B : cB;
        for (int t = 0; t < nt; t += 2) {
            const bool last = (t == nt - 2);
            const char* a1 = cA + (size_t)(t + 1) * kstep;
            const char* a2 = last ? nA : cA + (size_t)(t + 2) * kstep; const char* b2 = last ? nB : cB + (size_t)(t + 2) * kstep;
            const char* a3 = a2 + kstep; const char* b3 = b2 + kstep;
            if constexpr (Epi::SEG) { if (wr == 0 && (t == Epi::S1 || t == Epi::S2 || t == Epi::S3)) E.segment(acc, cur, t, wr, wc, fr, fq); }
            if constexpr (SP2) {
            PG8_LDB(B0, 0, 0); PG8_LDB(B1, 0, 1); PG8_SCHED; PG8_LDA(At, 0, 0); PG8_STAGE(PG8_SA(1, 1), a1 + hstep, voffA);
            PG8_WAIT_V(8); PG8_WAIT_L(0); PG8_BAR; PG8_MMA(0, 0, At, B0); PG8_MMA(0, 1, At, B1); PG8_BAR; PG8_SCHED;
            PG8_LDA(At, 0, 1); PG8_STAGE(PG8_SB(0, 0), b2, voffB); PG8_STAGE(PG8_SB(0, 1), b2 + hstep, voffB); PG8_STAGE(PG8_SA(0, 0), a2, voffA);
            PG8_WAIT_V(8); PG8_WAIT_L(0); PG8_BAR; PG8_MMA(1, 0, At, B0); PG8_MMA(1, 1, At, B1); PG8_BAR; PG8_SCHED;
            PG8_LDB(B0, 1, 0); PG8_LDB(B1, 1, 1); PG8_SCHED; PG8_LDA(At, 1, 0); PG8_STAGE(PG8_SA(0, 1), a2 + hstep, voffA);
            PG8_WAIT_V(8); PG8_WAIT_L(0); PG8_BAR; PG8_MMA(0, 0, At, B0); PG8_MMA(0, 1, At, B1); PG8_BAR; PG8_SCHED;
            PG8_LDA(At, 1, 1); PG8_STAGE(PG8_SB(1, 0), b3, voffB); PG8_STAGE(PG8_SB(1, 1), b3 + hstep, voffB); PG8_STAGE(PG8_SA(1, 0), a3, voffA);
            PG8_WAIT_V(8); PG8_WAIT_L(0); PG8_BAR; PG8_MMA(1, 0, At, B0); PG8_MMA(1, 1, At, B1);
            if constexpr (Epi::SEG) { if (wr == 1 && (t + 2 == Epi::S1 || t + 2 == Epi::S2 || t + 2 == Epi::S3)) E.segment(acc, cur, t + 2, wr, wc, fr, fq); }
            PG8_BAR; PG8_SCHED;
            } else {
            PG8_LDB(B0, 0, 0); PG8_SCHED; PG8_LDA(At, 0, 0); PG8_STAGE(PG8_SA(1, 1), a1 + hstep, voffA);
            PG8_WAIT_L(8); PG8_BAR; PG8_WAIT_L(0); PG8_MMA(0, 0, At, B0); PG8_BAR; PG8_SCHED;
            PG8_LDB(B1, 0, 1); PG8_STAGE(PG8_SB(0, 0), b2, voffB);
            PG8_BAR; PG8_WAIT_L(0); PG8_MMA(0, 1, At, B1); PG8_BAR;
            PG8_LDA(At, 0, 1); PG8_STAGE(PG8_SA(0, 0), a2, voffA);
            PG8_BAR; PG8_WAIT_L(0); PG8_MMA(1, 0, At, B0); PG8_BAR; PG8_SCHED;
            PG8_STAGE(PG8_SB(0, 1), b2 + hstep, voffB);
            PG8_WAIT_V(6); PG8_BAR; PG8_MMA(1, 1, At, B1); PG8_BAR;
            PG8_LDB(B0, 1, 0); PG8_SCHED; PG8_LDA(At, 1, 0); PG8_STAGE(PG8_SA(0, 1), a2 + hstep, voffA);
            PG8_WAIT_L(8); PG8_BAR; PG8_WAIT_L(0); PG8_MMA(0, 0, At, B0); PG8_BAR; PG8_SCHED;
            PG8_LDB(B1, 1, 1); PG8_STAGE(PG8_SB(1, 0), b3, voffB);
            PG8_BAR; PG8_WAIT_L(0); PG8_MMA(0, 1, At, B1); PG8_BAR;
            PG8_LDA(At, 1, 1); PG8_STAGE(PG8_SA(1, 0), a3, voffA);
            PG8_BAR; PG8_WAIT_L(0); PG8_MMA(1, 0, At, B0); PG8_BAR; PG8_SCHED;
            PG8_STAGE(PG8_SB(1, 1), b3 + hstep, voffB);
            PG8_WAIT_V(6); PG8_BAR; PG8_MMA(1, 1, At, B1); PG8_BAR;
            }
        }
        if constexpr (ALIGN_EPI) { if (wr == 0) PG8_BAR; }
        E(acc, cur, wr, wc, fr, fq);
        if (!has_next) break;
#pragma unroll
        for (int a = 0; a < 2; ++a)
#pragma unroll
            for (int b = 0; b < 2; ++b)
#pragma unroll
                for (int m = 0; m < 4; ++m)
#pragma unroll
                    for (int n = 0; n < 2; ++n) acc[a][b][m][n] = (f32x4){0.f, 0.f, 0.f, 0.f};
        cur = nxt; cA = nA; cB = nB; ++ui;
        if constexpr (ALIGN_EPI) { if (wr == 1) PG8_BAR; }
    }
    PG8_WAIT_V(0);
    if constexpr (!ALIGN_EPI) { if (wr == 0) PG8_BAR; }
    PG8_BAR;
#undef PG8_SA
#undef PG8_SB
#undef PG8_STAGE
#undef PG8_LDA
#undef PG8_LDB
#undef PG8_MMA
#undef PG8_WAIT_V
#undef PG8_WAIT_L
#undef PG8_BAR
#undef PG8_SCHED
#endif
}
}

struct KParams { const float* in[N_IN]; float* out; unsigned char* ws; int ph_lo, ph_hi; };
#ifdef CPU_EMU
typedef const KParams& KPR;
static const KParams* g_emu_kp = nullptr;
#define KP_DECL KPR p = *g_emu_kp
#define NOINLINE inline
#define UNI(x) (x)
#define LDS_DECL LAS unsigned char* lds = emu_lds_ptr
#define OPAQUE_V(x)
#define OPAQUE_S(x)
#else
typedef const KParams __attribute__((address_space(4)))& KPR;
#define KP_DECL const KParams __attribute__((address_space(4)))* kp_ = (const KParams __attribute__((address_space(4)))*)__builtin_amdgcn_kernarg_segment_ptr(); asm volatile("" : "+s"(kp_)); KPR p = *kp_
#define NOINLINE __forceinline__
#define UNI(x) __builtin_amdgcn_readfirstlane(x)
extern __shared__ __attribute__((aligned(16))) unsigned char lds_raw[];
#define LDS_DECL LAS unsigned char* lds = (LAS unsigned char*)lds_raw
#define OPAQUE_V(x) asm volatile("" : "+v"(x))
#define OPAQUE_S(x) asm volatile("" : "+s"(x))
#endif
#define ENTRY_BEGIN KP_DECL; LDS_DECL; int tid = threadIdx.x; OPAQUE_V(tid); int bid = blockIdx.x; OPAQUE_S(bid); const int lane = tid & 63, G = gridDim.x; const int wave = UNI(tid >> 6); const int gw = bid * NWAVES + wave, NGW = G * NWAVES; (void)lane; (void)gw; (void)NGW; (void)lds
#ifdef CPU_EMU
#define WAVE_SYNC() emu_wave_sync()
#else
#define WAVE_SYNC() do { asm volatile("s_waitcnt lgkmcnt(0)" ::: "memory"); __builtin_amdgcn_wave_barrier(); } while (0)
#endif
#define WSP(T, off) ((T*)(p.ws + (off)))
#ifdef CPU_EMU
#define CFENCE()
#define SCHED_FENCE()
#else
#define CFENCE() asm volatile("" ::: "memory")
#define SCHED_FENCE() __builtin_amdgcn_sched_barrier(0)
#endif
__device__ __forceinline__ float* hrow(KPR p, int t) { return t < SEQ ? p.out + (size_t)t * D : WSP(float, WS_HC) + (size_t)(t - SEQ) * D; }
__device__ __forceinline__ const float* modv(KPR p, int l, int which, int part) { return WSP(float, WS_MODV) + ((size_t)(l * 2 + which) * 6 + part) * D; }

struct DenseOrder {
    int nM, nN, nwg, G, c; const char* A; const char* B; size_t astep, bstep;
    __device__ __forceinline__ void init(int M, int N, int K, int G_, int c_, const void* A_, const void* B_) { nM = M / 256; nN = N / 256; nwg = nM * nN; G = G_; c = c_; A = (const char*)A_; B = (const char*)B_; astep = (size_t)256 * K * 2; bstep = astep; }
    __device__ __forceinline__ bool next(int i, pg8::Unit& u) const {
        const long L = (long)i * G + c; if (L >= nwg) return false;
        int wgid = (int)L; { const int q = nwg / 8, r = nwg % 8, xcd = wgid % 8, off = wgid / 8; wgid = (xcd < r ? xcd * (q + 1) : r * (q + 1) + (xcd - r) * q) + off; }
        const int nig = 8 * nN, gid = wgid / nig, fm = gid * 8, gsz = (nM - fm) < 8 ? (nM - fm) : 8;
        u.pm = fm + ((wgid % nig) % gsz); u.pn = (wgid % nig) / gsz; u.A = A + (size_t)u.pm * astep; u.B = B + (size_t)u.pn * bstep; u.tag = i; return true;
    }
};
struct MoeOrder {
    const int* tile_e; int ntiles, nN, G, c; const char* A; const char* B; size_t astep, bstepE, bstepN;
    __device__ __forceinline__ bool next(int i, pg8::Unit& u) const {
        int tile, pn;
        if ((G & 7) == 0) {
            const int xcd = c & 7, rank = c >> 3, W = G >> 3, q = ntiles / 8, r = ntiles % 8;
            const int tb = xcd < r ? xcd * (q + 1) : r * (q + 1) + (xcd - r) * q, nt = xcd < r ? q + 1 : q;
            const int L = i * W + rank; if (L >= nt * nN) return false;
            tile = tb + L / nN; pn = L % nN;
        } else { const long L = (long)i * G + c; if (L >= (long)ntiles * nN) return false; tile = (int)(L / nN); pn = (int)(L % nN); }
        const int e = tile_e[tile];
        u.pm = tile; u.pn = pn; u.A = A + (size_t)tile * astep; u.B = B + (size_t)e * bstepE + (size_t)pn * bstepN; u.tag = 0; return true;
    }
};

__device__ __forceinline__ void unpack8(const v4u w, float (&f)[8]) { f[0] = bflo(w.x); f[1] = bfhi(w.x); f[2] = bflo(w.y); f[3] = bfhi(w.y); f[4] = bflo(w.z); f[5] = bfhi(w.z); f[6] = bflo(w.w); f[7] = bfhi(w.w); }
struct EpiPG {
    static constexpr bool PERM = true, SEG = false; static constexpr int S1 = -1, S2 = -1, S3 = -1;
    bf16* O; int ldc;
    __device__ __forceinline__ void operator()(const f32x4 (&acc)[2][2][4][2], const pg8::Unit& u, int wr, int wc, int fr, int fq) const {
        const int row0 = u.pm * 256 + wr * 64 + fr;
        if (u.pn < 4) {
            const int col0 = (u.pn * 256 + wc * 32 + 8 * fq) / 2;
#pragma unroll
            for (int ai = 0; ai < 2; ++ai)
#pragma unroll
                for (int m = 0; m < 4; ++m) { bf16* rowp = O + (size_t)(row0 + ai * 128 + m * 16) * ldc + col0;
#pragma unroll
                    for (int bj = 0; bj < 2; ++bj) { const f32x4 v0 = acc[ai][bj][m][0], v1 = acc[ai][bj][m][1];
                        v2u w; w.x = pg8::cvt_pk_bf16(v0[0] * sigmoidf_(v0[1]), v0[2] * sigmoidf_(v0[3])); w.y = pg8::cvt_pk_bf16(v1[0] * sigmoidf_(v1[1]), v1[2] * sigmoidf_(v1[3]));
                        *(v2u*)(rowp + bj * 64) = w; } }
        } else {
            const int col0 = u.pn * 256 + wc * 32 + 8 * fq;
#pragma unroll
            for (int ai = 0; ai < 2; ++ai)
#pragma unroll
                for (int m = 0; m < 4; ++m) { bf16* rowp = O + (size_t)(row0 + ai * 128 + m * 16) * ldc + col0;
#pragma unroll
                    for (int bj = 0; bj < 2; ++bj) { const f32x4 v0 = acc[ai][bj][m][0], v1 = acc[ai][bj][m][1];
                        v4u w; w.x = pg8::cvt_pk_bf16(v0[0], v0[1]); w.y = pg8::cvt_pk_bf16(v0[2], v0[3]); w.z = pg8::cvt_pk_bf16(v1[0], v1[1]); w.w = pg8::cvt_pk_bf16(v1[2], v1[3]);
                        *(v4u*)(rowp + bj * 128) = w; } }
        }
    }
};
struct EpiP {
    static constexpr bool PERM = true, SEG = false; static constexpr int S1 = -1, S2 = -1, S3 = -1;
    bf16* O; int ldc;
    __device__ __forceinline__ void operator()(const f32x4 (&acc)[2][2][4][2], const pg8::Unit& u, int wr, int wc, int fr, int fq) const {
        const int row0 = u.pm * 256 + wr * 64 + fr, col0 = u.pn * 256 + wc * 32 + 8 * fq;
#pragma unroll
        for (int ai = 0; ai < 2; ++ai)
#pragma unroll
            for (int m = 0; m < 4; ++m) { bf16* rowp = O + (size_t)(row0 + ai * 128 + m * 16) * ldc + col0;
#pragma unroll
                for (int bj = 0; bj < 2; ++bj) { const f32x4 v0 = acc[ai][bj][m][0], v1 = acc[ai][bj][m][1];
                    v4u w; w.x = pg8::cvt_pk_bf16(v0[0], v0[1]); w.y = pg8::cvt_pk_bf16(v0[2], v0[3]); w.z = pg8::cvt_pk_bf16(v1[0], v1[1]); w.w = pg8::cvt_pk_bf16(v1[2], v1[3]);
                    *(v4u*)(rowp + bj * 128) = w; } }
    }
};
#ifdef CPU_EMU
__device__ __forceinline__ float gate_den(float x) { return 1.0f + __expf(-fminf(fmaxf(x, -30.f), 30.f)); }
#else
__device__ __forceinline__ float gate_den(float x) { return 1.0f + __expf(-__builtin_amdgcn_fmed3f(x, -30.f, 30.f)); }
#endif
struct EpiMerge {
    static constexpr bool PERM = true, SEG = true; static constexpr int S1 = 8, S2 = 20, S3 = 28;
    const bf16* Pg; bf16* MGb; const LAS float* rs;
    __device__ __forceinline__ void segment(f32x4 (&acc)[2][2][4][2], const pg8::Unit& u, int t, int wr, int wc, int fr, int fq) const {
        const int br = (t == S1) ? 0 : (t == S2 ? 1 : 2);
        int row0 = u.pm * 256 + wr * 64 + fr; OPAQUE_V(row0);
        const int col0 = u.pn * 256 + wc * 32 + 8 * fq;
#pragma unroll
        for (int ai = 0; ai < 2; ++ai)
#pragma unroll
            for (int m = 0; m < 4; ++m) { const int rl = wr * 64 + fr + ai * 128 + m * 16, row = row0 + ai * 128 + m * 16;
                const float rsv = rs[u.tag * 256 + rl]; const float sc = (br == 0) ? frcp(rsv) : (br == 1 ? rsv : 1.f);
                const bf16* gp = Pg + (size_t)row * NP + br * D + col0;
#pragma unroll
                for (int bj = 0; bj < 2; ++bj) { float a[8], b[8]; unpack8(*(const v4u*)(gp + bj * 128), a); unpack8(*(const v4u*)(gp + D + bj * 128), b);
#pragma unroll
                    for (int j = 0; j < 4; ++j) { acc[ai][bj][m][0][j] *= gate_den(b[j]) * frcp(gate_den(a[j])) * sc; acc[ai][bj][m][1][j] *= gate_den(b[4 + j]) * frcp(gate_den(a[4 + j])) * sc; } }
                if (m & 1) CFENCE(); }
    }
    __device__ __forceinline__ void operator()(const f32x4 (&acc)[2][2][4][2], const pg8::Unit& u, int wr, int wc, int fr, int fq) const {
        const int row0 = u.pm * 256 + wr * 64 + fr, col0 = u.pn * 256 + wc * 32 + 8 * fq;
#pragma unroll
        for (int ai = 0; ai < 2; ++ai)
#pragma unroll
            for (int m = 0; m < 4; ++m) { const int row = row0 + ai * 128 + m * 16; const bf16* gp = Pg + (size_t)row * NP + 3 * D + col0;
#pragma unroll
                for (int bj = 0; bj < 2; ++bj) { float g[8]; unpack8(*(const v4u*)(gp + bj * 128), g); const f32x4 v0 = acc[ai][bj][m][0], v1 = acc[ai][bj][m][1];
                    v4u w; w.x = pg8::cvt_pk_bf16(v0[0] * frcp(gate_den(g[0])), v0[1] * frcp(gate_den(g[1]))); w.y = pg8::cvt_pk_bf16(v0[2] * frcp(gate_den(g[2])), v0[3] * frcp(gate_den(g[3])));
                    w.z = pg8::cvt_pk_bf16(v1[0] * frcp(gate_den(g[4])), v1[1] * frcp(gate_den(g[5]))); w.w = pg8::cvt_pk_bf16(v1[2] * frcp(gate_den(g[6])), v1[3] * frcp(gate_den(g[7])));
                    *(v4u*)(MGb + (size_t)row * D + col0 + bj * 128) = w; }
                if (m & 1) CFENCE(); }
    }
};
struct EpiSwiGLU {
    static constexpr bool PERM = true, SEG = false; static constexpr int S1 = -1, S2 = -1, S3 = -1;
    bf16* HS;
    __device__ __forceinline__ void operator()(const f32x4 (&acc)[2][2][4][2], const pg8::Unit& u, int wr, int wc, int fr, int fq) const {
        const int row0 = u.pm * 256 + wr * 64 + fr, col0 = (u.pn * 256 + wc * 32 + 8 * fq) / 2;
#pragma unroll
        for (int ai = 0; ai < 2; ++ai)
#pragma unroll
            for (int m = 0; m < 4; ++m) { bf16* rowp = HS + (size_t)(row0 + ai * 128 + m * 16) * FF + col0;
#pragma unroll
                for (int bj = 0; bj < 2; ++bj) { const f32x4 v0 = acc[ai][bj][m][0], v1 = acc[ai][bj][m][1];
                    v2u w; w.x = pg8::cvt_pk_bf16(siluf_(v0[0]) * v0[1], siluf_(v0[2]) * v0[3]); w.y = pg8::cvt_pk_bf16(siluf_(v1[0]) * v1[1], siluf_(v1[2]) * v1[3]);
                    *(v2u*)(rowp + bj * 64) = w; } }
    }
};
struct EpiF32 {
    static constexpr bool PERM = false, SEG = false; static constexpr int S1 = -1, S2 = -1, S3 = -1;
    float* C; int ldc;
    __device__ __forceinline__ void operator()(const f32x4 (&acc)[2][2][4][2], const pg8::Unit& u, int wr, int wc, int fr, int fq) const {
        const int row0 = u.pm * 256 + wr * 64 + fr, col0 = u.pn * 256 + wc * 32 + 4 * fq;
#pragma unroll
        for (int ai = 0; ai < 2; ++ai)
#pragma unroll
            for (int m = 0; m < 4; ++m) { float* rowp = C + (size_t)(row0 + ai * 128 + m * 16) * ldc + col0;
#pragma unroll
                for (int bj = 0; bj < 2; ++bj)
#pragma unroll
                    for (int n = 0; n < 2; ++n) *(f32x4*)(rowp + bj * 128 + n * 16) = acc[ai][bj][m][n]; }
    }
};

struct TrDesc { const float* W; bf16* WT; int ldw, N, drow0, rstride, kb, nb, ldk, koff; };
__device__ __forceinline__ void tr_load(const TrDesc& d, int lane, f32x4 (&v)[16]) {
    const int k0 = 64 * d.kb, n = 64 * d.nb + (lane & 15) * 4, r4 = lane >> 4;
#pragma unroll
    for (int i = 0; i < 16; ++i) { const int kk = 4 * i + r4; const float* src = d.W + (size_t)(k0 + kk) * d.ldw + n;
        f32x4 t = (f32x4){0.f, 0.f, 0.f, 0.f};
        if (n + 3 < d.N) t = *(const f32x4*)src;
        else { if (n < d.N) t[0] = src[0]; if (n + 1 < d.N) t[1] = src[1]; if (n + 2 < d.N) t[2] = src[2]; }
        v[i] = t; }
}
__device__ __forceinline__ void tr_store(const TrDesc& d, LAS float* scr, int lane, const f32x4 (&v)[16]) {
    const int k0 = 64 * d.kb, n0 = 64 * d.nb, c4 = (lane & 15) * 4, r4 = lane >> 4;
#pragma unroll
    for (int i = 0; i < 16; ++i) { LAS float* q = scr + (4 * i + r4) * 65 + c4; q[0] = v[i][0]; q[1] = v[i][1]; q[2] = v[i][2]; q[3] = v[i][3]; }
    WAVE_SYNC();
#pragma unroll
    for (int j = 0; j < 8; ++j) { const int q = lane + 64 * j, n = q >> 3, kc = q & 7; const LAS float* s = scr + (8 * kc) * 65 + n;
        v4u o; o.x = pk2(s[0 * 65], s[1 * 65]); o.y = pk2(s[2 * 65], s[3 * 65]); o.z = pk2(s[4 * 65], s[5 * 65]); o.w = pk2(s[6 * 65], s[7 * 65]);
        if (n0 + n < d.N) *(v4u*)(d.WT + (size_t)(d.drow0 + (n0 + n) * d.rstride) * d.ldk + d.koff + k0 + 8 * kc) = o; }
    WAVE_SYNC();
}
constexpr int CV_NB0 = (PROJ + 63) / 64, CV_S0 = (D / 64) * CV_NB0, CV_S1 = (512 / 64) * (D / 64), CV_S2 = (768 / 64) * (D / 64), CV_S5 = (D / 64) * (D / 64),
              CV_S6 = NE * (D / 64) * (FF / 64), CV_S8 = NE * (FF / 64) * (D / 64), CV_TOT = CV_S0 + 3 * CV_S1 + CV_S2 + CV_S5 + 2 * CV_S6 + CV_S8;
__device__ __forceinline__ TrDesc conv_desc(KPR p, int l, int it) {
    TrDesc d; int r = it;
    if (r < CV_S0) { const int nb = r % CV_NB0, n0 = 64 * nb;
        d.W = p.in[I_WIN] + (size_t)l * D * PROJ; d.WT = WSP(bf16, WS_WIN); d.ldw = PROJ; d.N = PROJ; d.drow0 = n0 < 512 ? 0 : (n0 < 1024 ? -1023 : 0); d.rstride = n0 < 1024 ? 2 : 1; d.kb = r / CV_NB0; d.nb = nb; d.ldk = D; d.koff = 0; return d; } r -= CV_S0;
    d.ldw = D; d.N = D; d.drow0 = 0; d.rstride = 1; d.kb = r / (D / 64); d.nb = r % (D / 64); d.WT = WSP(bf16, WS_WCAT); d.ldk = YK;
    if (r < CV_S1) { d.W = p.in[I_WBA] + (size_t)l * 512 * D; d.koff = YOFF_A; return d; } r -= CV_S1; d.kb = r / (D / 64); d.nb = r % (D / 64);
    if (r < CV_S2) { d.W = p.in[I_WBB] + (size_t)l * 768 * D; d.koff = YOFF_B; return d; } r -= CV_S2; d.kb = r / (D / 64); d.nb = r % (D / 64);
    if (r < CV_S1) { d.W = p.in[I_WBC] + (size_t)l * 512 * D; d.koff = YOFF_C; return d; } r -= CV_S1; d.kb = r / (D / 64); d.nb = r % (D / 64);
    if (r < CV_S1) { d.W = p.in[I_WBD] + (size_t)l * 512 * D; d.koff = YOFF_D; return d; } r -= CV_S1; d.kb = r / (D / 64); d.nb = r % (D / 64);
    if (r < CV_S5) { d.W = p.in[I_WOUT] + (size_t)l * D * D; d.WT = WSP(bf16, WS_WOUT); d.ldk = D; d.koff = 0; return d; } r -= CV_S5;
    if (r < 2 * CV_S6) { const int up = r >= CV_S6; if (up) r -= CV_S6; const int e = r / ((D / 64) * (FF / 64)), q = r % ((D / 64) * (FF / 64));
        d.W = p.in[up ? I_EWU : I_EWG] + ((size_t)l * NE + e) * D * FF; d.WT = WSP(bf16, WS_WGU) + (size_t)e * 2 * FF * D; d.ldw = FF; d.N = FF; d.drow0 = up; d.rstride = 2; d.kb = q / (FF / 64); d.nb = q % (FF / 64); d.ldk = D; d.koff = 0; return d; } r -= 2 * CV_S6;
    { const int e = r / ((FF / 64) * (D / 64)), q = r % ((FF / 64) * (D / 64));
      d.W = p.in[I_EWD] + ((size_t)l * NE + e) * FF * D; d.WT = WSP(bf16, WS_WDN) + (size_t)e * D * FF; d.ldw = D; d.N = D; d.drow0 = 0; d.rstride = 1; d.kb = q / (D / 64); d.nb = q % (D / 64); d.ldk = FF; d.koff = 0; }
    return d;
}
__device__ __forceinline__ void conv_weights(KPR p, int l, LAS unsigned char* lds, int gw, int NGW, int lane, int wave) {
    LAS float* scr = (LAS float*)(lds + wave * 17408);
    if (gw < CV_TOT) {
        f32x4 cur[16], nxt[16];
        TrDesc dc = conv_desc(p, l, gw); tr_load(dc, lane, cur);
        for (int it = gw; it < CV_TOT; it += NGW) {
            const int ni = it + NGW; const bool hn = ni < CV_TOT; TrDesc dn = dc;
            if (hn) { dn = conv_desc(p, l, ni); tr_load(dn, lane, nxt); }
            tr_store(dc, scr, lane, cur);
            if (hn) { dc = dn;
#pragma unroll
                for (int i = 0; i < 16; ++i) cur[i] = nxt[i]; }
        }
    }
    { const int nchunks = (NP - PROJ) * D / 8; unsigned zz_ = 0u; OPAQUE_V(zz_); v4u z; z.x = zz_; z.y = zz_; z.z = zz_; z.w = zz_;
      for (int i = gw * 64 + lane; i < nchunks; i += NGW * 64) *(v4u*)(WSP(bf16, WS_WIN) + (size_t)PROJ * D + (size_t)i * 8) = z; }
}

__device__ __forceinline__ void phase_mod(KPR p, LAS unsigned char* lds, int tid, int bid, int G) {
    LAS float* red = (LAS float*)lds;
    const int lane = tid & 63, kg = tid >> 6;
    constexpr int NCB = 6 * D / 64;
    for (int it = bid; it < DEPTH * NCB; it += G) {
        const int l = it / NCB, col = (it % NCB) * 64 + lane;
        const float* W = p.in[I_WMOD] + (size_t)l * D * 6 * D;
        float a0 = 0.f, a1 = 0.f;
        for (int k0 = kg * (D / 8); k0 < (kg + 1) * (D / 8); k0 += 16) {
            float w[16];
#pragma unroll
            for (int j = 0; j < 16; ++j) w[j] = W[(size_t)(k0 + j) * 6 * D + col];
#pragma unroll
            for (int j = 0; j < 16; ++j) { a0 += siluf_(p.in[I_C][k0 + j]) * w[j]; a1 += siluf_(p.in[I_CCTX][k0 + j]) * w[j]; } }
        red[(kg * 64 + lane) * 2 + 0] = a0; red[(kg * 64 + lane) * 2 + 1] = a1;
        __syncthreads();
        if (tid < 64) { float s0 = 0.f, s1 = 0.f;
            for (int q = 0; q < 8; ++q) { s0 += red[(q * 64 + lane) * 2]; s1 += red[(q * 64 + lane) * 2 + 1]; }
            const float b = p.in[I_BMOD][(size_t)l * 6 * D + col];
            WSP(float, WS_MODV)[(size_t)(l * 2 + 0) * 6 * D + col] = s0 + b; WSP(float, WS_MODV)[(size_t)(l * 2 + 1) * 6 * D + col] = s1 + b; }
        __syncthreads();
    }
}
__device__ __forceinline__ void phase_u0(KPR p, int gw, int NGW, int lane) {
    for (int t = gw; t < MT; t += NGW) {
        const int which = t < SEQ ? 0 : 1;
        const float* src = t < SEQ ? p.in[I_X] + (size_t)t * D : p.in[I_CTX] + (size_t)(t - SEQ) * D;
        float* h = hrow(p, t); const float* sh = modv(p, 0, which, 0); const float* sc = modv(p, 0, which, 1);
        bf16* u = WSP(bf16, WS_U) + (size_t)t * D;
#pragma unroll
        for (int j = 0; j < D / 256; ++j) { const int c = 4 * lane + 256 * j;
            const f32x4 x = *(const f32x4*)(src + c), s = *(const f32x4*)(sh + c), q = *(const f32x4*)(sc + c);
            *(f32x4*)(h + c) = x;
            v2u w; w.x = pk2(x[0] * (1.f + q[0]) + s[0], x[1] * (1.f + q[1]) + s[1]); w.y = pk2(x[2] * (1.f + q[2]) + s[2], x[3] * (1.f + q[3]) + s[3]);
            *(v2u*)(u + c) = w; }
    }
}

constexpr int C1_RB = ROWS >= 64 ? 64 : ROWS, C1_NRB = ROWS / C1_RB, C1_LAT = GRID_W * C1_NRB, C1_IN = C1_RB + CONF_K - 1, C1_INMAX = 64 + CONF_K - 1;
static_assert(ROWS % C1_RB == 0 && C1_RB % 8 == 0 && C1_INMAX * 1024 + CONF_K * CONF_D * 4 <= 163840 - 256 && CTX % 64 == 0 && CONF_K == 31 && CONF_D == 512, "c1 geometry");
__device__ __forceinline__ void c1_conformer(KPR p, int l, LAS unsigned char* lds, int idx, int tid) {
    const bf16* P = WSP(bf16, WS_P);
    const int lane = tid & 63, wave = tid >> 6;
    const int cg = tid & 63, tg = tid >> 6;
    const bool isctx = idx >= C1_LAT;
    LAS float* tile = (LAS float*)lds;
    LAS bf16* inb = (LAS bf16*)lds;
    LAS float* wsm = (LAS float*)(lds + C1_INMAX * 1024);
    const int gc = idx % GRID_W, rb = idx / GRID_W;
    const int RB = isctx ? 64 : C1_RB, NIN = RB + CONF_K - 1, rlim = isctx ? CTX : ROWS;
    const int rbase = isctx ? (idx - C1_LAT) * 64 : rb * C1_RB, r0 = rbase - 15;
    float acc[8][8];
    {
        { constexpr int NL = (C1_INMAX + NWAVES - 1) / NWAVES, NLH = (NL + 1) / 2;
#pragma unroll 1
          for (int q0 = 0; q0 < NL; q0 += NLH) { v4u tmp[NLH];
#pragma unroll
            for (int q = 0; q < NLH; ++q) { const int i = wave + NWAVES * (q0 + q), r = r0 + i; unsigned zz_ = 0u; OPAQUE_V(zz_); tmp[q].x = zz_; tmp[q].y = zz_; tmp[q].z = zz_; tmp[q].w = zz_;
                if (i < NIN && r >= 0 && r < rlim) { const size_t tok = isctx ? (size_t)(SEQ + r) : (size_t)r * GRID_W + gc; tmp[q] = *(const v4u*)(P + tok * NP + 8 * lane); } }
#pragma unroll
            for (int q = 0; q < NLH; ++q) { const int i = wave + NWAVES * (q0 + q); if (i < NIN) *(LAS v4u*)(inb + i * 512 + 8 * lane) = tmp[q]; } } }
        { constexpr int NW4 = CONF_K * CONF_D / 4, NQ = (NW4 + NTHR - 1) / NTHR, NQH = (NQ + 1) / 2; const float* cwl = p.in[I_CDWW] + (size_t)l * CONF_K * CONF_D;
#pragma unroll 1
          for (int q0 = 0; q0 < NQ; q0 += NQH) { f32x4 tw[NQH];
#pragma unroll
            for (int q = 0; q < NQH; ++q) { const int i4 = tid + NTHR * (q0 + q); tw[q] = *(const f32x4*)(cwl + 4 * (i4 < NW4 ? i4 : NW4 - 1)); }
#pragma unroll
            for (int q = 0; q < NQH; ++q) { const int i4 = tid + NTHR * (q0 + q); if (i4 < NW4) *(LAS f32x4*)(wsm + 4 * i4) = tw[q]; } } }
        __syncthreads();
#pragma unroll
        for (int a = 0; a < 8; ++a)
#pragma unroll
            for (int b = 0; b < 8; ++b) acc[a][b] = 0.f;
        if (8 * tg < RB) {
            float win[8][8];
#pragma unroll
            for (int a = 0; a < 8; ++a) unpack8(*(const LAS v4u*)(inb + (8 * tg + a) * 512 + 8 * cg), win[a]);
#pragma unroll 1
            for (int j0 = 0; j0 < 32; j0 += 8) {
#pragma unroll
                for (int jj = 0; jj < 8; ++jj) { const int j = j0 + jj, jc = j < CONF_K ? j : CONF_K - 1; const float m = j < CONF_K ? 1.f : 0.f;
                    const f32x4 w0 = *(const LAS f32x4*)(wsm + jc * CONF_D + 8 * cg) * m, w1 = *(const LAS f32x4*)(wsm + jc * CONF_D + 8 * cg + 4) * m;
                    const float wj[8] = {w0[0], w0[1], w0[2], w0[3], w1[0], w1[1], w1[2], w1[3]};
#pragma unroll
                    for (int a = 0; a < 8; ++a)
#pragma unroll
                        for (int b = 0; b < 8; ++b) acc[a][b] += wj[b] * win[(a + jj) & 7][b];
                    int inext = 8 * tg + j + 8; inext = inext < NIN ? inext : NIN - 1;
#ifndef CPU_EMU
                    asm volatile("" : "+v"(inext), "+v"(acc[7][7]));
#endif
                    unpack8(*(const LAS v4u*)(inb + inext * 512 + 8 * cg), win[jj]); }
            }
        }
        __syncthreads();
    }
    { const f32x4 b0 = *(const f32x4*)(p.in[I_CDWB] + l * CONF_D + 8 * cg), b1 = *(const f32x4*)(p.in[I_CDWB] + l * CONF_D + 8 * cg + 4);
#pragma unroll
      for (int a = 0; a < 8; ++a) { f32x4 o0, o1;
#pragma unroll
          for (int b = 0; b < 4; ++b) { o0[b] = acc[a][b] + b0[b]; o1[b] = acc[a][4 + b] + b1[b]; }
          *(LAS f32x4*)(tile + (8 * tg + a) * 512 + 8 * cg) = o0; *(LAS f32x4*)(tile + (8 * tg + a) * 512 + 8 * cg + 4) = o1; } }
    __syncthreads();
    const int nrow = RB;
    const float* lg = p.in[I_CLNG] + l * CONF_D + 8 * lane; const float* lb = p.in[I_CLNB] + l * CONF_D + 8 * lane;
    for (int w = wave; w < nrow; w += NWAVES) {
        const int t = isctx ? SEQ + rbase + w : (rbase + w) * GRID_W + gc;
        const f32x4 a = *(const LAS f32x4*)(tile + w * 512 + 8 * lane), b = *(const LAS f32x4*)(tile + w * 512 + 8 * lane + 4);
        const float mean = wave_sum((a[0] + a[1]) + (a[2] + a[3]) + (b[0] + b[1]) + (b[2] + b[3])) * (1.f / 512.f);
        const f32x4 da = a - mean, db = b - mean;
        const float var = wave_sum((da[0] * da[0] + da[1] * da[1]) + (da[2] * da[2] + da[3] * da[3]) + (db[0] * db[0] + db[1] * db[1]) + (db[2] * db[2] + db[3] * db[3])) * (1.f / 512.f);
        const float rstd = frsq(var + LN_EPS);
        float y[8];
#pragma unroll
        for (int i = 0; i < 4; ++i) { y[i] = siluf_(da[i] * rstd * lg[i] + lb[i]); y[4 + i] = siluf_(db[i] * rstd * lg[4 + i] + lb[4 + i]); }
        v4u o; o.x = pk2(y[0], y[1]); o.y = pk2(y[2], y[3]); o.z = pk2(y[4], y[5]); o.w = pk2(y[6], y[7]);
        *(v4u*)(WSP(bf16, WS_Y) + (size_t)t * YK + YOFF_A + 8 * lane) = o;
    }
    __syncthreads();
}
__device__ __forceinline__ void load_rows10(const bf16* src, int t0, int tg, int lo, int hi, float (&x)[10][8]) {
#pragma unroll
    for (int a = 0; a < 10; ++a) { const int t = t0 + 8 * tg + a - 1;
        if (t >= lo && t < hi) unpack8(*(const v4u*)(src + (size_t)t * NP), x[a]); else {
#pragma unroll
            for (int q = 0; q < 8; ++q) x[a][q] = 0.f; } }
}
__device__ __forceinline__ void c2_wave(KPR p, int l, int tile, int cgrp, int lane) {
    const bf16* P = WSP(bf16, WS_P);
    const int t0 = tile * 64, lo = t0 < SEQ ? 0 : SEQ, hi = t0 < SEQ ? SEQ : MT, cg = lane & 7, tg = lane >> 3, ch = cgrp * 64 + 8 * cg;
    const float* w = p.in[I_SCCW] + (size_t)l * 3 * SC_D + ch;
    float w0[8], w1[8], w2[8];
#pragma unroll
    for (int b = 0; b < 8; ++b) { w0[b] = w[b]; w1[b] = w[SC_D + b]; w2[b] = w[2 * SC_D + b]; }
    float c[10][8], x[10][8];
    load_rows10(P + OFF_D + 512 + ch, t0, tg, lo, hi, c); load_rows10(P + OFF_D + 1024 + ch, t0, tg, lo, hi, x);
#pragma unroll
    for (int a = 0; a < 10; ++a)
#pragma unroll
        for (int b = 0; b < 8; ++b) c[a][b] *= x[a][b];
    v4u graw[8];
#pragma unroll
    for (int a = 0; a < 8; ++a) graw[a] = *(const v4u*)(P + (size_t)(t0 + 8 * tg + a) * NP + OFF_D + ch);
#pragma unroll
    for (int a = 0; a < 8; ++a) { const int t = t0 + 8 * tg + a; float g[8]; unpack8(graw[a], g);
        float y[8];
#pragma unroll
        for (int b = 0; b < 8; ++b) y[b] = g[b] * (w0[b] * c[a][b] + w1[b] * c[a + 1][b] + w2[b] * c[a + 2][b]);
        v4u o; o.x = pk2(y[0], y[1]); o.y = pk2(y[2], y[3]); o.z = pk2(y[4], y[5]); o.w = pk2(y[6], y[7]);
        *(v4u*)(WSP(bf16, WS_Y) + (size_t)t * YK + YOFF_D + ch) = o; }
}
template <int MODE> __device__ __forceinline__ void c34_load(KPR p, int tile, int cgrp, int lane, v4u (&raw)[10]) {
    const bf16* P = WSP(bf16, WS_P);
    const int t0 = tile * 64, lo = t0 < SEQ ? 0 : SEQ, hi = t0 < SEQ ? SEQ : MT, cg = lane & 7, tg = lane >> 3, ch = cgrp * 64 + 8 * cg;
    constexpr int POFF = MODE == 0 ? OFF_B + SSD_D : OFF_C;
#pragma unroll
    for (int a = 0; a < 10; ++a) { const int t = t0 + 8 * tg + a - 1; v4u z; z.x = 0u; z.y = 0u; z.z = 0u; z.w = 0u;
        raw[a] = (t >= lo && t < hi) ? *(const v4u*)(P + (size_t)t * NP + POFF + ch) : z; }
}
template <int MODE> __device__ __forceinline__ void c34_compute(KPR p, int l, LAS unsigned char* wlds, int tile, int cgrp, int lane, const v4u (&raw)[10]) {
    const int t0 = tile * 64, cg = lane & 7, tg = lane >> 3, ch = cgrp * 64 + 8 * cg;
    constexpr int NC = MODE == 0 ? XBC : 1536;
    const float* w = p.in[MODE == 0 ? I_SCW : I_HSW] + (size_t)l * 3 * NC + ch; const float* b = p.in[MODE == 0 ? I_SCB : I_HSB] + (size_t)l * NC + ch;
    float w0[8], w1[8], w2[8], bb[8];
#pragma unroll
    for (int q = 0; q < 8; ++q) { w0[q] = w[q]; w1[q] = w[NC + q]; w2[q] = w[2 * NC + q]; bb[q] = b[q]; }
    LAS bf16* tile_ = (LAS bf16*)wlds;
    const bool tr = (MODE == 1) || (cgrp < 20);
    float xp[8], xc_[8], xn[8];
    unpack8(raw[0], xp); unpack8(raw[1], xc_);
#pragma unroll
    for (int a = 0; a < 8; ++a) { unsigned short y[8]; unpack8(raw[a + 2], xn);
#pragma unroll
        for (int q = 0; q < 8; ++q) { float v = w0[q] * xp[q] + w1[q] * xc_[q] + w2[q] * xn[q] + bb[q]; if (MODE == 0) v = siluf_(v); y[q] = (unsigned short)f2bf(v); xp[q] = xc_[q]; xc_[q] = xn[q]; }
        if (tr) {
#pragma unroll
            for (int q = 0; q < 8; ++q) tile_[(8 * cg + q) * 72 + 8 * tg + a] = y[q]; }
        if (MODE == 0 && cgrp >= 12) { v4u o; o.x = y[0] | ((unsigned)y[1] << 16); o.y = y[2] | ((unsigned)y[3] << 16); o.z = y[4] | ((unsigned)y[5] << 16); o.w = y[6] | ((unsigned)y[7] << 16);
            *(v4u*)(WSP(bf16, WS_XC) + (size_t)(t0 + 8 * tg + a) * XBC + ch) = o; } }
    if (tr) {
        WAVE_SYNC();
        bf16* dst = WSP(bf16, MODE == 0 ? WS_XCT : WS_QT) + (size_t)(cgrp * 64) * MT + t0;
#pragma unroll
        for (int j = 0; j < 8; ++j) { const int q = lane + 64 * j, row = q >> 3, cc = q & 7; *(v4u*)(dst + (size_t)row * MT + 8 * cc) = *(const LAS v4u*)(tile_ + row * 72 + 8 * cc); }
        WAVE_SYNC();
    }
}
template <int MODE> __device__ __forceinline__ void c34_wave_loop(KPR p, int l, LAS unsigned char* wlds, int first, int nitems, int NGW, int lane) {
    constexpr int NCG = MODE == 0 ? 28 : 24;
    if (first >= nitems) return;
    v4u cur[10], nxt[10];
    c34_load<MODE>(p, first / NCG, first % NCG, lane, cur);
    for (int it = first; it < nitems; it += NGW) {
        const int ni = it + NGW; const bool hn = ni < nitems;
        if (hn) c34_load<MODE>(p, ni / NCG, ni % NCG, lane, nxt);
        c34_compute<MODE>(p, l, wlds, it / NCG, it % NCG, lane, cur);
        if (hn) {
#pragma unroll
            for (int a = 0; a < 10; ++a) cur[a] = nxt[a]; }
    }
}
__device__ __forceinline__ void c_dt_wave(KPR p, int l, int tile, int lane) {
    const bf16* src = WSP(bf16, WS_P) + (size_t)(tile * 64 + lane) * NP + OFF_B + SSD_D + XBC;
    const v4u r0 = *(const v4u*)src, r1 = *(const v4u*)(src + 8), r2 = *(const v4u*)(src + 16);
    float xa[8], xb[8], xc[8]; unpack8(r0, xa); unpack8(r1, xb); unpack8(r2, xc);
    const float* bias = p.in[I_SDTB] + l * 24; float* dst = WSP(float, WS_DT) + (size_t)(tile * 64 + lane) * 24;
#pragma unroll
    for (int h = 0; h < 3; ++h) { f32x4 o0, o1;
#pragma unroll
        for (int j = 0; j < 4; ++j) { const float x0 = (h == 0 ? xa[j] : (h == 1 ? xb[j] : xc[j])) + bias[8 * h + j], x1 = (h == 0 ? xa[4 + j] : (h == 1 ? xb[4 + j] : xc[4 + j])) + bias[8 * h + 4 + j];
            o0[j] = fmaxf(x0, 0.f) + flog(1.0f + __expf(-fabsf(x0))); o1[j] = fmaxf(x1, 0.f) + flog(1.0f + __expf(-fabsf(x1))); }
        *(f32x4*)(dst + 8 * h) = o0; *(f32x4*)(dst + 8 * h + 4) = o1; }
}
constexpr int CW_C2 = (MT / 64) * 8, CW_C3 = (MT / 64) * 28, CW_C4 = (MT / 64) * 24, CW_DT = MT / 64, CW_ITEMS = CW_C3 + CW_C4 + CW_C2 + CW_DT;
__device__ __forceinline__ void c_wave_items(KPR p, int l, LAS unsigned char* lds, int gw, int NGW, int lane, int wave, int last) {
    LAS unsigned char* wlds = lds + wave * 16384;
    const int ntl = last ? SEQ / 64 : MT / 64;
    c34_wave_loop<0>(p, l, wlds, gw, CW_C3, NGW, lane);
    c34_wave_loop<1>(p, l, wlds, gw, ntl * 24, NGW, lane);
    for (int it = gw; it < ntl * 8; it += NGW) c2_wave(p, l, it / 8, it % 8, lane);
    for (int it = gw; it < CW_DT; it += NGW) c_dt_wave(p, l, it, lane);
}
__device__ __forceinline__ float sin_rad(float x) { float s_, c_; sincos_turns(x * 0.15915494309189535f, s_, c_); return s_; }
__device__ __forceinline__ void c5_item(KPR p, int l, LAS unsigned char* lds, int idx, int tid) {
    LAS float* ws = (LAS float*)lds;
    LAS float* h1s = (LAS float*)(lds + 32768);
    const int t = idx * 64 + (tid >> 3), oq = tid & 7, pl = tid >> 3;
    const bool isctx = t >= SEQ; const int n = isctx ? CTX : SEQ, tl = isctx ? t - SEQ : t;
    const float t01 = (float)tl * frcp((float)(n - 1)), tn = (float)tl * (1.0f / (float)n);
    float a[8];
#pragma unroll
    for (int i = 0; i < 8; ++i) a[i] = ws[2112 + 8 * oq + i];
#pragma unroll 1
    for (int f = 0; f < 33; ++f) {
        float ft;
        if (f == 0) ft = t01;
        else { const int bi = (f - 1) & 15; const float band = 1e-4f + (15.0f - 1e-4f) * (float)bi * (1.0f / 15.0f); float sn_, cs_; sincos_turns(band * tn, sn_, cs_); ft = (f <= 16) ? cs_ : -sn_; }
        const f32x4 w0 = *(const LAS f32x4*)(ws + f * 64 + 8 * oq), w1 = *(const LAS f32x4*)(ws + f * 64 + 8 * oq + 4);
#pragma unroll
        for (int i = 0; i < 4; ++i) { a[i] += ft * w0[i]; a[4 + i] += ft * w1[i]; }
    }
#pragma unroll
    for (int i = 0; i < 8; ++i) h1s[(8 * oq + i) * 64 + pl] = sin_rad(ws[2176 + 4096 + 64 + 8 * oq + i] * a[i]);
    WAVE_SYNC();
#pragma unroll
    for (int i = 0; i < 8; ++i) a[i] = ws[2176 + 4096 + 8 * oq + i];
#pragma unroll 4
    for (int j = 0; j < 64; ++j) { const float h = h1s[j * 64 + pl];
        const f32x4 w0 = *(const LAS f32x4*)(ws + 2176 + j * 64 + 8 * oq), w1 = *(const LAS f32x4*)(ws + 2176 + j * 64 + 8 * oq + 4);
#pragma unroll
        for (int i = 0; i < 4; ++i) { a[i] += h * w0[i]; a[4 + i] += h * w1[i]; } }
    f32x4 o0, o1;
#pragma unroll
    for (int i = 0; i < 4; ++i) { o0[i] = sin_rad(ws[2176 + 4096 + 128 + 8 * oq + i] * a[i]); o1[i] = sin_rad(ws[2176 + 4096 + 128 + 8 * oq + 4 + i] * a[4 + i]); }
    float* o = WSP(float, WS_HID2) + (size_t)t * 64 + 8 * oq;
    *(f32x4*)o = o0; *(f32x4*)(o + 4) = o1;
    WAVE_SYNC();
}
__device__ __forceinline__ void c5_load_weights(KPR p, int l, LAS unsigned char* lds, int tid) {
    LAS float* ws = (LAS float*)lds;
    const float* w1g = p.in[I_HW1] + (size_t)l * 33 * 64; const float* w2g = p.in[I_HW2] + (size_t)l * 64 * 64;
    { float t1[5], t2[8];
#pragma unroll
      for (int j = 0; j < 5; ++j) { const int i = tid + NTHR * j; t1[j] = (i < 33 * 64) ? w1g[i] : 0.f; }
#pragma unroll
      for (int j = 0; j < 8; ++j) t2[j] = w2g[tid + NTHR * j];
#pragma unroll
      for (int j = 0; j < 5; ++j) { const int i = tid + NTHR * j; if (i < 33 * 64) ws[i] = t1[j]; }
#pragma unroll
      for (int j = 0; j < 8; ++j) ws[2176 + tid + NTHR * j] = t2[j]; }
    for (int i = tid; i < 64; i += NTHR) { ws[2112 + i] = p.in[I_HB1][l * 64 + i]; ws[2176 + 4096 + i] = p.in[I_HB2][l * 64 + i]; }
    for (int i = tid; i < 128; i += NTHR) ws[2176 + 4096 + 64 + i] = p.in[I_HFREQ][l * 128 + i];
}
constexpr int C1_ITEMS = C1_LAT + CTX / 64, C23_ITEMS = MT / 64, C4_ITEMS = MT / 64, C5_ITEMS = MT / 64, C6_ITEMS = 8 * (MT / 256), C_ITEMS = C6_ITEMS + C1_ITEMS;

__device__ __forceinline__ float a_rate_of(KPR p, int l, int d, int h) { return -__expf(p.in[I_SALOG][(l * 2 + d) * NH + h]); }
__device__ __forceinline__ bf16x8 as_bf16x8(v4u v) { return __builtin_bit_cast(bf16x8, v); }
__device__ __forceinline__ void d_ssd_item(KPR p, int l, LAS unsigned char* lds, int idx, int e_only, int tid) {
    const int c = idx / NG, g = idx % NG, t0 = c * CHUNK, lane = tid & 63, wave = tid >> 6;
    const bf16* XCT = WSP(bf16, WS_XCT); const float* DTp = WSP(float, WS_DT);
    LAS bf16* XT = (LAS bf16*)lds;
    LAS bf16* BT = (LAS bf16*)(lds + 52224);
    LAS float* Wv = (LAS float*)(lds + 87040);
    __syncthreads();
    { v4u tl[10];
#pragma unroll
      for (int j = 0; j < 10; ++j) { const int q = tid + NTHR * j, row = q >> 4, cc = (q & 15) * 8; const int src = row < 192 ? g * 192 + row : 768 + g * NS + (row - 192);
          tl[j] = *(const v4u*)(XCT + (size_t)src * MT + t0 + cc); }
#pragma unroll
      for (int j = 0; j < 10; ++j) { const int q = tid + NTHR * j, row = q >> 4, cc = (q & 15) * 8; *(LAS v4u*)((row < 192 ? XT + row * 136 : BT + (row - 192) * 136) + cc) = tl[j]; } }
    if (wave < 6) {
        const int d = wave / 3, e = wave % 3, h = g * HPG + e; const float ar = a_rate_of(p, l, d, h);
        const int l0 = 2 * lane;
        const float dt0 = DTp[(size_t)(t0 + l0) * 24 + d * NH + h], dt1 = DTp[(size_t)(t0 + l0 + 1) * 24 + d * NH + h];
        const float ld0 = dt0 * ar, ld1 = dt1 * ar;
        float x = ld0 + ld1;
#pragma unroll
        for (int o = 1; o < 64; o <<= 1) { const float y = __shfl_up(x, o); if (lane >= o) x += y; }
        const float tot = __shfl(x, 63);
        float A1 = x, A0 = x - ld1;
        if (d == 1) { A0 = tot - A0 + ld0; A1 = tot - A1 + ld1; }
        float* ac = WSP(float, WS_ACUM) + (size_t)(d * NH + h) * MT + t0 + l0; ac[0] = A0; ac[1] = A1;
        Wv[wave * 128 + l0] = dt0 * __expf(tot - A0); Wv[wave * 128 + l0 + 1] = dt1 * __expf(tot - A1);
        if (lane == 0) WSP(float, WS_CDEC)[(size_t)(d * NCH + c) * NH + h] = __expf(tot);
    }
    __syncthreads();
    const int nb = wave & 3, pb = wave >> 2, r = lane & 31, hh = lane >> 5;
    for (int combo = 0; combo < 6; ++combo) {
        const int d = combo / 3, e = combo % 3, h = g * HPG + e;
        f32x16 acc;
#pragma unroll
        for (int i = 0; i < 16; ++i) acc[i] = 0.f;
#pragma unroll
        for (int ks = 0; ks < 8; ++ks) {
            const int lb_ = 16 * ks + 8 * hh;
            float xv[8]; unpack8(*(const LAS v4u*)(XT + (e * 64 + 32 * pb + r) * 136 + lb_), xv);
            const f32x4 w0 = *(const LAS f32x4*)(Wv + combo * 128 + lb_), w1 = *(const LAS f32x4*)(Wv + combo * 128 + lb_ + 4);
            v4u av; av.x = pk2(xv[0] * w0[0], xv[1] * w0[1]); av.y = pk2(xv[2] * w0[2], xv[3] * w0[3]); av.z = pk2(xv[4] * w1[0], xv[5] * w1[1]); av.w = pk2(xv[6] * w1[2], xv[7] * w1[3]);
            const bf16x8 bfrag = as_bf16x8(*(const LAS v4u*)(BT + (32 * nb + r) * 136 + lb_));
            acc = MFMA32(as_bf16x8(av), bfrag, acc);
        }
        float* st = WSP(float, WS_ST) + ((size_t)(d * NCH + c) * NH + h) * HD * NS + (size_t)(32 * pb) * NS + 32 * nb + r;
#pragma unroll
        for (int i = 0; i < 16; ++i) st[(size_t)((i & 3) + 8 * (i >> 2) + 4 * hh) * NS] = acc[i];
    }
    __syncthreads();
}
__device__ __forceinline__ int scan_chunk(int d, int i) {
    if (i < NCH - NCH_LAT) return (d == 0) ? NCH_LAT + i : NCH - 1 - i;
    const int k = i - (NCH - NCH_LAT); return (d == 0) ? k : NCH_LAT - 1 - k;
}
__device__ __forceinline__ void e_scan_item(KPR p, int idx, int tid) {
    const int el = idx * NTHR + tid;
    const int d = el / (NH * HD * NS), h = (el / (HD * NS)) % NH, pn = el % (HD * NS);
    const float* st = WSP(float, WS_ST); const float* cd = WSP(float, WS_CDEC); bf16* hb = WSP(bf16, WS_HIN);
    float hs = 0.f;
    constexpr int BATCH = 10; static_assert(NCH % BATCH == 0, "scan batch");
    for (int i0 = 0; i0 < NCH; i0 += BATCH) {
        float v[BATCH], dc[BATCH];
#pragma unroll
        for (int j = 0; j < BATCH; ++j) { const int c = scan_chunk(d, i0 + j); v[j] = st[((size_t)(d * NCH + c) * NH + h) * HD * NS + pn]; dc[j] = cd[(size_t)(d * NCH + c) * NH + h]; }
#pragma unroll
        for (int j = 0; j < BATCH; ++j) { const int c = scan_chunk(d, i0 + j); hb[((size_t)(d * NCH + c) * NH + h) * HD * NS + pn] = (bf16)f2bf(hs); hs = dc[j] * hs + v[j]; }
    }
}
__device__ __forceinline__ void f_ssd_item(KPR p, int l, LAS unsigned char* lds, int c, int g, int e0, int e1, int tid) {
    const int t0 = c * CHUNK, lane = tid & 63, wave = tid >> 6;
    const bf16* XCp = WSP(bf16, WS_XC); const bf16* XCT = WSP(bf16, WS_XCT); const float* DTp = WSP(float, WS_DT); const bf16* P = WSP(bf16, WS_P);
    LAS bf16* Bm = (LAS bf16*)lds;
    LAS bf16* Cm = (LAS bf16*)(lds + 34816);
    LAS bf16* XT = (LAS bf16*)(lds + 69632);
    LAS bf16* Hs = (LAS bf16*)(lds + 121856);
    LAS float* Ac = (LAS float*)(lds + 139264);
    LAS float* Dv = Ac + 768;
    const int ncombo = 2 * (e1 - e0);
    const bf16* hbase = WSP(bf16, WS_HIN);
    v4u hreg[2];
#define FSSD_HIN_LOAD(cc) do { const bf16* hin_ = hbase + ((size_t)(((cc) & 1) * NCH + c) * NH + g * HPG + e0 + ((cc) >> 1)) * HD * NS; _Pragma("unroll") for (int j_ = 0; j_ < 2; ++j_) { const int q_ = tid + NTHR * j_; hreg[j_] = *(const v4u*)(hin_ + (size_t)(q_ >> 4) * NS + (q_ & 15) * 8); } } while (0)
    FSSD_HIN_LOAD(0);
    __syncthreads();
    { v4u tb[4], tc[4], tx[6]; float ta[2], td[2];
#pragma unroll
      for (int j = 0; j < 4; ++j) { const int q = tid + NTHR * j, row = q >> 4, cc = (q & 15) * 8;
          tb[j] = *(const v4u*)(XCp + (size_t)(t0 + row) * XBC + SSD_D + g * NS + cc); tc[j] = *(const v4u*)(XCp + (size_t)(t0 + row) * XBC + SSD_D + NG * NS + g * NS + cc); }
#pragma unroll
      for (int j = 0; j < 6; ++j) { const int q = tid + NTHR * j, row = q >> 4, cc = (q & 15) * 8; tx[j] = *(const v4u*)(XCT + (size_t)(g * 192 + row) * MT + t0 + cc); }
#pragma unroll
      for (int j = 0; j < 2; ++j) { const int q = tid + NTHR * j; ta[j] = 0.f; td[j] = 0.f; if (q < 768) { const int combo = q >> 7, rr = q & 127, d = combo / 3, h = g * HPG + combo % 3;
          ta[j] = WSP(float, WS_ACUM)[(size_t)(d * NH + h) * MT + t0 + rr]; td[j] = DTp[(size_t)(t0 + rr) * 24 + d * NH + h]; } }
#pragma unroll
      for (int j = 0; j < 4; ++j) { const int q = tid + NTHR * j, row = q >> 4, cc = (q & 15) * 8; *(LAS v4u*)(Bm + row * 136 + cc) = tb[j]; *(LAS v4u*)(Cm + row * 136 + cc) = tc[j]; }
#pragma unroll
      for (int j = 0; j < 6; ++j) { const int q = tid + NTHR * j, row = q >> 4, cc = (q & 15) * 8; *(LAS v4u*)(XT + row * 136 + cc) = tx[j]; }
#pragma unroll
      for (int j = 0; j < 2; ++j) { const int q = tid + NTHR * j; if (q < 768) { Ac[q] = ta[j]; Dv[q] = td[j]; } } }
    __syncthreads();
    const int lb = wave & 3, ph = wave >> 2, r = lane & 31, hh = lane >> 5;
    f32x16 T[4];
#pragma unroll
    for (int sb = 0; sb < 4; ++sb)
#pragma unroll
        for (int i = 0; i < 16; ++i) T[sb][i] = 0.f;
#pragma unroll 2
    for (int ks = 0; ks < 8; ++ks) {
        const bf16x8 cf = as_bf16x8(*(const LAS v4u*)(Cm + (32 * lb + r) * 136 + 16 * ks + 8 * hh));
#pragma unroll
        for (int sb = 0; sb < 4; ++sb) T[sb] = MFMA32(as_bf16x8(*(const LAS v4u*)(Bm + (32 * sb + r) * 136 + 16 * ks + 8 * hh)), cf, T[sb]);
    }
    f32x16 Y;
    for (int cc = 0; cc < ncombo; ++cc) {
        const int e = e0 + (cc >> 1), d = cc & 1, h = g * HPG + e, combo = d * 3 + e;
        if (d == 0) {
#pragma unroll
            for (int i = 0; i < 16; ++i) Y[i] = 0.f;
        }
        __syncthreads();
#pragma unroll
        for (int j = 0; j < 2; ++j) { const int q = tid + NTHR * j; *(LAS v4u*)(Hs + (q >> 4) * 136 + (q & 15) * 8) = hreg[j]; }
        __syncthreads();
        if (cc + 1 < ncombo) FSSD_HIN_LOAD(cc + 1);
        const float Al = Ac[combo * 128 + 32 * lb + r]; const float eal = __expf(Al);
#pragma unroll 4
        for (int ks = 0; ks < 8; ++ks) { float cv[8]; unpack8(*(const LAS v4u*)(Cm + (32 * lb + r) * 136 + 16 * ks + 8 * hh), cv);
            v4u av; av.x = pk2(cv[0] * eal, cv[1] * eal); av.y = pk2(cv[2] * eal, cv[3] * eal); av.z = pk2(cv[4] * eal, cv[5] * eal); av.w = pk2(cv[6] * eal, cv[7] * eal);
            Y = MFMA32(as_bf16x8(av), as_bf16x8(*(const LAS v4u*)(Hs + (32 * ph + r) * 136 + 16 * ks + 8 * hh)), Y); }
#pragma unroll
        for (int sb = 0; sb < 4; ++sb) {
            if (d == 0 ? (sb > lb) : (sb < lb)) continue;
            const LAS bf16* xrow = XT + (e * 64 + 32 * ph + r) * 136 + 32 * sb + 4 * hh;
#pragma unroll
            for (int sp = 0; sp < 2; ++sp) {
                float tm[8];
                const int sbase = 32 * sb + 16 * sp + 4 * hh;
                const f32x4 a0 = *(const LAS f32x4*)(Ac + combo * 128 + sbase), a1 = *(const LAS f32x4*)(Ac + combo * 128 + sbase + 8);
                const f32x4 d0 = *(const LAS f32x4*)(Dv + combo * 128 + sbase), d1 = *(const LAS f32x4*)(Dv + combo * 128 + sbase + 8);
#pragma unroll
                for (int j = 0; j < 8; ++j) { const int i = 8 * sp + j, sl = (i & 3) + 8 * (i >> 2) + 4 * hh;
                    const bool valid = (sb != lb) || (d == 0 ? (sl <= r) : (sl >= r));
                    const float as = (j < 4) ? a0[j & 3] : a1[j & 3], ds = (j < 4) ? d0[j & 3] : d1[j & 3];
                    tm[j] = valid ? T[sb][i] * __expf(Al - as) * ds : 0.f; }
                v4u av; av.x = pk2(tm[0], tm[1]); av.y = pk2(tm[2], tm[3]); av.z = pk2(tm[4], tm[5]); av.w = pk2(tm[6], tm[7]);
                const v2u x0 = *(const LAS v2u*)(xrow + 16 * sp), x1 = *(const LAS v2u*)(xrow + 16 * sp + 8);
                v4u bv; bv.x = x0.x; bv.y = x0.y; bv.z = x1.x; bv.w = x1.y;
                Y = MFMA32(as_bf16x8(av), as_bf16x8(bv), Y);
                SCHED_FENCE();
            }
            SCHED_FENCE();
        }
        if (d == 1) {
            int t0v = t0; OPAQUE_V(t0v);
            const float Dh = p.in[I_SD][l * NH + h];
            const int colg = h * HD + 32 * ph + r; const float ngv = p.in[I_SNG][l * SSD_D + colg];
            const LAS bf16* xrow = XT + (e * 64 + 32 * ph + r) * 136 + 32 * lb;
            float ssq[16]; unsigned short zv[16];
#pragma unroll
            for (int i = 0; i < 16; ++i) zv[i] = P[(size_t)(t0v + 32 * lb + (i & 3) + 8 * (i >> 2) + 4 * hh) * NP + OFF_B + colg];
            v2u xq[4];
#pragma unroll
            for (int q = 0; q < 4; ++q) xq[q] = *(const LAS v2u*)(xrow + 8 * q + 4 * hh);
#pragma unroll
            for (int i = 0; i < 16; ++i) { const int lr = (i & 3) + 8 * (i >> 2) + 4 * hh, t = t0v + 32 * lb + lr;
                const unsigned xw = (i & 2) ? xq[i >> 2].y : xq[i >> 2].x; const float xv_ = (i & 1) ? bfhi(xw) : bflo(xw);
                const float y = Y[i] + Dh * xv_;
                const float u = y * siluf_(bf2f(zv[i]));
                ssq[i] = u * u;
                WSP(bf16, WS_Y)[(size_t)t * YK + YOFF_B + colg] = (bf16)f2bf(u * ngv); }
#pragma unroll
            for (int i = 0; i < 16; ++i) { const float v = half_sum32(ssq[i]);
                if (r == 16) WSP(float, WS_SSQ)[(size_t)(t0v + 32 * lb + (i & 3) + 8 * (i >> 2) + 4 * hh) * 24 + (g * HPG + e) * 2 + ph] = v; }
        }
    }
#undef FSSD_HIN_LOAD
    __syncthreads();
}

#define HPAD(i) ((i) + ((i) >> 5))
__device__ __forceinline__ f32x2 cmul(f32x2 a, f32x2 b) { return (f32x2){a.x * b.x - a.y * b.y, a.x * b.y + a.y * b.x}; }
__device__ __forceinline__ f32x2 cconj(f32x2 a) { return (f32x2){a.x, -a.y}; }
template <int LR> __device__ __forceinline__ constexpr int brevn(int i) { int r = 0; for (int b = 0; b < LR; ++b) r |= ((i >> b) & 1) << (LR - 1 - b); return r; }
__device__ __forceinline__ constexpr float w32_cos(int e) {
    constexpr float t[16] = {1.0f, 0.9807852804032304f, 0.9238795325112867f, 0.8314696123025452f, 0.7071067811865476f, 0.5555702330196022f, 0.3826834323650898f, 0.19509032201612825f,
                             0.0f, -0.19509032201612825f, -0.3826834323650898f, -0.5555702330196022f, -0.7071067811865476f, -0.8314696123025452f, -0.9238795325112867f, -0.9807852804032304f};
    return t[e]; }
__device__ __forceinline__ constexpr float w32_sin(int e) {
    constexpr float t[16] = {0.0f, 0.19509032201612825f, 0.3826834323650898f, 0.5555702330196022f, 0.7071067811865476f, 0.8314696123025452f, 0.9238795325112867f, 0.9807852804032304f,
                             1.0f, 0.9807852804032304f, 0.9238795325112867f, 0.8314696123025452f, 0.7071067811865476f, 0.5555702330196022f, 0.3826834323650898f, 0.19509032201612825f};
    return t[e]; }
template <bool INV> __device__ __forceinline__ f32x2 mul_w32(f32x2 d, int e) {
    const float sg = INV ? -1.f : 1.f;
    if (e == 0) return d;
    if (e == 8) return (f32x2){sg * d.y, -sg * d.x};
    if (e == 4) return (f32x2){(d.x + sg * d.y) * 0.7071067811865476f, (d.y - sg * d.x) * 0.7071067811865476f};
    if (e == 12) return (f32x2){(-d.x + sg * d.y) * 0.7071067811865476f, (-d.y - sg * d.x) * 0.7071067811865476f};
    const float c = w32_cos(e), sn = w32_sin(e);
    return (f32x2){d.x * c + sg * d.y * sn, d.y * c - sg * d.x * sn};
}
template <int R, bool INV> __device__ __forceinline__ void dft_r(f32x2 (&v)[R]) {
    constexpr int LR = (R == 32) ? 5 : 4;
#pragma unroll
    for (int hs = LR - 1; hs >= 0; --hs) { const int half = 1 << hs;
#pragma unroll
        for (int b = 0; b < R / 2; ++b) { const int j = b & (half - 1), i0 = ((b >> hs) << (hs + 1)) + j, i1 = i0 + half;
            const f32x2 a = v[i0], c = v[i1]; v[i0] = a + c; v[i1] = mul_w32<INV>(a - c, (j << (LR - 1 - hs)) * (32 / R)); }
        if (R == 32) SCHED_FENCE(); }
}
template <int n, int P> struct FftPlan { static constexpr int R = (n == 16384) ? (P < 2 ? 32 : (P == 2 ? 16 : 1)) : (n == 1024 ? (P < 2 ? 32 : 1) : (n == 256 ? (P < 2 ? 16 : 1) : 0)); };
template <int n, int P> struct FftM { static constexpr int value = FftM<n, P - 1>::value / FftPlan<n, P>::R; };
template <int n> struct FftM<n, -1> { static constexpr int value = n; };
static_assert(FftM<16384, 2>::value == 1 && FftM<256, 1>::value == 1, "fft plan");
template <int n> __device__ __forceinline__ int fft_pos(int k) {
    int pos = 0;
    if constexpr (FftPlan<n, 0>::R > 1) { constexpr int R = FftPlan<n, 0>::R, M = FftM<n, 0>::value; pos += (k % R) * M; k /= R; }
    if constexpr (FftPlan<n, 1>::R > 1) { constexpr int R = FftPlan<n, 1>::R, M = FftM<n, 1>::value; pos += (k % R) * M; k /= R; }
    if constexpr (FftPlan<n, 2>::R > 1) { constexpr int R = FftPlan<n, 2>::R, M = FftM<n, 2>::value; pos += (k % R) * M; k /= R; }
    return pos;
}
template <int n, int P, bool INV> __device__ __forceinline__ void fft_pass(LAS f32x2* xc, int tid) {
    constexpr int R = FftPlan<n, P>::R, M = FftM<n, P>::value, LR = (R == 32) ? 5 : 4, NB = n / R;
    constexpr int lm = (M == 1) ? 0 : (M == 16 ? 4 : (M == 32 ? 5 : (M == 512 ? 9 : (M == 1024 ? 10 : -1))));
    static_assert(lm >= 0 && (1 << lm) == M, "fft pass geometry");
#pragma unroll 1
    for (int uu = 0; uu < (NB + NTHR - 1) / NTHR; ++uu) { const int u = tid + uu * NTHR; if (u >= NB) continue; const int b = u & (M - 1), base = ((u >> lm) << (lm + LR)) + b;
        f32x2 v[R];
        const int hb = HPAD(base);
#define FOFF(S) ((S) * M + (((S) * M) >> 5))
        const float ang1 = (float)b * (1.0f / (float)(R * M));
        if constexpr (!INV) {
#pragma unroll
            for (int a = 0; a < R; ++a) v[a] = xc[hb + FOFF(a)];
            dft_r<R, false>(v);
            float ag = ang1;
#pragma unroll
            for (int i = 0; i < R; ++i) { const int s_ = brevn<LR>(i); f32x2 y = v[i];
                if ((i & 7) == 0) OPAQUE_V(ag);
                if (s_ != 0 && M > 1) { float sn, cs; sincos_turns((float)s_ * ag, sn, cs); y = cmul(y, (f32x2){cs, -sn}); }
                xc[hb + FOFF(s_)] = y;
                if ((i & 7) == 7) SCHED_FENCE(); }
        } else {
            float ag = ang1;
#pragma unroll
            for (int s_ = 0; s_ < R; ++s_) { f32x2 y = xc[hb + FOFF(s_)];
                if ((s_ & 7) == 0) OPAQUE_V(ag);
                if (s_ != 0 && M > 1) { float sn, cs; sincos_turns((float)s_ * ag, sn, cs); y = cmul(y, (f32x2){cs, sn}); }
                v[s_] = y;
                if ((s_ & 7) == 7) SCHED_FENCE(); }
            dft_r<R, true>(v);
#pragma unroll
            for (int i = 0; i < R; ++i) xc[hb + FOFF(brevn<LR>(i))] = v[i];
        }
#undef FOFF
    }
    __syncthreads();
}
template <int n> __device__ __forceinline__ void fft_fwd(LAS f32x2* xc, int tid) {
    if constexpr (FftPlan<n, 0>::R > 1) fft_pass<n, 0, false>(xc, tid);
    if constexpr (FftPlan<n, 1>::R > 1) fft_pass<n, 1, false>(xc, tid);
    if constexpr (FftPlan<n, 2>::R > 1) fft_pass<n, 2, false>(xc, tid);
}
template <int n> __device__ __forceinline__ void fft_inv(LAS f32x2* xc, int tid) {
    if constexpr (FftPlan<n, 2>::R > 1) fft_pass<n, 2, true>(xc, tid);
    if constexpr (FftPlan<n, 1>::R > 1) fft_pass<n, 1, true>(xc, tid);
    if constexpr (FftPlan<n, 0>::R > 1) fft_pass<n, 0, true>(xc, tid);
}
template <int n> __device__ __forceinline__ void hyena_item(KPR p, int l, LAS unsigned char* lds, int c, int toff, f32x4* fscr, f32x2* zscr, int tid) {
    LAS float* xr = (LAS float*)lds; LAS f32x2* xc = (LAS f32x2*)lds;
    LAS float* aux = (LAS float*)(lds + 139264);
    const bf16* QT = WSP(bf16, WS_QT); const bf16* TAPS = WSP(bf16, WS_TAPS);
    const int lane = tid & 63, wave = tid >> 6;
    constexpr int NM = (n / 2 + NTHR - 1) / NTHR, CH = NM >= 8 ? 8 : NM, NK = NM + 1, CK = 4;
    for (int o = 0; o < 2; ++o) {
        const bf16* tf = TAPS + (size_t)(o * 1024 + c) * MT + toff; const bf16* tb = TAPS + (size_t)(o * 1024 + 512 + c) * MT + toff;
        __syncthreads();
        float asum = 0.f;
#pragma unroll 1
        for (int j0 = 0; j0 < NM; j0 += CH) {
            unsigned wf[CH], wb[CH];
#pragma unroll
            for (int j = 0; j < CH; ++j) { const int m = tid + NTHR * (j0 + j); wf[j] = 0u; wb[j] = 0u; if (m < n / 2) { wf[j] = *(const unsigned*)(tf + 2 * m); wb[j] = *(const unsigned*)(tb + 2 * m); } }
#pragma unroll
            for (int j = 0; j < CH; ++j) { const int m = tid + NTHR * (j0 + j); if (m < n / 2) {
                const float f0 = bflo(wf[j]), f1 = bfhi(wf[j]), b0 = bflo(wb[j]), b1 = bfhi(wb[j]);
                xc[HPAD(m)] = (f32x2){f0, f1}; asum += fabsf(f0) + fabsf(f1) + fabsf(b1) + (m > 0 ? fabsf(b0) : 0.f);
                if (m > 0) xr[2 * HPAD(n - m)] = b0; else xr[2 * HPAD(n / 2)] = 0.f;
                xr[2 * HPAD(n - m - 1) + 1] = b1; } }
        }
        asum = wave_sum(asum);
        if (lane == 0) aux[128 + wave] = asum;
        __syncthreads();
        float norm = 0.f;
#pragma unroll
        for (int i = 0; i < NWAVES; ++i) norm += aux[128 + i];
        fft_fwd<n>(xc, tid);
        const float scale = frcp(norm * (float)n);
#pragma unroll 2
        for (int j = 0; j < NK; ++j) { const int k = tid + NTHR * j; if (k <= n / 2) {
            const int pk = HPAD(fft_pos<n>(k)), pq = HPAD(fft_pos<n>((n - k) & (n - 1)));
            const f32x2 A = xc[pk], Bc = cconj(xc[pq]);
            const f32x2 E = (A + Bc) * 0.5f, Dd = A - Bc; const f32x2 O = (f32x2){Dd.y * 0.5f, -Dd.x * 0.5f};
            float sn, cs; sincos_turns((float)k * (0.5f / (float)n), sn, cs);
            const f32x2 wO = cmul((f32x2){cs, -sn}, O);
            const f32x2 Kk = (E + wO) * scale, Kn = cconj(E - wO) * scale;
            fscr[k] = (f32x4){Kk.x, Kk.y, Kn.x, Kn.y}; } }
        __syncthreads();
#pragma unroll 1
        for (int j0 = 0; j0 < NM; j0 += CH) {
            f32x2 zz[CH];
#pragma unroll
            for (int j = 0; j < CH; ++j) { const int m = tid + NTHR * (j0 + j); zz[j] = (f32x2){0.f, 0.f};
                if (m < n / 2) { if (o == 0) { const unsigned w = *(const unsigned*)(QT + (size_t)c * MT + toff + 2 * m); zz[j] = (f32x2){bflo(w), bfhi(w)}; } else zz[j] = zscr[m]; } }
#pragma unroll
            for (int j = 0; j < CH; ++j) { const int m = tid + NTHR * (j0 + j); if (m < n / 2) { xc[HPAD(m)] = zz[j]; xc[HPAD(m + n / 2)] = (f32x2){0.f, 0.f}; } }
        }
        __syncthreads();
        fft_fwd<n>(xc, tid);
#pragma unroll 1
        for (int j0 = 0; j0 < NK; j0 += CK) {
            f32x4 kfv[CK];
#pragma unroll
            for (int j = 0; j < CK; ++j) { const int k = tid + NTHR * (j0 + j); kfv[j] = (f32x4){0.f, 0.f, 0.f, 0.f}; if (j0 + j < NK && k <= n / 2) kfv[j] = fscr[k]; }
#pragma unroll
            for (int j = 0; j < CK; ++j) { const int k = tid + NTHR * (j0 + j); if (j0 + j < NK && k <= n / 2) {
                const int pk = HPAD(fft_pos<n>(k)), pq = HPAD(fft_pos<n>((n - k) & (n - 1)));
                const f32x2 A = xc[pk], Bc = cconj(xc[pq]);
                const f32x2 E = (A + Bc) * 0.5f, Dd = A - Bc; const f32x2 O = (f32x2){Dd.y * 0.5f, -Dd.x * 0.5f};
                float sn, cs; sincos_turns((float)k * (0.5f / (float)n), sn, cs);
                const f32x2 w = (f32x2){cs, -sn}; const f32x2 wO = cmul(w, O);
                const f32x4 kf = kfv[j];
                const f32x2 Yk = cmul(E + wO, (f32x2){kf[0], kf[1]}), Yn = cmul(cconj(E - wO), (f32x2){kf[2], kf[3]});
                const f32x2 Ey = (Yk + cconj(Yn)) * 0.5f; const f32x2 Oy = cmul((Yk - cconj(Yn)) * 0.5f, cconj(w));
                xc[pk] = (f32x2){Ey.x - Oy.y, Ey.y + Oy.x};
                if (pq != pk) xc[pq] = (f32x2){Ey.x + Oy.y, Oy.x - Ey.y};
            } }
        }
        __syncthreads();
        fft_inv<n>(xc, tid);
        const float bias = p.in[I_HBIAS][(size_t)(l * 2 + o) * HY_D + c];
#pragma unroll 1
        for (int j0 = 0; j0 < NM; j0 += CH) {
            unsigned gwv[CH]; f32x2 zz[CH];
#pragma unroll
            for (int j = 0; j < CH; ++j) { const int m = tid + NTHR * (j0 + j); gwv[j] = 0u; zz[j] = (f32x2){0.f, 0.f};
                if (m < n / 2) { gwv[j] = *(const unsigned*)(QT + (size_t)((o + 1) * 512 + c) * MT + toff + 2 * m);
                    if (o == 0) { const unsigned w = *(const unsigned*)(QT + (size_t)c * MT + toff + 2 * m); zz[j] = (f32x2){bflo(w), bfhi(w)}; } else zz[j] = zscr[m]; } }
#pragma unroll
            for (int j = 0; j < CH; ++j) { const int m = tid + NTHR * (j0 + j); if (m < n / 2) {
                const f32x2 cv = xc[HPAD(m)];
                const float r0 = bflo(gwv[j]) * (cv.x + bias * zz[j].x), r1 = bfhi(gwv[j]) * (cv.y + bias * zz[j].y);
                if (o == 0) zscr[m] = (f32x2){r0, r1};
                else *(unsigned*)(WSP(bf16, WS_YCT) + (size_t)c * MT + toff + 2 * m) = pk2(r0, r1); } }
        }
    }
    __syncthreads();
}
__device__ __forceinline__ void c6_taps_item(KPR p, int l, LAS unsigned char* lds, int idx, int tid) {
    const int fg = idx % 8, tt = idx / 8, lane = tid & 63, wave = tid >> 6, r = lane & 31, hh = lane >> 5;
    LAS bf16* Hs = (LAS bf16*)lds;
    LAS bf16* Ws = (LAS bf16*)(lds + 36864);
    const float* hid = WSP(float, WS_HID2) + (size_t)tt * 256 * 64; const float* w3 = p.in[I_HW3] + (size_t)l * 64 * HY_NF + fg * 256;
    __syncthreads();
    { f32x4 tl[8];
#pragma unroll
      for (int j = 0; j < 8; ++j) { const int q = tid + NTHR * j, row = q >> 4, c4 = (q & 15) * 4; tl[j] = *(const f32x4*)(hid + (size_t)row * 64 + c4); }
#pragma unroll
      for (int j = 0; j < 8; ++j) { const int q = tid + NTHR * j, row = q >> 4, c4 = (q & 15) * 4; v2u w; w.x = pk2(tl[j][0], tl[j][1]); w.y = pk2(tl[j][2], tl[j][3]); *(LAS v2u*)(Hs + row * 72 + c4) = w; } }
#pragma unroll 1
    for (int j0 = 0; j0 < 32; j0 += 8) { float tw[8];
#pragma unroll
        for (int j = 0; j < 8; ++j) { const int q = tid + NTHR * (j0 + j), i = q >> 8, f = q & 255; tw[j] = w3[(size_t)i * HY_NF + f]; }
#pragma unroll
        for (int j = 0; j < 8; ++j) { const int q = tid + NTHR * (j0 + j), i = q >> 8, f = q & 255; Ws[f * 72 + i] = (bf16)f2bf(tw[j]); } }
    __syncthreads();
    const int t0 = tt * 256, isctx = t0 >= SEQ, n = isctx ? CTX : SEQ, tl0 = isctx ? t0 - SEQ : t0;
    const float DMIN = -3.0701134573253945f, DMAX = -15.350567286626973f;
    bf16x8 af[4];
#pragma unroll
    for (int ks = 0; ks < 4; ++ks) af[ks] = as_bf16x8(*(const LAS v4u*)(Ws + (32 * wave + r) * 72 + 16 * ks + 8 * hh));
    float dl[16];
#pragma unroll
    for (int i = 0; i < 16; ++i) { const int f = fg * 256 + 32 * wave + (i & 3) + 8 * (i >> 2) + 4 * hh; dl[i] = fabsf(DMIN + (DMAX - DMIN) * ((float)f / 2047.0f)); }
    for (int tb = 0; tb < 8; ++tb) {
        f32x16 acc;
#pragma unroll
        for (int i = 0; i < 16; ++i) acc[i] = 0.f;
#pragma unroll
        for (int ks = 0; ks < 4; ++ks) acc = MFMA32(af[ks], as_bf16x8(*(const LAS v4u*)(Hs + (32 * tb + r) * 72 + 16 * ks + 8 * hh)), acc);
        const float t01 = (float)(tl0 + 32 * tb + r) * frcp((float)(n - 1));
        bf16* o = WSP(bf16, WS_TAPS) + (size_t)(fg * 256 + 32 * wave) * MT + t0 + 32 * tb + r;
#pragma unroll
        for (int i = 0; i < 16; ++i) o[(size_t)((i & 3) + 8 * (i >> 2) + 4 * hh) * MT] = (bf16)f2bf(acc[i] * __expf(-t01 * dl[i]));
    }
    __syncthreads();
}
__device__ __forceinline__ void f_yct_item(KPR p, LAS unsigned char* lds, int idx, int tid) {
    LAS bf16* tile = (LAS bf16*)lds;
    const int t0 = idx * 64;
    { v4u tl[8];
#pragma unroll
      for (int j = 0; j < 8; ++j) { const int q = tid + NTHR * j, row = q >> 3, cc = q & 7; tl[j] = *(const v4u*)(WSP(bf16, WS_YCT) + (size_t)row * MT + t0 + 8 * cc); }
#pragma unroll
      for (int j = 0; j < 8; ++j) { const int q = tid + NTHR * j, row = q >> 3, cc = q & 7; *(LAS v4u*)(tile + row * 72 + 8 * cc) = tl[j]; } }
    __syncthreads();
    for (int q = tid; q < 64 * 64; q += NTHR) { const int tok = q >> 6, cc = q & 63;
        unsigned short e[8];
#pragma unroll
        for (int i = 0; i < 8; ++i) e[i] = tile[(8 * cc + i) * 72 + tok];
        v4u o; o.x = e[0] | ((unsigned)e[1] << 16); o.y = e[2] | ((unsigned)e[3] << 16); o.z = e[4] | ((unsigned)e[5] << 16); o.w = e[6] | ((unsigned)e[7] << 16);
        *(v4u*)(WSP(bf16, WS_Y) + (size_t)(t0 + tok) * YK + YOFF_C + 8 * cc) = o; }
    __syncthreads();
}
constexpr int D_HY_LAT = HY_D, D_SSD_LAT = NCH_LAT * NG, D_SSD_CTX = (NCH - NCH_LAT) * NG, D_SSD = D_SSD_LAT + D_SSD_CTX, D_HY_CTX = HY_D, D_ITEMS = D_HY_LAT + D_SSD + D_HY_CTX;
constexpr int E_ITEMS = 2 * NH * HD * NS / NTHR;
constexpr int F_SSD_LAT = NCH_LAT * NG, F_SSD_CTX = (NCH - NCH_LAT) * NG * HPG, F_YCT = MT / 64, F_ITEMS = F_SSD_LAT + F_SSD_CTX + F_YCT;

#ifndef GEMM1_ALIGN
#define GEMM1_ALIGN true
#endif
#ifndef GEMM1_SP2
#define GEMM1_SP2 true
#endif

#ifndef PROBE_DBL
#define PROBE_DBL 0
#endif

constexpr float DN_ALPHA = (DEPTH == 4) ? 1.681792830507429f : (DEPTH == 2 ? 1.4142135623730951f : (DEPTH == 1 ? 1.189207115002721f : 0.f));
static_assert(DN_ALPHA != 0.f, "add DN_ALPHA for this DEPTH");
__device__ __forceinline__ int tok_per_wg(int G) { return (MT + G - 1) / G; }
template <int NR> __device__ __forceinline__ void phase_r_rows(KPR p, int l, LAS float* rgw_s, LAS float* rew_s, LAS int* hist, const int (&t)[NR], const bool (&ok)[NR], int lane, bool dummy) {
    const bf16* T = WSP(bf16, WS_MG);
    const float* lg = p.in[I_LNG] + (size_t)(l * 2 + 0) * D; const float* lb = p.in[I_LNB] + (size_t)(l * 2 + 0) * D;
    f32x4 x[NR][D / 256]; float s[NR], s2[NR];
#pragma unroll
    for (int r = 0; r < NR; ++r) { s[r] = 0.f; const int which = t[r] < SEQ ? 0 : 1; const float* hr = hrow(p, t[r]); const float* g1 = modv(p, l, which, 2);
#pragma unroll
        for (int j = 0; j < D / 256; ++j) { const int c = 4 * lane + 256 * j; const v2u mx = *(const v2u*)(T + (size_t)t[r] * D + c); x[r][j] = *(const f32x4*)(hr + c) * DN_ALPHA + *(const f32x4*)(g1 + c) * (f32x4){bflo(mx.x), bfhi(mx.x), bflo(mx.y), bfhi(mx.y)}; s[r] += (x[r][j][0] + x[r][j][1]) + (x[r][j][2] + x[r][j][3]); } }
#pragma unroll
    for (int r = 0; r < NR; ++r) s[r] = wave_sum(s[r]) * (1.f / D);
#pragma unroll
    for (int r = 0; r < NR; ++r) { s2[r] = 0.f;
#pragma unroll
        for (int j = 0; j < D / 256; ++j) { x[r][j] = x[r][j] - s[r]; s2[r] += (x[r][j][0] * x[r][j][0] + x[r][j][1] * x[r][j][1]) + (x[r][j][2] * x[r][j][2] + x[r][j][3] * x[r][j][3]); } }
#pragma unroll
    for (int r = 0; r < NR; ++r) s2[r] = frsq(wave_sum(s2[r]) * (1.f / D) + LN_EPS);
    float gl[NR][4]; f32x2 gl2[NR][4];
#pragma unroll
    for (int r = 0; r < NR; ++r) { const int which = t[r] < SEQ ? 0 : 1; const float* sh = modv(p, l, which, 3); const float* sc = modv(p, l, which, 4);
        float* h = dummy ? WSP(float, WS_YS) + (size_t)t[r] * D : hrow(p, t[r]); bf16* u = WSP(bf16, WS_U) + (size_t)t[r] * D;
        gl2[r][0] = (f32x2){0.f, 0.f}; gl2[r][1] = gl2[r][0]; gl2[r][2] = gl2[r][0]; gl2[r][3] = gl2[r][0];
#pragma unroll
        for (int j = 0; j < D / 256; ++j) { const int c = 4 * lane + 256 * j;
            const f32x4 h1 = x[r][j] * s2[r] * *(const f32x4*)(lg + c) + *(const f32x4*)(lb + c);
            const f32x4 q = *(const f32x4*)(sc + c); const f32x4 sv = *(const f32x4*)(sh + c);
            f32x4 u2; u2[0] = h1[0] * (1.f + q[0]) + sv[0]; u2[1] = h1[1] * (1.f + q[1]) + sv[1]; u2[2] = h1[2] * (1.f + q[2]) + sv[2]; u2[3] = h1[3] * (1.f + q[3]) + sv[3];
            x[r][j] = u2;
            if (ok[r]) { *(f32x4*)(h + c) = h1; v2u w; w.x = pk2(u2[0], u2[1]); w.y = pk2(u2[2], u2[3]); *(v2u*)(u + c) = w; }
#pragma unroll
            for (int g = 0; g < 4; ++g) { const f32x4 gw4 = *(const LAS f32x4*)(rgw_s + g * D + c); gl2[r][g] += u2.lo * gw4.lo; gl2[r][g] += u2.hi * gw4.hi; } } }
#pragma unroll
    for (int r = 0; r < NR; ++r)
#pragma unroll
        for (int g = 0; g < 4; ++g) gl[r][g] = wave_sum(gl2[r][g].x + gl2[r][g].y) + p.in[I_RGB][l * 4 + g];
    int gs[NR]; float gprob[NR]; float el[NR][8]; f32x2 el2[NR][8];
#pragma unroll
    for (int r = 0; r < NR; ++r) { gs[r] = 0; float gm = gl[r][0];
#pragma unroll
        for (int g = 1; g < 4; ++g) if (gl[r][g] > gm) { gm = gl[r][g]; gs[r] = g; }
        gprob[r] = frcp(__expf(gl[r][0] - gm) + __expf(gl[r][1] - gm) + __expf(gl[r][2] - gm) + __expf(gl[r][3] - gm));
#pragma unroll
        for (int i = 0; i < 8; ++i) el2[r][i] = (f32x2){0.f, 0.f};
#pragma unroll
        for (int j = 0; j < D / 256; ++j) { const int c = 4 * lane + 256 * j;
#pragma unroll
            for (int i = 0; i < 8; ++i) { const f32x4 w4 = *(const LAS f32x4*)(rew_s + (gs[r] * 8 + i) * D + c); const f32x4 xv = x[r][j];
                el2[r][i] += xv.lo * w4.lo; el2[r][i] += xv.hi * w4.hi; } } }
#pragma unroll
    for (int r = 0; r < NR; ++r)
#pragma unroll
        for (int i = 0; i < 8; ++i) el[r][i] = wave_sum(el2[r][i].x + el2[r][i].y) + p.in[I_REB][l * NE + gs[r] * 8 + i];
#pragma unroll
    for (int r = 0; r < NR; ++r) {
        int i0 = 0; float v0 = el[r][0];
#pragma unroll
        for (int i = 1; i < 8; ++i) if (el[r][i] > v0) { v0 = el[r][i]; i0 = i; }
        int i1 = -1; float v1 = -3.0e38f;
#pragma unroll
        for (int i = 0; i < 8; ++i) if (i != i0 && el[r][i] > v1) { v1 = el[r][i]; i1 = i; }
        const float e1 = __expf(v1 - v0), w0 = gprob[r] * frcp(1.f + e1), w1 = gprob[r] * e1 * frcp(1.f + e1);
        if (lane == 0 && ok[r]) {
            v4u rr; rr.x = (unsigned)(gs[r] * 8 + i0); rr.y = (unsigned)(gs[r] * 8 + i1); rr.z = f2u(w0); rr.w = f2u(w1);
            *(v4u*)(WSP(unsigned, WS_ROUTE) + (size_t)t[r] * 4) = rr;
            atomicAdd((int*)&hist[gs[r] * 8 + i0], 1); atomicAdd((int*)&hist[gs[r] * 8 + i1], 1);
        }
    }
}
__device__ __forceinline__ void phase_r(KPR p, int l, LAS unsigned char* lds, int tid, int bid, int G, int tlim, bool dummy = false) {
    const int lane = tid & 63, wave = tid >> 6;
    LAS float* rew_s = (LAS float*)lds;
    LAS float* rgw_s = (LAS float*)(lds + (size_t)D * NE * 4);
    LAS int* hist = (LAS int*)(lds + (size_t)D * (NE + 4) * 4);
    __syncthreads();
    { const float* rgw = p.in[I_RGW] + (size_t)l * D * 4; const float* rew = p.in[I_REW] + (size_t)l * D * NE;
      constexpr int NQ = D * NE / 4 / NTHR;
#pragma unroll 1
      for (int j0 = 0; j0 < NQ; j0 += 8) { f32x4 tv[8];
#pragma unroll
          for (int j = 0; j < 8; ++j) { const int q = tid + NTHR * (j0 + j), c = q >> 3, e4 = (q & 7) * 4; tv[j] = (j0 + j < NQ) ? *(const f32x4*)(rew + (size_t)c * NE + e4) : (f32x4){0.f, 0.f, 0.f, 0.f}; }
#pragma unroll
          for (int j = 0; j < 8; ++j) if (j0 + j < NQ) { const int q = tid + NTHR * (j0 + j), c = q >> 3, e4 = (q & 7) * 4;
              rew_s[(e4 + 0) * D + c] = tv[j][0]; rew_s[(e4 + 1) * D + c] = tv[j][1]; rew_s[(e4 + 2) * D + c] = tv[j][2]; rew_s[(e4 + 3) * D + c] = tv[j][3]; } }
      for (int q = tid; q < D; q += NTHR) { const f32x4 v = *(const f32x4*)(rgw + 4 * q); rgw_s[q] = v[0]; rgw_s[D + q] = v[1]; rgw_s[2 * D + q] = v[2]; rgw_s[3 * D + q] = v[3]; } }
    if (tid < NE) hist[tid] = 0;
    __syncthreads();
    const int TPW = tok_per_wg(G), tb = bid * TPW, te = (tb + TPW < tlim) ? tb + TPW : tlim;
    constexpr int NR = 3;
    for (int k = tb + wave; k < te; k += NWAVES * NR) {
        int t[NR]; bool ok[NR];
#pragma unroll
        for (int r = 0; r < NR; ++r) { const int tt = k + r * NWAVES; ok[r] = tt < te; t[r] = ok[r] ? tt : k; }
        phase_r_rows<NR>(p, l, rgw_s, rew_s, hist, t, ok, lane, dummy);
    }
    __syncthreads();
    if (tid < NE) WSP(int, WS_HIST)[bid * NE + tid] = hist[tid];
    __syncthreads();
}
__device__ __forceinline__ void phase_g(KPR p, LAS unsigned char* lds, int tid, int bid, int G, int tlim) {
    const int lane = tid & 63, wave = tid >> 6;
    LAS int* cnt = (LAS int*)(lds + 131072);
    LAS int* bef = cnt + 32;
    LAS int* pst = cnt + 64;
    LAS int* base = cnt + 100;
    LAS int* alist = cnt + 160;
    const int TPW = tok_per_wg(G), tb = bid * TPW, te = (tb + TPW < tlim) ? tb + TPW : tlim, na = 2 * (te > tb ? te - tb : 0);
    const unsigned* route = WSP(unsigned, WS_ROUTE);
    { LAS int* part = cnt + 160 + 4096;
      const int e = tid & 31, pt = tid >> 5; int tot = 0, b = 0;
#pragma unroll 1
      for (int w0 = pt; w0 < G; w0 += 16 * 8) { int hv[8];
#pragma unroll
          for (int j = 0; j < 8; ++j) { const int w = w0 + 16 * j; hv[j] = (w < G) ? WSP(int, WS_HIST)[w * NE + e] : 0; }
#pragma unroll
          for (int j = 0; j < 8; ++j) { const int w = w0 + 16 * j; tot += hv[j]; if (w < bid) b += hv[j]; } }
      part[(pt * 2 + 0) * 32 + e] = tot; part[(pt * 2 + 1) * 32 + e] = b;
      __syncthreads();
      if (tid < NE) { int t2 = 0, b2 = 0; for (int q = 0; q < 16; ++q) { t2 += part[(q * 2) * 32 + tid]; b2 += part[(q * 2 + 1) * 32 + tid]; } cnt[tid] = t2; bef[tid] = b2; } }
    for (int a = tid; a < na; a += NTHR) alist[a] = (int)route[(size_t)(tb + (a >> 1)) * 4 + (a & 1)];
    __syncthreads();
    if (tid == 0) { int s = 0; for (int e = 0; e < NE; ++e) { pst[e] = s; s += (cnt[e] + 255) / 256 * 256; } pst[NE] = s; }
    __syncthreads();
    if (tid < NE) base[tid] = pst[tid] + bef[tid];
    __syncthreads();
    { int mypos[(2 * 1024 + NTHR - 1) / NTHR];
#pragma unroll
      for (int q = 0; q < (2 * 1024 + NTHR - 1) / NTHR; ++q) { const int a = tid + q * NTHR; mypos[q] = 0;
          if (q * NTHR < na) { const int e = a < na ? alist[a] : -1; int rank = 0;
#pragma unroll 8
              for (int a2 = 0; a2 < na; ++a2) rank += (a2 < a && alist[a2] == e) ? 1 : 0;
              if (a < na) mypos[q] = base[e] + rank; } }
      __syncthreads();
#pragma unroll
      for (int q = 0; q < (2 * 1024 + NTHR - 1) / NTHR; ++q) { const int a = tid + q * NTHR; if (a < na) alist[a] = mypos[q]; } }
    __syncthreads();
    for (int a = tid; a < na; a += NTHR) WSP(int, WS_POS)[(size_t)(tb + (a >> 1)) * 2 + (a & 1)] = alist[a];
    for (int a0 = wave * 4; a0 < na; a0 += NWAVES * 4) {
        constexpr int NJ = (D / 8 + 63) / 64; v4u buf[4][NJ];
#pragma unroll
        for (int r = 0; r < 4; ++r) { const int a = a0 + r < na ? a0 + r : a0; const bf16* src = WSP(bf16, WS_U) + (size_t)(tb + (a >> 1)) * D;
#pragma unroll
            for (int j = 0; j < NJ; ++j) if (lane + 64 * j < D / 8) buf[r][j] = *(const v4u*)(src + 8 * (lane + 64 * j)); }
#pragma unroll
        for (int r = 0; r < 4; ++r) if (a0 + r < na) { bf16* dst = WSP(bf16, WS_XS) + (size_t)alist[a0 + r] * D;
#pragma unroll
            for (int j = 0; j < NJ; ++j) if (lane + 64 * j < D / 8) *(v4u*)(dst + 8 * (lane + 64 * j)) = buf[r][j]; }
    }
    for (int e = bid; e < NE; e += G) {
        const int r0 = pst[e] + cnt[e], r1 = pst[e + 1]; unsigned zz_ = 0u; OPAQUE_V(zz_); v4u z; z.x = zz_; z.y = zz_; z.z = zz_; z.w = zz_;
        for (int q = tid; q < (r1 - r0) * (D / 8); q += NTHR) *(v4u*)(WSP(bf16, WS_XS) + (size_t)r0 * D + (size_t)q * 8) = z;
    }
    if (bid == 0) {
        const int nt = pst[NE] / 256;
        for (int i = tid; i < nt; i += NTHR) { int e = 0; while (e < NE - 1 && i * 256 >= pst[e + 1]) ++e; WSP(int, WS_TILEE)[i] = e; }
        if (tid == 0) WSP(int, WS_TILEE)[NTMAX] = nt;
    }
    __syncthreads();
}
__device__ __forceinline__ void phase_n(KPR p, int l, int gw, int NGW, int lane, int tlim, bool dummy = false) {
    const bf16* YS = WSP(bf16, WS_YS);
    const float* lg = p.in[I_LNG] + (size_t)(l * 2 + 1) * D; const float* lb = p.in[I_LNB] + (size_t)(l * 2 + 1) * D;
    constexpr int NR = 5;
    for (int k = gw; k < tlim; k += NGW * NR) {
        int t[NR]; bool ok[NR]; f32x4 x[NR][D / 256]; float s[NR], s2[NR];
#pragma unroll
        for (int r = 0; r < NR; ++r) { const int tt = k + r * NGW; ok[r] = tt < tlim; t[r] = ok[r] ? tt : k; }
        v4u rt[NR]; int p0[NR], p1[NR];
#pragma unroll
        for (int r = 0; r < NR; ++r) { rt[r] = *(const v4u*)(WSP(unsigned, WS_ROUTE) + (size_t)t[r] * 4); p0[r] = WSP(int, WS_POS)[(size_t)t[r] * 2]; p1[r] = WSP(int, WS_POS)[(size_t)t[r] * 2 + 1]; }
#pragma unroll
        for (int r = 0; r < NR; ++r) { const int which = t[r] < SEQ ? 0 : 1; const unsigned uz = rt[r].z, uw = rt[r].w; const float w0 = u2f(uz), w1 = u2f(uw);
            const float* g2 = modv(p, l, which, 5); const float* h = hrow(p, t[r]); s[r] = 0.f;
#pragma unroll
            for (int j = 0; j < D / 256; ++j) { const int c = 4 * lane + 256 * j;
                const v2u ya = *(const v2u*)(YS + (size_t)p0[r] * D + c), yb = *(const v2u*)(YS + (size_t)p1[r] * D + c);
                const f32x4 f = (f32x4){bflo(ya.x), bfhi(ya.x), bflo(ya.y), bfhi(ya.y)} * w0 + (f32x4){bflo(yb.x), bfhi(yb.x), bflo(yb.y), bfhi(yb.y)} * w1;
                x[r][j] = *(const f32x4*)(h + c) * DN_ALPHA + *(const f32x4*)(g2 + c) * f; s[r] += (x[r][j][0] + x[r][j][1]) + (x[r][j][2] + x[r][j][3]); } }
#pragma unroll
        for (int r = 0; r < NR; ++r) s[r] = wave_sum(s[r]) * (1.f / D);
#pragma unroll
        for (int r = 0; r < NR; ++r) { s2[r] = 0.f;
#pragma unroll
            for (int j = 0; j < D / 256; ++j) { x[r][j] = x[r][j] - s[r]; s2[r] += (x[r][j][0] * x[r][j][0] + x[r][j][1] * x[r][j][1]) + (x[r][j][2] * x[r][j][2] + x[r][j][3] * x[r][j][3]); } }
#pragma unroll
        for (int r = 0; r < NR; ++r) s2[r] = frsq(wave_sum(s2[r]) * (1.f / D) + LN_EPS);
#pragma unroll
        for (int r = 0; r < NR; ++r) { if (!ok[r]) continue; const int which = t[r] < SEQ ? 0 : 1; float* h = hrow(p, t[r]);
#pragma unroll
            for (int j = 0; j < D / 256; ++j) { const int c = 4 * lane + 256 * j;
                const f32x4 h2 = x[r][j] * s2[r] * *(const f32x4*)(lg + c) + *(const f32x4*)(lb + c);
                *(f32x4*)((dummy ? WSP(float, WS_XS) + (size_t)t[r] * D : h) + c) = h2;
                if (l + 1 < DEPTH) { const f32x4 q = *(const f32x4*)(modv(p, l + 1, which, 1) + c), sv = *(const f32x4*)(modv(p, l + 1, which, 0) + c);
                    v2u w; w.x = pk2(h2[0] * (1.f + q[0]) + sv[0], h2[1] * (1.f + q[1]) + sv[1]); w.y = pk2(h2[2] * (1.f + q[2]) + sv[2], h2[3] * (1.f + q[3]) + sv[3]);
                    *(v2u*)(WSP(bf16, WS_U) + (size_t)t[r] * D + c) = w; } } }
    }
}
__device__ __forceinline__ float ssd_rms_scale(const float* ssq, int row) {
    const float* q = ssq + (size_t)row * 24; float s = 0.f;
#pragma unroll
    for (int j = 0; j < 6; ++j) { const f32x4 v = *(const f32x4*)(q + 4 * j); s += (v[0] + v[1]) + (v[2] + v[3]); }
    return frsq(s * (1.0f / SSD_D) + LN_EPS);
}
constexpr int CTX_TILES = (CTX / 32) * (D / 32);
__device__ __forceinline__ void ctx_reduce_store(LAS unsigned char* lds, const f32x16& tot, int tid, float (&out2)[2]) {
    LAS float* red = (LAS float*)lds; const int lane = tid & 63, wave = tid >> 6;
    __syncthreads();
#pragma unroll
    for (int i = 0; i < 16; ++i) red[(wave * 16 + i) * 64 + lane] = tot[i];
    __syncthreads();
#pragma unroll
    for (int q = 0; q < 2; ++q) { const int e = tid + q * NTHR; float s = 0.f;
#pragma unroll
        for (int w = 0; w < NWAVES; ++w) s += red[w * 1024 + e];
        out2[q] = s; }
}
__device__ __forceinline__ void ctx_h_tile(KPR p, LAS unsigned char* lds, int tile, int tid) {
    const int rb = tile / (D / 32), cb = tile % (D / 32), lane = tid & 63, wave = tid >> 6, r = lane & 31, hh = lane >> 5;
    const int row0 = SEQ + 32 * rb, col0 = 32 * cb;
    const bf16* P = WSP(bf16, WS_P); const float* ssq = WSP(float, WS_SSQ);
    f32x16 tot;
#pragma unroll
    for (int i = 0; i < 16; ++i) tot[i] = 0.f;
#pragma unroll 1
    for (int br = 0; br < 4; ++br) {
        const int K = (br == 1) ? 768 : 512, ksl = K / 8;
        const int koff = br == 0 ? YOFF_A : (br == 1 ? YOFF_B : (br == 2 ? YOFF_C : YOFF_D));
        const bf16* A = WSP(bf16, WS_Y) + (size_t)(row0 + r) * YK + koff + wave * ksl + 8 * hh;
        const bf16* B = WSP(bf16, WS_WCAT) + (size_t)(col0 + r) * YK + koff + wave * ksl + 8 * hh;
        f32x16 acc;
#pragma unroll
        for (int i = 0; i < 16; ++i) acc[i] = 0.f;
#pragma unroll 6
        for (int ks = 0; ks < ksl / 16; ++ks) acc = MFMA32(as_bf16x8(*(const v4u*)(A + 16 * ks)), as_bf16x8(*(const v4u*)(B + 16 * ks)), acc);
#pragma unroll
        for (int i = 0; i < 16; ++i) { const int row = row0 + (i & 3) + 8 * (i >> 2) + 4 * hh;
            float g = sigmoidf_(bf2f(P[(size_t)row * NP + OFF_G + br * D + col0 + r]));
            if (br == 1) g *= ssd_rms_scale(ssq, row);
            tot[i] += g * acc[i];
            if ((i & 3) == 3) CFENCE(); }
    }
    float o2[2]; ctx_reduce_store(lds, tot, tid, o2);
#pragma unroll
    for (int q = 0; q < 2; ++q) { const int e = tid + q * NTHR, i = e >> 6, ln = e & 63; const int row = row0 + (i & 3) + 8 * (i >> 2) + 4 * (ln >> 5), col = col0 + (ln & 31);
        WSP(bf16, WS_U)[(size_t)row * D + col] = (bf16)f2bf(o2[q]); }
}
__device__ __forceinline__ void ctx_i_tile(KPR p, int l, LAS unsigned char* lds, int tile, int tid) {
    const int rb = tile / (D / 32), cb = tile % (D / 32), lane = tid & 63, wave = tid >> 6, r = lane & 31, hh = lane >> 5;
    const int row0 = SEQ + 32 * rb, col0 = 32 * cb; constexpr int ksl = D / 8;
    const bf16* A = WSP(bf16, WS_U) + (size_t)(row0 + r) * D + wave * ksl + 8 * hh;
    const bf16* B = WSP(bf16, WS_WOUT) + (size_t)(col0 + r) * D + wave * ksl + 8 * hh;
    f32x16 acc;
#pragma unroll
    for (int i = 0; i < 16; ++i) acc[i] = 0.f;
#pragma unroll
    for (int ks = 0; ks < ksl / 16; ++ks) acc = MFMA32(as_bf16x8(*(const v4u*)(A + 16 * ks)), as_bf16x8(*(const v4u*)(B + 16 * ks)), acc);
    float o2[2]; ctx_reduce_store(lds, acc, tid, o2);
#pragma unroll
    for (int q = 0; q < 2; ++q) { const int e = tid + q * NTHR, i = e >> 6, ln = e & 63; const int row = row0 + (i & 3) + 8 * (i >> 2) + 4 * (ln >> 5), col = col0 + (ln & 31);
        WSP(bf16, WS_MG)[(size_t)row * D + col] = (bf16)f2bf(o2[q]); }
}
__device__ NOINLINE void e_pre0() { ENTRY_BEGIN; phase_mod(p, lds, tid, bid, G); conv_weights(p, 0, lds, gw, NGW, lane, wave); }
__device__ NOINLINE void e_u0() { ENTRY_BEGIN; phase_u0(p, gw, NGW, lane); }
__device__ NOINLINE void e_gemm_b() { ENTRY_BEGIN;
    DenseOrder S; S.init(MT, NP, D, G, bid, WSP(bf16, WS_U), WSP(bf16, WS_WIN)); EpiPG E{WSP(bf16, WS_P), NP};
    pg8::gemm_phase<EpiPG, DenseOrder, GEMM1_ALIGN, GEMM1_SP2>(lds, D, S, E, tid); }
__device__ NOINLINE void e_c1(int l, int idx) { ENTRY_BEGIN; c1_conformer(p, UNI(l), lds, UNI(idx), tid); }
__device__ NOINLINE void e_cw(int l, int nheavy, int last) { ENTRY_BEGIN; __syncthreads();
    if (bid >= nheavy) c_wave_items(p, UNI(l), lds, (bid - nheavy) * NWAVES + wave, (G - nheavy) * NWAVES, lane, wave, UNI(last));
    __syncthreads(); }
__device__ NOINLINE void e_c5(int l) { ENTRY_BEGIN; __syncthreads(); c5_load_weights(p, UNI(l), lds, tid); __syncthreads(); for (int it = bid; it < C5_ITEMS; it += G) c5_item(p, UNI(l), lds, it, tid); __syncthreads(); }
__device__ NOINLINE void e_c6(int l, int idx) { ENTRY_BEGIN; c6_taps_item(p, UNI(l), lds, UNI(idx), tid); }
__device__ NOINLINE void e_hyena(int l, int c, int isctx) { ENTRY_BEGIN;
    f32x4* fscr = WSP(f32x4, WS_FSCR) + (size_t)bid * (SEQ / 2 + 1); f32x2* zscr = WSP(f32x2, WS_ZSCR) + (size_t)bid * (SEQ / 2);
    if (UNI(isctx)) hyena_item<CTX>(p, UNI(l), lds, UNI(c), SEQ, fscr, zscr, tid); else hyena_item<SEQ>(p, UNI(l), lds, UNI(c), 0, fscr, zscr, tid); }
__device__ NOINLINE void e_dssd(int l, int idx, int e_only) { ENTRY_BEGIN; d_ssd_item(p, UNI(l), lds, UNI(idx), UNI(e_only), tid); }
__device__ NOINLINE void e_scan() { ENTRY_BEGIN; for (int it = bid; it < E_ITEMS; it += G) e_scan_item(p, it, tid); }
__device__ NOINLINE void e_fssd(int l, int c, int g, int e0, int e1) { ENTRY_BEGIN; f_ssd_item(p, UNI(l), lds, UNI(c), UNI(g), UNI(e0), UNI(e1), tid); }
__device__ NOINLINE void e_fyct(int idx) { ENTRY_BEGIN; f_yct_item(p, lds, UNI(idx), tid); }
__device__ NOINLINE void e_gemm_h() { ENTRY_BEGIN;
    LAS float* rs = (LAS float*)(lds + 131072);
    { DenseOrder T; T.init(SEQ, D, YK, G, bid, nullptr, nullptr); pg8::Unit u; const float* ssq = WSP(float, WS_SSQ);
      __syncthreads();
      for (int i = 0; i < 8 && T.next(i, u); ++i) if (tid < 256) rs[i * 256 + tid] = ssd_rms_scale(ssq, u.pm * 256 + tid);
      __syncthreads(); }
    DenseOrder S; S.init(SEQ, D, YK, G, bid, WSP(bf16, WS_Y), WSP(bf16, WS_WCAT));
    EpiMerge E{WSP(bf16, WS_P) + OFF_G, WSP(bf16, WS_U), rs};
    int Kq = YK; OPAQUE_S(Kq);
    pg8::gemm_phase<EpiMerge, DenseOrder, true, true>(lds, Kq, S, E, tid); }
__device__ NOINLINE void e_gemm_i() { ENTRY_BEGIN;
    DenseOrder S; S.init(SEQ, D, D, G, bid, WSP(bf16, WS_U), WSP(bf16, WS_WOUT));
    EpiP E{WSP(bf16, WS_MG), D};
    pg8::gemm_phase<EpiP, DenseOrder, true, true>(lds, D, S, E, tid); }
__device__ NOINLINE void e_ctx_h() { ENTRY_BEGIN; for (int t = bid; t < CTX_TILES; t += G) ctx_h_tile(p, lds, t, tid); __syncthreads(); }
__device__ NOINLINE void e_ctx_i(int l) { ENTRY_BEGIN; for (int t = bid; t < CTX_TILES; t += G) ctx_i_tile(p, UNI(l), lds, t, tid); __syncthreads(); }
__device__ NOINLINE void e_r(int l, int tlim) { ENTRY_BEGIN; if (PROBE_DBL & 4194304) phase_r(p, UNI(l), lds, tid, bid, G, UNI(tlim), true); phase_r(p, UNI(l), lds, tid, bid, G, UNI(tlim)); }
__device__ NOINLINE void e_g(int tlim) { ENTRY_BEGIN; phase_g(p, lds, tid, bid, G, UNI(tlim)); }
__device__ NOINLINE void e_gemm_m1() { ENTRY_BEGIN;
    MoeOrder S{WSP(int, WS_TILEE), UNI(WSP(int, WS_TILEE)[NTMAX]), 2 * FF / 256, G, bid, (const char*)WSP(bf16, WS_XS), (const char*)WSP(bf16, WS_WGU), (size_t)256 * D * 2, (size_t)2 * FF * D * 2, (size_t)256 * D * 2};
    EpiSwiGLU E{WSP(bf16, WS_HS)};
    pg8::gemm_phase<EpiSwiGLU, MoeOrder, true, true>(lds, D, S, E, tid); }
__device__ NOINLINE void e_gemm_m2() { ENTRY_BEGIN;
    MoeOrder S{WSP(int, WS_TILEE), UNI(WSP(int, WS_TILEE)[NTMAX]), D / 256, G, bid, (const char*)WSP(bf16, WS_HS), (const char*)WSP(bf16, WS_WDN), (size_t)256 * FF * 2, (size_t)D * FF * 2, (size_t)256 * FF * 2};
    EpiP E{WSP(bf16, WS_YS), D};
    pg8::gemm_phase<EpiP, MoeOrder, true, true>(lds, FF, S, E, tid); }
__device__ NOINLINE void e_n(int l_) { ENTRY_BEGIN; const int l = UNI(l_); const int tlim = (l == DEPTH - 1) ? SEQ : MT; if (PROBE_DBL & 8388608) phase_n(p, l, gw, NGW, lane, tlim, true); phase_n(p, l, gw, NGW, lane, tlim); if (l + 1 < DEPTH) { conv_weights(p, l + 1, lds, gw, NGW, lane, wave); if (PROBE_DBL & 8) conv_weights(p, l + 1, lds, gw, NGW, lane, wave); } }

constexpr int NPH_PRE = 2, NPH_LAYER = 12, NPHASES = NPH_PRE + DEPTH * NPH_LAYER;
__global__ void __launch_bounds__(NTHR, 2) fwd_kernel(KParams kp) {
#ifdef CPU_EMU
    static KParams kp_static; kp_static = kp; g_emu_kp = &kp_static;
    const int lo = kp.ph_lo, hi = kp.ph_hi;
    XcdBarrier bar; bar.dummy = 0;
#else
    KP_DECL; LDS_DECL;
    const int lo = p.ph_lo, hi = p.ph_hi;
    volatile LAS unsigned* misc = (volatile LAS unsigned*)(lds + LDS_BYTES - 256);
    if (threadIdx.x < 64) misc[threadIdx.x] = 0u;
    __syncthreads();
    unsigned* ctl = WSP(unsigned, WS_CTL);
    XcdBarrier bar; bar.bar = ctl + CW_BAR; bar.x = 0; bar.st = misc;
    if (hi - lo > 1) bar = xcd_barrier_post(ctl + CW_BAR, misc);
#endif
    const int bid = blockIdx.x, G = gridDim.x;
#ifndef PH_MASK
#define PH_MASK 0xffffffu
#endif
#define PHON(k) ((PH_MASK >> (k)) & 1u)
#define IN(k) (lo <= (k) && (k) < hi)
#define SEAM(k) do { if (IN(k) && IN((k) + 1)) { xcd_barrier(bar); if (PROBE_DBL & 524288) { xcd_barrier(bar); xcd_barrier(bar); } } } while (0)
    if (PHON(0) && IN(0)) { e_pre0(); e_c5(0); if (PROBE_DBL & 4096) e_c5(0); }
    SEAM(0);
    if (PHON(1) && IN(1)) e_u0();
    SEAM(1);
    for (int l = 0; l < DEPTH; ++l) {
        const int b0 = NPH_PRE + l * NPH_LAYER;
        const int last = (l == DEPTH - 1) ? 1 : 0, tlim = last ? SEQ : MT;
        if (PHON(2) && IN(b0 + 0)) { e_gemm_b(); if (PROBE_DBL & 128) e_gemm_b(); }
        SEAM(b0 + 0);
        if (PHON(3) && IN(b0 + 1)) {
            for (int it = bid; it < C6_ITEMS; it += G) { if (last && (it / 8) * 256 >= SEQ) continue; e_c6(l, it); }
            {
                const int c1n = last ? C1_LAT : C1_ITEMS;
                const int xcd = bid & 7, slot = bid >> 3, per = (c1n + 7) / 8, nslot = (G + 7) / 8;
                int nheavy = 0;
                if ((G & 7) == 0) { for (int j = slot; j < per; j += nslot) { const int it = xcd * per + j; if (it < c1n) e_c1(l, it); }
                    if (nslot < per && per <= 2 * nslot) { for (int x = 0; x < 8; ++x) if (x * per + nslot < c1n) nheavy = x + 1; if (nheavy * 4 > G) nheavy = 0; } }
                else for (int it = bid; it < c1n; it += G) e_c1(l, it);
                e_cw(l, nheavy, last);
            }
            if (PROBE_DBL & 16) { for (int it = bid; it < C_ITEMS; it += G) { if (it < C6_ITEMS) e_c6(l, it); else e_c1(l, it - C6_ITEMS); } e_cw(l, 0, last); }
            if (PROBE_DBL & 65536) for (int it = bid; it < C6_ITEMS; it += G) e_c6(l, it);
            if (PROBE_DBL & 131072) for (int it = bid; it < C1_ITEMS; it += G) e_c1(l, it);
            if (PROBE_DBL & 262144) e_cw(l, 0, last); }
        SEAM(b0 + 1);
        if (PHON(4) && IN(b0 + 2)) for (int it = bid; it < D_ITEMS; it += G) {
            int r = it;
            if (r < D_HY_LAT) { e_hyena(l, r, 0); if (PROBE_DBL & 1) e_hyena(l, r, 0); continue; } r -= D_HY_LAT;
            if (r < D_SSD) { e_dssd(l, r, -1); if (PROBE_DBL & 2) e_dssd(l, r, -1); continue; } r -= D_SSD;
            if (!last) { e_hyena(l, r, 1); if (PROBE_DBL & 8192) e_hyena(l, r, 1); } }
        SEAM(b0 + 2);
        if (PHON(5) && IN(b0 + 3)) { e_scan(); if (PROBE_DBL & 1048576) e_scan(); }
        SEAM(b0 + 3);
        const int fgap = (!last && F_SSD_LAT % G == 0 && G > 2 * F_SSD_CTX) ? F_SSD_CTX : 0;
        if (PHON(6) && IN(b0 + 4)) for (int it = bid; it < F_ITEMS + fgap; it += G) { int r = it;
            if (r < F_SSD_LAT + F_SSD_CTX) { int c_, g_, e0_, e1_;
                if (r >= F_SSD_LAT && last) continue;
                if (r < F_SSD_LAT) { c_ = r / NG; g_ = r % NG; e0_ = 0; e1_ = HPG; } else { const int q = r - F_SSD_LAT, cg = q / HPG; c_ = NCH_LAT + cg / NG; g_ = cg % NG; e0_ = q % HPG; e1_ = e0_ + 1; }
                e_fssd(l, c_, g_, e0_, e1_); if (PROBE_DBL & 4) e_fssd(l, c_, g_, e0_, e1_); continue; }
            r -= F_SSD_LAT + F_SSD_CTX;
            if (fgap) { if (r >= G - fgap && r < G) continue; if (r >= G) r -= fgap; }
            if (last && r >= SEQ / 64) continue;
            e_fyct(r); if (PROBE_DBL & 2097152) e_fyct(r); }
        SEAM(b0 + 4);
        if (PHON(7) && IN(b0 + 5)) { if (!last) e_ctx_h(); if (PROBE_DBL & 16384) e_ctx_h(); e_gemm_h(); if (PROBE_DBL & 256) e_gemm_h(); }
        SEAM(b0 + 5);
        if (PHON(8) && IN(b0 + 6)) { if (!last) e_ctx_i(l); if (PROBE_DBL & 16384) e_ctx_i(l); e_gemm_i(); if (PROBE_DBL & 512) e_gemm_i(); }
        SEAM(b0 + 6);
        if (PHON(9) && IN(b0 + 7)) { e_r(l, tlim); if (PROBE_DBL & 32) e_r(l, tlim); }
        SEAM(b0 + 7);
        if (PHON(10) && IN(b0 + 8)) { e_g(tlim); if (PROBE_DBL & 64) e_g(tlim); }
        SEAM(b0 + 8);
        if (PHON(11) && IN(b0 + 9)) { e_gemm_m1(); if (PROBE_DBL & 1024) e_gemm_m1(); }
        SEAM(b0 + 9);
        if (PHON(12) && IN(b0 + 10)) { e_gemm_m2(); if (PROBE_DBL & 2048) e_gemm_m2(); }
        SEAM(b0 + 10);
        if (PHON(13) && IN(b0 + 11)) { e_n(l); if (l + 1 < DEPTH) { e_c5(l + 1); if (PROBE_DBL & 4096) e_c5(l + 1); } }
        SEAM(b0 + 11);
    }
#undef IN
#undef SEAM
}

#ifndef CPU_EMU
extern "C" void kernel_launch(void* const* d_in, const int* in_sizes, int n_in, void* d_out, int out_size, void* d_ws, size_t ws_size, hipStream_t stream) {
    static int grid = 0;
    if (grid == 0) {
        if (n_in != N_IN || out_size != SEQ * D || ws_size < WS_END) { fprintf(stderr, "kernel_launch: unexpected shapes (n_in %d out %d ws %zu need %zu)\n", n_in, out_size, ws_size, (size_t)WS_END); grid = -1; return; }
        int dev = 0, cus = 0, per_cu = 0;
        if (hipGetDevice(&dev) != hipSuccess || hipDeviceGetAttribute(&cus, hipDeviceAttributeMultiprocessorCount, dev) != hipSuccess) { grid = -1; return; }
        if (hipFuncSetAttribute((const void*)fwd_kernel, hipFuncAttributeMaxDynamicSharedMemorySize, LDS_BYTES) != hipSuccess) { fprintf(stderr, "kernel_launch: hipFuncSetAttribute failed\n"); grid = -1; return; }
        if (hipOccupancyMaxActiveBlocksPerMultiprocessor(&per_cu, (const void*)fwd_kernel, NTHR, LDS_BYTES) != hipSuccess || per_cu < 1) fprintf(stderr, "kernel_launch: occupancy query reports %d\n", per_cu);
        (void)hipGetLastError();
        grid = cus < 256 ? cus : 256;
    }
    if (grid < 0) return;
    if (hipMemsetAsync((char*)d_ws + WS_CTL, 0, CTL_BYTES, stream) != hipSuccess) return;
    KParams a{};
    for (int i = 0; i < N_IN; ++i) a.in[i] = (const float*)d_in[i];
    a.out = (float*)d_out; a.ws = (unsigned char*)d_ws;
#if MK_MULTI
    for (int ph = 0; ph < NPHASES; ++ph) { a.ph_lo = ph; a.ph_hi = ph + 1; hipLaunchKernelGGL(fwd_kernel, dim3(grid), dim3(NTHR), LDS_BYTES, stream, a); }
#else
    a.ph_lo = 0; a.ph_hi = NPHASES; hipLaunchKernelGGL(fwd_kernel, dim3(grid), dim3(NTHR), LDS_BYTES, stream, a);
#endif
}
#endif
```

```cpp
#ifndef CPU_EMU
#include <hip/hip_runtime.h>
#endif
#include <stdint.h>
#include <stdio.h>

#ifndef CFG_D
#define CFG_D 1024
#define CFG_SEQ 16384
#define CFG_DEPTH 4
#endif
#ifndef MK_MULTI
#define MK_MULTI 0
#endif

constexpr int D = CFG_D, SEQ = CFG_SEQ, DEPTH = CFG_DEPTH, CTX = 256, MT = SEQ + CTX;
constexpr int GRID_W = 64, ROWS = SEQ / GRID_W;
constexpr int CONF_D = 512, CONF_K = 31;
constexpr int SSD_D = 768, NH = 12, HD = 64, NG = 4, HPG = 3, NS = 128, XBC = 1792, SSD_PROJ = 2584, CHUNK = 128, NCH = MT / CHUNK, NCH_LAT = SEQ / CHUNK;
constexpr int HY_D = 512, SC_D = 512, HY_NF = 2048;
constexpr int OFF_A = 0, OFF_B = 1024, OFF_C = 3608, OFF_D = 5144, OFF_G = 6680, PROJ = OFF_G + 4 * D, NP = (PROJ + 255) / 256 * 256;
constexpr int NE = 32, FF = 512, NRMAX = ((2 * MT + NE * 255) / 256 + 1) * 256, NTMAX = NRMAX / 256;
constexpr float LN_EPS = 1e-5f;
constexpr int NTHR = 512, NWAVES = 8;
constexpr int LDS_BYTES = 163840, STAGE_REGION = 131072, MISC_OFF = 131072 + 16384;

enum { I_X = 0, I_C, I_CTX, I_CCTX, I_WMOD, I_BMOD, I_LNG, I_LNB, I_WIN, I_CDWW, I_CDWB, I_CLNG, I_CLNB, I_SCW, I_SCB, I_SALOG, I_SDTB, I_SD, I_SNG,
       I_HSW, I_HSB, I_HW1, I_HB1, I_HW2, I_HB2, I_HFREQ, I_HW3, I_HBIAS, I_SCCW, I_WBA, I_WBB, I_WBC, I_WBD, I_WOUT, I_RGW, I_RGB, I_REW, I_REB, I_EWG, I_EWU, I_EWD, N_IN };

constexpr size_t al256(size_t x) { return (x + 255) & ~(size_t)255; }
constexpr size_t WS_CTL = 0, CTL_BYTES = 1u << 20;
constexpr size_t WS_MODV = WS_CTL + CTL_BYTES;
constexpr size_t WS_WIN = al256(WS_MODV + (size_t)DEPTH * 2 * 6 * D * 4);
constexpr size_t WS_WCAT = al256(WS_WIN + (size_t)NP * D * 2);
constexpr size_t WS_WOUT = al256(WS_WCAT + (size_t)D * 2304 * 2);
constexpr size_t WS_WGU = al256(WS_WOUT + (size_t)D * D * 2);
constexpr size_t WS_WDN = al256(WS_WGU + (size_t)NE * 2 * FF * D * 2);
constexpr size_t WS_HC = al256(WS_WDN + (size_t)NE * D * FF * 2);
constexpr size_t WS_U = al256(WS_HC + (size_t)CTX * D * 4);
constexpr size_t WS_P = al256(WS_U + (size_t)MT * D * 2);
constexpr size_t P_BYTES = (size_t)MT * NP * 2;
constexpr size_t WS_XS = WS_P;
constexpr size_t WS_HS = al256(WS_XS + (size_t)NRMAX * D * 2);
constexpr size_t WS_YS = al256(WS_HS + (size_t)NRMAX * FF * 2);
constexpr size_t MOE_END = WS_YS + (size_t)NRMAX * D * 4;
constexpr size_t WS_Y = al256(WS_P + (P_BYTES > (MOE_END - WS_P) ? P_BYTES : (MOE_END - WS_P)));
constexpr int YK = 2304, YOFF_A = 0, YOFF_B = 512, YOFF_C = 1280, YOFF_D = 1792;
constexpr size_t WS_MG = al256(WS_Y + (size_t)MT * YK * 2);
constexpr size_t WS_TAPS = WS_MG;
constexpr size_t MG_BYTES = (size_t)MT * D * 4 > (size_t)2048 * MT * 2 ? (size_t)MT * D * 4 : (size_t)2048 * MT * 2;
constexpr size_t WS_XC = al256(WS_MG + MG_BYTES);
constexpr size_t WS_XCT = al256(WS_XC + (size_t)MT * XBC * 2);
constexpr size_t WS_DT = al256(WS_XCT + (size_t)1280 * MT * 2);
constexpr size_t WS_ACUM = al256(WS_DT + (size_t)MT * 24 * 4);
constexpr size_t WS_CDEC = al256(WS_ACUM + (size_t)2 * NH * MT * 4);
constexpr size_t WS_ST = al256(WS_CDEC + (size_t)2 * NCH * NH * 4);
constexpr size_t WS_HIN = al256(WS_ST + (size_t)2 * NCH * NH * HD * NS * 4);
constexpr size_t WS_SSQ = al256(WS_HIN + (size_t)2 * NCH * NH * HD * NS * 2);
constexpr size_t WS_QT = al256(WS_SSQ + (size_t)MT * 24 * 4);
constexpr size_t WS_HID2 = al256(WS_QT + (size_t)1536 * MT * 2);
constexpr size_t WS_YCT = al256(WS_HID2 + (size_t)MT * 64 * 4);
constexpr size_t WS_FSCR = al256(WS_YCT + (size_t)512 * MT * 2);
constexpr size_t WS_ZSCR = al256(WS_FSCR + (size_t)256 * (SEQ / 2 + 1) * 16);
constexpr size_t WS_ROUTE = al256(WS_ZSCR + (size_t)256 * (SEQ / 2) * 8);
constexpr size_t WS_POS = al256(WS_ROUTE + (size_t)MT * 16);
constexpr size_t WS_HIST = al256(WS_POS + (size_t)MT * 8);
constexpr size_t WS_TILEE = al256(WS_HIST + 256 * 32 * 4);
constexpr size_t WS_END = al256(WS_TILEE + (NTMAX + 64) * 4);
constexpr int CW_BAR = 0;
constexpr int CW_QUEUE = 4096;

#ifdef CPU_EMU
#define LAS
#define GAS
#else
#define LAS __attribute__((address_space(3)))
#define GAS __attribute__((address_space(1)))
#endif
typedef unsigned short bf16;
typedef unsigned v4u __attribute__((ext_vector_type(4)));
typedef unsigned v2u __attribute__((ext_vector_type(2)));
typedef float f32x4 __attribute__((ext_vector_type(4)));
typedef float f32x2 __attribute__((ext_vector_type(2)));
typedef short bf16x8 __attribute__((ext_vector_type(8)));
typedef float f32x16 __attribute__((ext_vector_type(16)));
#define MFMA32(a, b, c) __builtin_amdgcn_mfma_f32_32x32x16_bf16(a, b, c, 0, 0, 0)
#ifdef CPU_EMU
__device__ __forceinline__ unsigned f2bf(float f) { unsigned u = __builtin_bit_cast(unsigned, f); return (u + 0x7fffu + ((u >> 16) & 1u)) >> 16; }
__device__ __forceinline__ unsigned pk2(float lo, float hi) { return f2bf(lo) | (f2bf(hi) << 16); }
#else
__device__ __forceinline__ unsigned f2bf(float f) { unsigned r; asm("v_cvt_pk_bf16_f32 %0, %1, 0" : "=v"(r) : "v"(f)); return r; }
__device__ __forceinline__ unsigned pk2(float lo, float hi) { unsigned r; asm("v_cvt_pk_bf16_f32 %0, %1, %2" : "=v"(r) : "v"(lo), "v"(hi)); return r; }
#endif
__device__ __forceinline__ float bf2f(unsigned h) { return __builtin_bit_cast(float, (h & 0xffffu) << 16); }
__device__ __forceinline__ float u2f(unsigned u) { return __builtin_bit_cast(float, u); }
__device__ __forceinline__ unsigned f2u(float f) { return __builtin_bit_cast(unsigned, f); }
__device__ __forceinline__ float bflo(unsigned w) { return __builtin_bit_cast(float, w << 16); }
__device__ __forceinline__ float bfhi(unsigned w) { return __builtin_bit_cast(float, w & 0xffff0000u); }
#ifdef CPU_EMU
__device__ __forceinline__ float frcp(float x) { return 1.0f / x; }
__device__ __forceinline__ float frsq(float x) { return 1.0f / sqrtf(x); }
__device__ __forceinline__ float flog(float x) { return logf(x); }
#else
__device__ __forceinline__ float frcp(float x) { return __builtin_amdgcn_rcpf(x); }
__device__ __forceinline__ float frsq(float x) { return __builtin_amdgcn_rsqf(x); }
__device__ __forceinline__ float flog(float x) { return __logf(x); }
#endif
__device__ __forceinline__ float sigmoidf_(float x) { return frcp(1.0f + __expf(-x)); }
__device__ __forceinline__ float siluf_(float x) { return x * frcp(1.0f + __expf(-x)); }
#ifdef CPU_EMU
__device__ __forceinline__ float wave_sum(float v) {
#pragma unroll
    for (int o = 1; o < 64; o <<= 1) v += __shfl_xor(v, o);
    return v;
}
__device__ __forceinline__ float half_sum32(float v) {
#pragma unroll
    for (int o = 1; o < 32; o <<= 1) v += __shfl_xor(v, o);
    return v;
}
#else
template <int CTRL, int RMASK> __device__ __forceinline__ float dpp_add(float v) { return v + u2f((unsigned)__builtin_amdgcn_update_dpp(0, (int)f2u(v), CTRL, RMASK, 0xF, false)); }
__device__ __forceinline__ float row_sum16(float v) {
    v = dpp_add<0xB1, 0xF>(v);
    v = dpp_add<0x4E, 0xF>(v);
    v = dpp_add<0x141, 0xF>(v);
    v = dpp_add<0x140, 0xF>(v);
    return v;
}
__device__ __forceinline__ float half_sum32(float v) {
    v = row_sum16(v);
    return dpp_add<0x142, 0xA>(v);
}
__device__ __forceinline__ float wave_sum(float v) {
    v = half_sum32(v);
    v = dpp_add<0x143, 0xC>(v);
    return u2f((unsigned)__builtin_amdgcn_readlane((int)f2u(v), 63));
}
#endif
#ifdef CPU_EMU
#define LDS_WAIT()
#define VM_WAIT()
__device__ __forceinline__ void sincos_turns(float t, float& s, float& c) { s = sinf(6.283185307179586f * t); c = cosf(6.283185307179586f * t); }
#else
#define LDS_WAIT() asm volatile("s_waitcnt lgkmcnt(0)" ::: "memory")
#define VM_WAIT() asm volatile("s_waitcnt vmcnt(0)" ::: "memory")
__device__ __forceinline__ void sincos_turns(float t, float& s, float& c) { s = __builtin_amdgcn_sinf(t); c = __builtin_amdgcn_cosf(t); }
#endif

#ifndef CPU_EMU
#define XB_TMO      128
#define XB_XCNT(j)  (256  + 64 * (j))
#define XB_XSUB(j)  (1280 + 64 * (j))
#define XB_XGEN(j)  (2304 + 64 * (j))
#define XB_TOP      3328
#define XB_TOPGEN   3392
#define XCD_BAR_WORDS 3456
#define XB_SPIN_CAP (1u << 18)
__device__ __forceinline__ unsigned xb_ld(unsigned* p)              { return __hip_atomic_load(p, __ATOMIC_RELAXED, __HIP_MEMORY_SCOPE_AGENT); }
__device__ __forceinline__ unsigned xb_add(unsigned* p, unsigned v) { return __hip_atomic_fetch_add(p, v, __ATOMIC_RELAXED, __HIP_MEMORY_SCOPE_AGENT); }
__device__ __forceinline__ unsigned xb_xcc_id() { return (unsigned)__builtin_amdgcn_s_getreg((3 << 11) | 20) & 0xFu; }
#define XB_SPIN(cond, bar) do { unsigned _sp = 0; while (cond) { __builtin_amdgcn_s_sleep(1); \
    if ((++_sp & 255u) == 0u) { if (xb_ld(&(bar)[XB_TMO])) break; if (_sp > XB_SPIN_CAP) { atomicAdd(&(bar)[XB_TMO], 1u); break; } } } } while (0)
struct XcdBarrier { unsigned* bar; unsigned x; volatile LAS unsigned* st; };
__device__ __forceinline__ XcdBarrier xcd_barrier_post(unsigned* bar, volatile LAS unsigned* st) {
    XcdBarrier b; b.bar = bar; b.x = xb_xcc_id(); b.st = st;
    if (threadIdx.x == 0) (void)xb_add(&bar[XB_XCNT(b.x)], 1u);
    return b;
}
__device__ __forceinline__ void xcd_barrier_complete(unsigned* bar, unsigned x, unsigned& nloc, unsigned& nx) {
    const unsigned G = gridDim.x * gridDim.y * gridDim.z;
    unsigned sum, cnt, mine, sp = 0u;
    for (;;) {
        sum = 0u; cnt = 0u; mine = 0u;
#pragma unroll
        for (unsigned j = 0; j < 16; ++j) { const unsigned c = xb_ld(&bar[XB_XCNT(j)]); sum += c; cnt += (c > 0u) ? 1u : 0u; mine = (j == x) ? c : mine; }
        if (sum == G) break;
        __builtin_amdgcn_s_sleep(1);
        if ((++sp & 255u) == 0u) { if (xb_ld(&bar[XB_TMO])) break; if (sp > XB_SPIN_CAP) { atomicAdd(&bar[XB_TMO], 1u); break; } }
    }
    nloc = mine > 0u ? mine : 1u; nx = cnt > 0u ? cnt : 1u;
}
__device__ __forceinline__ void xcd_barrier(const XcdBarrier& b) {
    asm volatile("s_waitcnt vmcnt(0)" ::: "memory");
    __syncthreads();
    if (threadIdx.x == 0) {
        unsigned* bar = b.bar;
        __builtin_amdgcn_s_waitcnt(0);
        unsigned nloc = b.st[0], nx = b.st[1];
        if (nloc == 0u) { xcd_barrier_complete(bar, b.x, nloc, nx); b.st[0] = nloc; b.st[1] = nx; }
        const unsigned old = xb_add(&bar[XB_XSUB(b.x)], 1u);
        const unsigned gen = old / nloc;
        if (old + 1u == (gen + 1u) * nloc) {
            __builtin_amdgcn_fence(__ATOMIC_RELEASE, "agent");
            asm volatile("s_waitcnt vmcnt(0)" ::: "memory");
            const unsigned og = xb_add(&bar[XB_TOP], 1u);
            const unsigned tg = og / nx;
            if (og + 1u == (tg + 1u) * nx) xb_add(&bar[XB_TOPGEN], 1u);
            else XB_SPIN(xb_ld(&bar[XB_TOPGEN]) == tg, bar);
            __builtin_amdgcn_fence(__ATOMIC_ACQUIRE, "agent");
            xb_add(&bar[XB_XGEN(b.x)], 1u);
            asm volatile("s_waitcnt vmcnt(0)" ::: "memory");
        } else {
            XB_SPIN(xb_ld(&bar[XB_XGEN(b.x)]) == gen, bar);
            __builtin_amdgcn_fence(__ATOMIC_ACQUIRE, "agent");
            asm volatile("s_waitcnt vmcnt(0)" ::: "memory");
        }
    }
    __syncthreads();
}
#else
struct XcdBarrier { int dummy; };
__device__ __forceinline__ void xcd_barrier(const XcdBarrier&) { emu_grid_sync(); }
#endif

namespace pg8 {
constexpr int BM = 256, BK = 64, HALF = 128, HTB = HALF * BK * 2, STAGE_BYTES = 8 * HTB;
__host__ __device__ __forceinline__ int lds_byte(int r, int c) { const int st = (r >> 4) * 2 + (c >> 5), rr = r & 15, cc = c & 31, ob = rr * 64 + cc * 2; return st * 1024 + (ob ^ (((ob >> 9) & 1) << 5)); }
__host__ __device__ __forceinline__ void stage_rc(int b, int& R, int& C) { const int st = b / 1024, sb = b % 1024, swz = sb ^ (((sb >> 9) & 1) << 5); R = (st >> 1) * 16 + swz / 64; C = (st & 1) * 32 + (swz % 64) / 2; }
__host__ __device__ __forceinline__ int perm32(int rho) { const int n = rho >> 4, i = rho & 15; return 8 * (i >> 2) + 4 * n + (i & 3); }
struct Unit { int pm, pn; const char* A; const char* B; int tag; };
#ifndef CPU_EMU
__device__ __forceinline__ unsigned cvt_pk_bf16(float lo, float hi) { unsigned r; asm volatile("v_cvt_pk_bf16_f32 %0, %1, %2" : "=v"(r) : "v"(lo), "v"(hi)); return r; }
#else
__device__ __forceinline__ unsigned cvt_pk_bf16(float lo, float hi) { return pk2(lo, hi); }
#endif

template <class Epi, class Sched, bool ALIGN_EPI = false, bool SP2 = false>
__device__ __forceinline__ void gemm_phase(LAS unsigned char* lds, const int K, const Sched& S, const Epi& E, const int tid) {
    const int lane = tid & 63;
#ifdef CPU_EMU
    const int wid = tid >> 6, wr = wid >> 2, wc = wid & 3, fr = lane & 15, fq = lane >> 4;
    Unit cur;
    for (int ui = 0; S.next(ui, cur); ++ui) {
        f32x4 acc[2][2][4][2];
        const bf16* A = (const bf16*)cur.A; const bf16* B = (const bf16*)cur.B;
        for (int ai = 0; ai < 2; ++ai) for (int bj = 0; bj < 2; ++bj) for (int m = 0; m < 4; ++m) for (int n = 0; n < 2; ++n) for (int j = 0; j < 4; ++j) {
            const int r = 128 * ai + 64 * wr + 16 * m + fr;
            const int c = Epi::PERM ? (128 * bj + 32 * wc + 8 * fq + 4 * n + j) : (128 * bj + 32 * wc + 16 * n + 4 * fq + j);
            acc[ai][bj][m][n][j] = 0.f; }
        for (int t = 0; t < K / BK; ++t) {
            if constexpr (Epi::SEG) { if (t == Epi::S1 || t == Epi::S2 || t == Epi::S3) E.segment(acc, cur, t, wr, wc, fr, fq); }
            for (int ai = 0; ai < 2; ++ai) for (int bj = 0; bj < 2; ++bj) for (int m = 0; m < 4; ++m) for (int n = 0; n < 2; ++n) for (int j = 0; j < 4; ++j) {
                const int r = 128 * ai + 64 * wr + 16 * m + fr;
                const int c = Epi::PERM ? (128 * bj + 32 * wc + 8 * fq + 4 * n + j) : (128 * bj + 32 * wc + 16 * n + 4 * fq + j);
                float s = 0.f; const bf16* ar = A + (size_t)r * K + t * BK; const bf16* br = B + (size_t)c * K + t * BK;
                for (int k = 0; k < BK; ++k) s += bf2f(ar[k]) * bf2f(br[k]);
                acc[ai][bj][m][n][j] += s; }
        }
        E(acc, cur, wr, wc, fr, fq);
    }
    __syncthreads();
#else
    const int wid = __builtin_amdgcn_readfirstlane(tid >> 6), wr = wid >> 2, wc = wid & 3, fr = lane & 15, fq = lane >> 4;
    const int nt = K / BK;
    unsigned voffA[2], voffB[2];
#pragma unroll
    for (int i = 0; i < 2; ++i) { int R, C; stage_rc(tid * 16 + i * 8192, R, C); const int Rb = Epi::PERM ? ((R & ~31) + perm32(R & 31)) : R;
        voffA[i] = (unsigned)(R * K + C) * 2u; voffB[i] = (unsigned)(Rb * K + C) * 2u; }
    const size_t kstep = (size_t)(BK * 2);
    const size_t hstep = (size_t)HALF * K * 2;
    const unsigned ldsw = (unsigned)wid * 1024u;
    const int aoff = lds_byte(wr * 64 + fr, fq * 8), boff = lds_byte(wc * 32 + fr, fq * 8);
#define PG8_SA(b, h) (((b) * 2 + (h)) * HTB)
#define PG8_SB(b, h) ((4 + (b) * 2 + (h)) * HTB)
#define PG8_STAGE(bufoff, gbase, voff) do { _Pragma("unroll") for (int _i = 0; _i < 2; ++_i) \
        __builtin_amdgcn_global_load_lds((const unsigned*)((const char*)(gbase) + (voff)[_i]), (LAS unsigned*)(lds + (bufoff) + ldsw + _i * 8192), 16, 0, 0); } while (0)
#define PG8_LDA(dst, b, h) do { _Pragma("unroll") for (int m = 0; m < 4; ++m) _Pragma("unroll") for (int k = 0; k < 2; ++k) dst[m][k] = *(const LAS bf16x8*)(lds + PG8_SA(b, h) + aoff + m * 2048 + k * 1024); } while (0)
#define PG8_LDB(dst, b, h) do { _Pragma("unroll") for (int n = 0; n < 2; ++n) _Pragma("unroll") for (int k = 0; k < 2; ++k) dst[n][k] = *(const LAS bf16x8*)(lds + PG8_SB(b, h) + boff + n * 2048 + k * 1024); } while (0)
#define PG8_MMA(ai, bj, At, Bt) do { __builtin_amdgcn_s_setprio(1); _Pragma("unroll") for (int m = 0; m < 4; ++m) _Pragma("unroll") for (int n = 0; n < 2; ++n) _Pragma("unroll") for (int k = 0; k < 2; ++k) \
        acc[ai][bj][m][n] = __builtin_amdgcn_mfma_f32_16x16x32_bf16(Bt[n][k], At[m][k], acc[ai][bj][m][n], 0, 0, 0); __builtin_amdgcn_s_setprio(0); } while (0)
#define PG8_WAIT_V(n) asm volatile("s_waitcnt vmcnt(" #n ")" ::: "memory")
#define PG8_WAIT_L(n) asm volatile("s_waitcnt lgkmcnt(" #n ")" ::: "memory")
#define PG8_BAR __builtin_amdgcn_s_barrier()
#define PG8_SCHED __builtin_amdgcn_sched_barrier(0)
    Unit cur, nxt; int ui = 0;
    if (!S.next(0, cur)) return;
    f32x4 acc[2][2][4][2];
#pragma unroll
    for (int a = 0; a < 2; ++a)
#pragma unroll
        for (int b = 0; b < 2; ++b)
#pragma unroll
            for (int m = 0; m < 4; ++m)
#pragma unroll
                for (int n = 0; n < 2; ++n) acc[a][b][m][n] = (f32x4){0.f, 0.f, 0.f, 0.f};
    bf16x8 At[4][2], B0[2][2], B1[2][2];
    const char* cA = cur.A; const char* cB = cur.B;
    if constexpr (SP2) {
        PG8_STAGE(PG8_SB(0, 0), cB, voffB); PG8_STAGE(PG8_SB(0, 1), cB + hstep, voffB); PG8_STAGE(PG8_SA(0, 0), cA, voffA); PG8_STAGE(PG8_SA(0, 1), cA + hstep, voffA);
        if (wr == 1) PG8_BAR;
        PG8_WAIT_V(2); PG8_BAR;
        PG8_STAGE(PG8_SB(1, 0), cB + kstep, voffB); PG8_STAGE(PG8_SA(1, 0), cA + kstep, voffA); PG8_STAGE(PG8_SB(1, 1), cB + hstep + kstep, voffB);
        PG8_WAIT_V(6); PG8_BAR;
    } else {
        PG8_STAGE(PG8_SB(0, 0), cB, voffB); PG8_STAGE(PG8_SA(0, 0), cA, voffA); PG8_STAGE(PG8_SB(0, 1), cB + hstep, voffB); PG8_STAGE(PG8_SA(0, 1), cA + hstep, voffA);
        if (wr == 1) PG8_BAR;
        PG8_WAIT_V(4); PG8_BAR;
        PG8_STAGE(PG8_SB(1, 0), cB + kstep, voffB); PG8_STAGE(PG8_SA(1, 0), cA + kstep, voffA); PG8_STAGE(PG8_SB(1, 1), cB + hstep + kstep, voffB);
        PG8_WAIT_V(6); PG8_BAR;
    }
    for (;;) {
        const bool has_next = S.next(ui + 1, nxt);
        const char* nA = has_next ? nxt.A : cA; const char* nB = has_next ? nxt.B : cB;
        for (int t = 0; t < nt; t += 2) {
            const bool last = (t == nt - 2);
            const char* a1 = cA + (size_t)(t + 1) * kstep;
            const char* a2 = last ? nA : cA + (size_t)(t + 2) * kstep; const char* b2 = last ? nB : cB + (size_t)(t + 2) * kstep;
            const char* a3 = a2 + kstep; const char* b3 = b2 + kstep;
            if constexpr (Epi::SEG) { if (wr == 0 && (t == Epi::S1 || t == Epi::S2 || t == Epi::S3)) E.segment(acc, cur, t, wr, wc, fr, fq); }
            if constexpr (SP2) {
            PG8_LDB(B0, 0, 0); PG8_LDB(B1, 0, 1); PG8_SCHED; PG8_LDA(At, 0, 0); PG8_STAGE(PG8_SA(1, 1), a1 + hstep, voffA);
            PG8_WAIT_V(8); PG8_WAIT_L(0); PG8_BAR; PG8_MMA(0, 0, At, B0); PG8_MMA(0, 1, At, B1); PG8_BAR; PG8_SCHED;
            PG8_LDA(At, 0, 1); PG8_STAGE(PG8_SB(0, 0), b2, voffB); PG8_STAGE(PG8_SB(0, 1), b2 + hstep, voffB); PG8_STAGE(PG8_SA(0, 0), a2, voffA);
            PG8_WAIT_V(8); PG8_WAIT_L(0); PG8_BAR; PG8_MMA(1, 0, At, B0); PG8_MMA(1, 1, At, B1); PG8_BAR; PG8_SCHED;
            PG8_LDB(B0, 1, 0); PG8_LDB(B1, 1, 1); PG8_SCHED; PG8_LDA(At, 1, 0); PG8_STAGE(PG8_SA(0, 1), a2 + hstep, voffA);
            PG8_WAIT_V(8); PG8_WAIT_L(0); PG8_BAR; PG8_MMA(0, 0, At, B0); PG8_MMA(0, 1, At, B1); PG8_BAR; PG8_SCHED;
            PG8_LDA(At, 1, 1); PG8_STAGE(PG8_SB(1, 0), b3, voffB); PG8_STAGE(PG8_SB(1, 1), b3 + hstep, voffB); PG8_STAGE(PG8_SA(1, 0), a3, voffA);
            PG8_WAIT_V(8); PG8_WAIT_L(0); PG8_BAR; PG8_MMA(1, 0, At, B0); PG8_MMA(1, 1, At, B1);
            if constexpr (Epi::SEG) { if (wr == 1 && (t + 2 == Epi::S1 || t + 2 == Epi::S2 || t + 2 == Epi::S3)) E.segment(acc, cur, t + 2, wr, wc, fr, fq); }
            PG8_BAR; PG8_SCHED;
            } else {
            PG8_LDB(B0, 0, 0); PG8_SCHED; PG8_LDA(At, 0, 0); PG8_STAGE(PG8_SA(1, 1), a1 + hstep, voffA);
            PG8_WAIT_L(8); PG8_BAR; PG8_WAIT_L(0); PG8_MMA(0, 0, At, B0); PG8_BAR; PG8_SCHED;
            PG8_LDB(B1, 0, 1); PG8_STAGE(PG8_SB(0, 0), b2, voffB);
            PG8_BAR; PG8_WAIT_L(0); PG8_MMA(0, 1, At, B1); PG8_BAR;
            PG8_LDA(At, 0, 1); PG8_STAGE(PG8_SA(0, 0), a2, voffA);
            PG8_BAR; PG8_WAIT_L(0); PG8_MMA(1, 0, At, B0); PG8_BAR; PG8_SCHED;
            PG8_STAGE(PG8_SB(0, 1), b2 + hstep, voffB);
            PG8_WAIT_V(6); PG8_BAR; PG8_MMA(1, 1, At, B1); PG8_BAR;
            PG8_LDB(B0, 1, 0); PG8_SCHED; PG8_LDA(At, 1, 0); PG8_STAGE(PG8_SA(0, 1), a2 + hstep, voffA);
            PG8_WAIT_L(8); PG8_BAR; PG8_WAIT_L(0); PG8_MMA(0, 0, At, B0); PG8_BAR; PG8_SCHED;
            PG8_LDB(B1, 1, 1); PG8_STAGE(PG8_SB(1, 0), b3, voffB);
            PG8_BAR; PG8_WAIT_L(0); PG8_MMA(0, 1, At, B1); PG8_BAR;
            PG8_LDA(At, 1, 1); PG8_STAGE(PG8_SA(1, 0), a3, voffA);
            PG8_BAR; PG8_WAIT_L(0); PG8_MMA(1, 0, At, B0); PG8_BAR; PG8_SCHED;
            PG8_STAGE(PG8_SB(1, 1), b3 + hstep, voffB);
            PG8_WAIT_V(6); PG8_BAR; PG8_MMA(1, 1, At, B1); PG8_BAR;
            }
        }
        if constexpr (ALIGN_EPI) { if (wr == 0) PG8_BAR; }
        E(acc, cur, wr, wc, fr, fq);
        if (!has_next) break;
#pragma unroll
        for (int a = 0; a < 2; ++a)
#pragma unroll
            for (int b = 0; b < 2; ++b)
#pragma unroll
                for (int m = 0; m < 4; ++m)
#pragma unroll
                    for (int n = 0; n < 2; ++n) acc[a][b][m][n] = (f32x4){0.f, 0.f, 0.f, 0.f};
        cur = nxt; cA = nA; cB = nB; ++ui;
        if constexpr (ALIGN_EPI) { if (wr == 1) PG8_BAR; }
    }
    PG8_WAIT_V(0);
    if constexpr (!ALIGN_EPI) { if (wr == 0) PG8_BAR; }
    PG8_BAR;
#undef PG8_SA
#undef PG8_SB
#undef PG8_STAGE
#undef PG8_LDA
#undef PG8_LDB
#undef PG8_MMA
#undef PG8_WAIT_V
#undef PG8_WAIT_L
#undef PG8_BAR
#undef PG8_SCHED
#endif
}
}

struct KParams { const float* in[N_IN]; float* out; unsigned char* ws; int ph_lo, ph_hi; };
#ifdef CPU_EMU
typedef const KParams& KPR;
static const KParams* g_emu_kp = nullptr;
#define KP_DECL KPR p = *g_emu_kp
#define NOINLINE inline
#define UNI(x) (x)
#define LDS_DECL LAS unsigned char* lds = emu_lds_ptr
#define OPAQUE_V(x)
#define OPAQUE_S(x)
#else
typedef const KParams __attribute__((address_space(4)))& KPR;
#define KP_DECL const KParams __attribute__((address_space(4)))* kp_ = (const KParams __attribute__((address_space(4)))*)__builtin_amdgcn_kernarg_segment_ptr(); asm volatile("" : "+s"(kp_)); KPR p = *kp_
#define NOINLINE __forceinline__
#define UNI(x) __builtin_amdgcn_readfirstlane(x)
extern __shared__ __attribute__((aligned(16))) unsigned char lds_raw[];
#define LDS_DECL LAS unsigned char* lds = (LAS unsigned char*)lds_raw
#define OPAQUE_V(x) asm volatile("" : "+v"(x))
#define OPAQUE_S(x) asm volatile("" : "+s"(x))
#endif
#define ENTRY_BEGIN KP_DECL; LDS_DECL; int tid = threadIdx.x; OPAQUE_V(tid); int bid = blockIdx.x; OPAQUE_S(bid); const int lane = tid & 63, G = gridDim.x; const int wave = UNI(tid >> 6); const int gw = bid * NWAVES + wave, NGW = G * NWAVES; (void)lane; (void)gw; (void)NGW; (void)lds
#ifdef CPU_EMU
#define WAVE_SYNC() emu_wave_sync()
#else
#define WAVE_SYNC() do { asm volatile("s_waitcnt lgkmcnt(0)" ::: "memory"); __builtin_amdgcn_wave_barrier(); } while (0)
#endif
#define WSP(T, off) ((T*)(p.ws + (off)))
#ifdef CPU_EMU
#define CFENCE()
#define SCHED_FENCE()
#else
#define CFENCE() asm volatile("" ::: "memory")
#define SCHED_FENCE() __builtin_amdgcn_sched_barrier(0)
#endif
__device__ __forceinline__ float* hrow(KPR p, int t) { return t < SEQ ? p.out + (size_t)t * D : WSP(float, WS_HC) + (size_t)(t - SEQ) * D; }
__device__ __forceinline__ const float* modv(KPR p, int l, int which, int part) { return WSP(float, WS_MODV) + ((size_t)(l * 2 + which) * 6 + part) * D; }

struct DenseOrder {
    int nM, nN, nwg, G, c; const char* A; const char* B; size_t astep, bstep;
    __device__ __forceinline__ void init(int M, int N, int K, int G_, int c_, const void* A_, const void* B_) { nM = M / 256; nN = N / 256; nwg = nM * nN; G = G_; c = c_; A = (const char*)A_; B = (const char*)B_; astep = (size_t)256 * K * 2; bstep = astep; }
    __device__ __forceinline__ bool next(int i, pg8::Unit& u) const {
        const long L = (long)i * G + c; if (L >= nwg) return false;
        int wgid = (int)L; { const int q = nwg / 8, r = nwg % 8, xcd = wgid % 8, off = wgid / 8; wgid = (xcd < r ? xcd * (q + 1) : r * (q + 1) + (xcd - r) * q) + off; }
        const int nig = 8 * nN, gid = wgid / nig, fm = gid * 8, gsz = (nM - fm) < 8 ? (nM - fm) : 8;
        u.pm = fm + ((wgid % nig) % gsz); u.pn = (wgid % nig) / gsz; u.A = A + (size_t)u.pm * astep; u.B = B + (size_t)u.pn * bstep; u.tag = i; return true;
    }
};
struct MoeOrder {
    const int* tile_e; int ntiles, nN, G, c; const char* A; const char* B; size_t astep, bstepE, bstepN;
    __device__ __forceinline__ bool next(int i, pg8::Unit& u) const {
        int tile, pn;
        if ((G & 7) == 0) {
            const int xcd = c & 7, rank = c >> 3, W = G >> 3, q = ntiles / 8, r = ntiles % 8;
            const int tb = xcd < r ? xcd * (q + 1) : r * (q + 1) + (xcd - r) * q, nt = xcd < r ? q + 1 : q;
            const int L = i * W + rank; if (L >= nt * nN) return false;
            tile = tb + L / nN; pn = L % nN;
        } else { const long L = (long)i * G + c; if (L >= (long)ntiles * nN) return false; tile = (int)(L / nN); pn = (int)(L % nN); }
        const int e = tile_e[tile];
        u.pm = tile; u.pn = pn; u.A = A + (size_t)tile * astep; u.B = B + (size_t)e * bstepE + (size_t)pn * bstepN; u.tag = 0; return true;
    }
};

__device__ __forceinline__ void unpack8(const v4u w, float (&f)[8]) { f[0] = bflo(w.x); f[1] = bfhi(w.x); f[2] = bflo(w.y); f[3] = bfhi(w.y); f[4] = bflo(w.z); f[5] = bfhi(w.z); f[6] = bflo(w.w); f[7] = bfhi(w.w); }
struct EpiPG {
    static constexpr bool PERM = true, SEG = false; static constexpr int S1 = -1, S2 = -1, S3 = -1;
    bf16* O; int ldc;
    __device__ __forceinline__ void operator()(const f32x4 (&acc)[2][2][4][2], const pg8::Unit& u, int wr, int wc, int fr, int fq) const {
        const int row0 = u.pm * 256 + wr * 64 + fr;
        if (u.pn < 4) {
            const int col0 = (u.pn * 256 + wc * 32 + 8 * fq) / 2;
#pragma unroll
            for (int ai = 0; ai < 2; ++ai)
#pragma unroll
                for (int m = 0; m < 4; ++m) { bf16* rowp = O + (size_t)(row0 + ai * 128 + m * 16) * ldc + col0;
#pragma unroll
                    for (int bj = 0; bj < 2; ++bj) { const f32x4 v0 = acc[ai][bj][m][0], v1 = acc[ai][bj][m][1];
                        v2u w; w.x = pg8::cvt_pk_bf16(v0[0] * sigmoidf_(v0[1]), v0[2] * sigmoidf_(v0[3])); w.y = pg8::cvt_pk_bf16(v1[0] * sigmoidf_(v1[1]), v1[2] * sigmoidf_(v1[3]));
                        *(v2u*)(rowp + bj * 64) = w; } }
        } else {
            const int col0 = u.pn * 256 + wc * 32 + 8 * fq;
#pragma unroll
            for (int ai = 0; ai < 2; ++ai)
#pragma unroll
                for (int m = 0; m < 4; ++m) { bf16* rowp = O + (size_t)(row0 + ai * 128 + m * 16) * ldc + col0;
#pragma unroll
                    for (int bj = 0; bj < 2; ++bj) { const f32x4 v0 = acc[ai][bj][m][0], v1 = acc[ai][bj][m][1];
                        v4u w; w.x = pg8::cvt_pk_bf16(v0[0], v0[1]); w.y = pg8::cvt_pk_bf16(v0[2], v0[3]); w.z = pg8::cvt_pk_bf16(v1[0], v1[1]); w.w = pg8::cvt_pk_bf16(v1[2], v1[3]);
                        *(v4u*)(rowp + bj * 128) = w; } }
        }
    }
};
struct EpiP {
    static constexpr bool PERM = true, SEG = false; static constexpr int S1 = -1, S2 = -1, S3 = -1;
    bf16* O; int ldc;
    __device__ __forceinline__ void operator()(const f32x4 (&acc)[2][2][4][2], const pg8::Unit& u, int wr, int wc, int fr, int fq) const {
        const int row0 = u.pm * 256 + wr * 64 + fr, col0 = u.pn * 256 + wc * 32 + 8 * fq;
#pragma unroll
        for (int ai = 0; ai < 2; ++ai)
#pragma unroll
            for (int m = 0; m < 4; ++m) { bf16* rowp = O + (size_t)(row0 + ai * 128 + m * 16) * ldc + col0;
#pragma unroll
                for (int bj = 0; bj < 2; ++bj) { const f32x4 v0 = acc[ai][bj][m][0], v1 = acc[ai][bj][m][1];
                    v4u w; w.x = pg8::cvt_pk_bf16(v0[0], v0[1]); w.y = pg8::cvt_pk_bf16(v0[2], v0[3]); w.z = pg8::cvt_pk_bf16(v1[0], v1[1]); w.w = pg8::cvt_pk_bf16(v1[2], v1[3]);
                    *(v4u*)(rowp + bj * 128) = w; } }
    }
};
#ifdef CPU_EMU
__device__ __forceinline__ float gate_den(float x) { return 1.0f + __expf(-fminf(fmaxf(x, -30.f), 30.f)); }
#else
__device__ __forceinline__ float gate_den(float x) { return 1.0f + __expf(-__builtin_amdgcn_fmed3f(x, -30.f, 30.f)); }
#endif
struct EpiMerge {
    static constexpr bool PERM = true, SEG = true; static constexpr int S1 = 8, S2 = 20, S3 = 28;
    const bf16* Pg; bf16* MGb; const LAS float* rs;
    __device__ __forceinline__ void segment(f32x4 (&acc)[2][2][4][2], const pg8::Unit& u, int t, int wr, int wc, int fr, int fq) const {
        const int br = (t == S1) ? 0 : (t == S2 ? 1 : 2);
        int row0 = u.pm * 256 + wr * 64 + fr; OPAQUE_V(row0);
        const int col0 = u.pn * 256 + wc * 32 + 8 * fq;
#pragma unroll
        for (int ai = 0; ai < 2; ++ai)
#pragma unroll
            for (int m = 0; m < 4; ++m) { const int rl = wr * 64 + fr + ai * 128 + m * 16, row = row0 + ai * 128 + m * 16;
                const float rsv = rs[u.tag * 256 + rl]; const float sc = (br == 0) ? frcp(rsv) : (br == 1 ? rsv : 1.f);
                const bf16* gp = Pg + (size_t)row * NP + br * D + col0;
#pragma unroll
                for (int bj = 0; bj < 2; ++bj) { float a[8], b[8]; unpack8(*(const v4u*)(gp + bj * 128), a); unpack8(*(const v4u*)(gp + D + bj * 128), b);
#pragma unroll
                    for (int j = 0; j < 4; ++j) { acc[ai][bj][m][0][j] *= gate_den(b[j]) * frcp(gate_den(a[j])) * sc; acc[ai][bj][m][1][j] *= gate_den(b[4 + j]) * frcp(gate_den(a[4 + j])) * sc; } }
                if (m & 1) CFENCE(); }
    }
    __device__ __forceinline__ void operator()(const f32x4 (&acc)[2][2][4][2], const pg8::Unit& u, int wr, int wc, int fr, int fq) const {
        const int row0 = u.pm * 256 + wr * 64 + fr, col0 = u.pn * 256 + wc * 32 + 8 * fq;
#pragma unroll
        for (int ai = 0; ai < 2; ++ai)
#pragma unroll
            for (int m = 0; m < 4; ++m) { const int row = row0 + ai * 128 + m * 16; const bf16* gp = Pg + (size_t)row * NP + 3 * D + col0;
#pragma unroll
                for (int bj = 0; bj < 2; ++bj) { float g[8]; unpack8(*(const v4u*)(gp + bj * 128), g); const f32x4 v0 = acc[ai][bj][m][0], v1 = acc[ai][bj][m][1];
                    v4u w; w.x = pg8::cvt_pk_bf16(v0[0] * frcp(gate_den(g[0])), v0[1] * frcp(gate_den(g[1]))); w.y = pg8::cvt_pk_bf16(v0[2] * frcp(gate_den(g[2])), v0[3] * frcp(gate_den(g[3])));
                    w.z = pg8::cvt_pk_bf16(v1[0] * frcp(gate_den(g[4])), v1[1] * frcp(gate_den(g[5]))); w.w = pg8::cvt_pk_bf16(v1[2] * frcp(gate_den(g[6])), v1[3] * frcp(gate_den(g[7])));
                    *(v4u*)(MGb + (size_t)row * D + col0 + bj * 128) = w; }
                if (m & 1) CFENCE(); }
    }
};
struct EpiSwiGLU {
    static constexpr bool PERM = true, SEG = false; static constexpr int S1 = -1, S2 = -1, S3 = -1;
    bf16* HS;
    __device__ __forceinline__ void operator()(const f32x4 (&acc)[2][2][4][2], const pg8::Unit& u, int wr, int wc, int fr, int fq) const {
        const int row0 = u.pm * 256 + wr * 64 + fr, col0 = (u.pn * 256 + wc * 32 + 8 * fq) / 2;
#pragma unroll
        for (int ai = 0; ai < 2; ++ai)
#pragma unroll
            for (int m = 0; m < 4; ++m) { bf16* rowp = HS + (size_t)(row0 + ai * 128 + m * 16) * FF + col0;
#pragma unroll
                for (int bj = 0; bj < 2; ++bj) { const f32x4 v0 = acc[ai][bj][m][0], v1 = acc[ai][bj][m][1];
                    v2u w; w.x = pg8::cvt_pk_bf16(siluf_(v0[0]) * v0[1], siluf_(v0[2]) * v0[3]); w.y = pg8::cvt_pk_bf16(siluf_(v1[0]) * v1[1], siluf_(v1[2]) * v1[3]);
                    *(v2u*)(rowp + bj * 64) = w; } }
    }
};
struct EpiF32 {
    static constexpr bool PERM = false, SEG = false; static constexpr int S1 = -1, S2 = -1, S3 = -1;
    float* C; int ldc;
    __device__ __forceinline__ void operator()(const f32x4 (&acc)[2][2][4][2], const pg8::Unit& u, int wr, int wc, int fr, int fq) const {
        const int row0 = u.pm * 256 + wr * 64 + fr, col0 = u.pn * 256 + wc * 32 + 4 * fq;
#pragma unroll
        for (int ai = 0; ai < 2; ++ai)
#pragma unroll
            for (int m = 0; m < 4; ++m) { float* rowp = C + (size_t)(row0 + ai * 128 + m * 16) * ldc + col0;
#pragma unroll
                for (int bj = 0; bj < 2; ++bj)
#pragma unroll
                    for (int n = 0; n < 2; ++n) *(f32x4*)(rowp + bj * 128 + n * 16) = acc[ai][bj][m][n]; }
    }
};

struct TrDesc { const float* W; bf16* WT; int ldw, N, drow0, rstride, kb, nb, ldk, koff; };
__device__ __forceinline__ void tr_load(const TrDesc& d, int lane, f32x4 (&v)[16]) {
    const int k0 = 64 * d.kb, n = 64 * d.nb + (lane & 15) * 4, r4 = lane >> 4;
#pragma unroll
    for (int i = 0; i < 16; ++i) { const int kk = 4 * i + r4; const float* src = d.W + (size_t)(k0 + kk) * d.ldw + n;
        f32x4 t = (f32x4){0.f, 0.f, 0.f, 0.f};
        if (n + 3 < d.N) t = *(const f32x4*)src;
        else { if (n < d.N) t[0] = src[0]; if (n + 1 < d.N) t[1] = src[1]; if (n + 2 < d.N) t[2] = src[2]; }
        v[i] = t; }
}
__device__ __forceinline__ void tr_store(const TrDesc& d, LAS float* scr, int lane, const f32x4 (&v)[16]) {
    const int k0 = 64 * d.kb, n0 = 64 * d.nb, c4 = (lane & 15) * 4, r4 = lane >> 4;
#pragma unroll
    for (int i = 0; i < 16; ++i) { LAS float* q = scr + (4 * i + r4) * 65 + c4; q[0] = v[i][0]; q[1] = v[i][1]; q[2] = v[i][2]; q[3] = v[i][3]; }
    WAVE_SYNC();
#pragma unroll
    for (int j = 0; j < 8; ++j) { const int q = lane + 64 * j, n = q >> 3, kc = q & 7; const LAS float* s = scr + (8 * kc) * 65 + n;
        v4u o; o.x = pk2(s[0 * 65], s[1 * 65]); o.y = pk2(s[2 * 65], s[3 * 65]); o.z = pk2(s[4 * 65], s[5 * 65]); o.w = pk2(s[6 * 65], s[7 * 65]);
        if (n0 + n < d.N) *(v4u*)(d.WT + (size_t)(d.drow0 + (n0 + n) * d.rstride) * d.ldk + d.koff + k0 + 8 * kc) = o; }
    WAVE_SYNC();
}
constexpr int CV_NB0 = (PROJ + 63) / 64, CV_S0 = (D / 64) * CV_NB0, CV_S1 = (512 / 64) * (D / 64), CV_S2 = (768 / 64) * (D / 64), CV_S5 = (D / 64) * (D / 64),
              CV_S6 = NE * (D / 64) * (FF / 64), CV_S8 = NE * (FF / 64) * (D / 64), CV_TOT = CV_S0 + 3 * CV_S1 + CV_S2 + CV_S5 + 2 * CV_S6 + CV_S8;
__device__ __forceinline__ TrDesc conv_desc(KPR p, int l, int it) {
    TrDesc d; int r = it;
    if (r < CV_S0) { const int nb = r % CV_NB0, n0 = 64 * nb;
        d.W = p.in[I_WIN] + (size_t)l * D * PROJ; d.WT = WSP(bf16, WS_WIN); d.ldw = PROJ; d.N = PROJ; d.drow0 = n0 < 512 ? 0 : (n0 < 1024 ? -1023 : 0); d.rstride = n0 < 1024 ? 2 : 1; d.kb = r / CV_NB0; d.nb = nb; d.ldk = D; d.koff = 0; return d; } r -= CV_S0;
    d.ldw = D; d.N = D; d.drow0 = 0; d.rstride = 1; d.kb = r / (D / 64); d.nb = r % (D / 64); d.WT = WSP(bf16, WS_WCAT); d.ldk = YK;
    if (r < CV_S1) { d.W = p.in[I_WBA] + (size_t)l * 512 * D; d.koff = YOFF_A; return d; } r -= CV_S1; d.kb = r / (D / 64); d.nb = r % (D / 64);
    if (r < CV_S2) { d.W = p.in[I_WBB] + (size_t)l * 768 * D; d.koff = YOFF_B; return d; } r -= CV_S2; d.kb = r / (D / 64); d.nb = r % (D / 64);
    if (r < CV_S1) { d.W = p.in[I_WBC] + (size_t)l * 512 * D; d.koff = YOFF_C; return d; } r -= CV_S1; d.kb = r / (D / 64); d.nb = r % (D / 64);
    if (r < CV_S1) { d.W = p.in[I_WBD] + (size_t)l * 512 * D; d.koff = YOFF_D; return d; } r -= CV_S1; d.kb = r / (D / 64); d.nb = r % (D / 64);
    if (r < CV_S5) { d.W = p.in[I_WOUT] + (size_t)l * D * D; d.WT = WSP(bf16, WS_WOUT); d.ldk = D; d.koff = 0; return d; } r -= CV_S5;
    if (r < 2 * CV_S6) { const int up = r >= CV_S6; if (up) r -= CV_S6; const int e = r / ((D / 64) * (FF / 64)), q = r % ((D / 64) * (FF / 64));
        d.W = p.in[up ? I_EWU : I_EWG] + ((size_t)l * NE + e) * D * FF; d.WT = WSP(bf16, WS_WGU) + (size_t)e * 2 * FF * D; d.ldw = FF; d.N = FF; d.drow0 = up; d.rstride = 2; d.kb = q / (FF / 64); d.nb = q % (FF / 64); d.ldk = D; d.koff = 0; return d; } r -= 2 * CV_S6;
    { const int e = r / ((FF / 64) * (D / 64)), q = r % ((FF / 64) * (D / 64));
      d.W = p.in[I_EWD] + ((size_t)l * NE + e) * FF * D; d.WT = WSP(bf16, WS_WDN) + (size_t)e * D * FF; d.ldw = D; d.N = D; d.drow0 = 0; d.rstride = 1; d.kb = q / (D / 64); d.nb = q % (D / 64); d.ldk = FF; d.koff = 0; }
    return d;
}
__device__ __forceinline__ void conv_weights(KPR p, int l, LAS unsigned char* lds, int gw, int NGW, int lane, int wave) {
    LAS float* scr = (LAS float*)(lds + wave * 17408);
    if (gw < CV_TOT) {
        f32x4 cur[16], nxt[16];
        TrDesc dc = conv_desc(p, l, gw); tr_load(dc, lane, cur);
        for (int it = gw; it < CV_TOT; it += NGW) {
            const int ni = it + NGW; const bool hn = ni < CV_TOT; TrDesc dn = dc;
            if (hn) { dn = conv_desc(p, l, ni); tr_load(dn, lane, nxt); }
            tr_store(dc, scr, lane, cur);
            if (hn) { dc = dn;
#pragma unroll
                for (int i = 0; i < 16; ++i) cur[i] = nxt[i]; }
        }
    }
    { const int nchunks = (NP - PROJ) * D / 8; unsigned zz_ = 0u; OPAQUE_V(zz_); v4u z; z.x = zz_; z.y = zz_; z.z = zz_; z.w = zz_;
      for (int i = gw * 64 + lane; i < nchunks; i += NGW * 64) *(v4u*)(WSP(bf16, WS_WIN) + (size_t)PROJ * D + (size_t)i * 8) = z; }
}

__device__ __forceinline__ void phase_mod(KPR p, LAS unsigned char* lds, int tid, int bid, int G) {
    LAS float* red = (LAS float*)lds;
    const int lane = tid & 63, kg = tid >> 6;
    constexpr int NCB = 6 * D / 64;
    for (int it = bid; it < DEPTH * NCB; it += G) {
        const int l = it / NCB, col = (it % NCB) * 64 + lane;
        const float* W = p.in[I_WMOD] + (size_t)l * D * 6 * D;
        float a0 = 0.f, a1 = 0.f;
        for (int k0 = kg * (D / 8); k0 < (kg + 1) * (D / 8); k0 += 16) {
            float w[16];
#pragma unroll
            for (int j = 0; j < 16; ++j) w[j] = W[(size_t)(k0 + j) * 6 * D + col];
#pragma unroll
            for (int j = 0; j < 16; ++j) { a0 += siluf_(p.in[I_C][k0 + j]) * w[j]; a1 += siluf_(p.in[I_CCTX][k0 + j]) * w[j]; } }
        red[(kg * 64 + lane) * 2 + 0] = a0; red[(kg * 64 + lane) * 2 + 1] = a1;
        __syncthreads();
        if (tid < 64) { float s0 = 0.f, s1 = 0.f;
            for (int q = 0; q < 8; ++q) { s0 += red[(q * 64 + lane) * 2]; s1 += red[(q * 64 + lane) * 2 + 1]; }
            const float b = p.in[I_BMOD][(size_t)l * 6 * D + col];
            WSP(float, WS_MODV)[(size_t)(l * 2 + 0) * 6 * D + col] = s0 + b; WSP(float, WS_MODV)[(size_t)(l * 2 + 1) * 6 * D + col] = s1 + b; }
        __syncthreads();
    }
}
__device__ __forceinline__ void phase_u0(KPR p, int gw, int NGW, int lane) {
    for (int t = gw; t < MT; t += NGW) {
        const int which = t < SEQ ? 0 : 1;
        const float* src = t < SEQ ? p.in[I_X] + (size_t)t * D : p.in[I_CTX] + (size_t)(t - SEQ) * D;
        float* h = hrow(p, t); const float* sh = modv(p, 0, which, 0); const float* sc = modv(p, 0, which, 1);
        bf16* u = WSP(bf16, WS_U) + (size_t)t * D;
#pragma unroll
        for (int j = 0; j < D / 256; ++j) { const int c = 4 * lane + 256 * j;
            const f32x4 x = *(const f32x4*)(src + c), s = *(const f32x4*)(sh + c), q = *(const f32x4*)(sc + c);
            *(f32x4*)(h + c) = x;
            v2u w; w.x = pk2(x[0] * (1.f + q[0]) + s[0], x[1] * (1.f + q[1]) + s[1]); w.y = pk2(x[2] * (1.f + q[2]) + s[2], x[3] * (1.f + q[3]) + s[3]);
            *(v2u*)(u + c) = w; }
    }
}

constexpr int C1_RB = ROWS >= 64 ? 64 : ROWS, C1_NRB = ROWS / C1_RB, C1_LAT = GRID_W * C1_NRB, C1_IN = C1_RB + CONF_K - 1, C1_INMAX = 64 + CONF_K - 1;
static_assert(ROWS % C1_RB == 0 && C1_RB % 8 == 0 && C1_INMAX * 1024 + CONF_K * CONF_D * 4 <= 163840 - 256 && CTX % 64 == 0 && CONF_K == 31 && CONF_D == 512, "c1 geometry");
__device__ __forceinline__ void c1_conformer(KPR p, int l, LAS unsigned char* lds, int idx, int tid) {
    const bf16* P = WSP(bf16, WS_P);
    const int lane = tid & 63, wave = tid >> 6;
    const int cg = tid & 63, tg = tid >> 6;
    const bool isctx = idx >= C1_LAT;
    LAS float* tile = (LAS float*)lds;
    LAS bf16* inb = (LAS bf16*)lds;
    LAS float* wsm = (LAS float*)(lds + C1_INMAX * 1024);
    const int gc = idx % GRID_W, rb = idx / GRID_W;
    const int RB = isctx ? 64 : C1_RB, NIN = RB + CONF_K - 1, rlim = isctx ? CTX : ROWS;
    const int rbase = isctx ? (idx - C1_LAT) * 64 : rb * C1_RB, r0 = rbase - 15;
    float acc[8][8];
    {
        { constexpr int NL = (C1_INMAX + NWAVES - 1) / NWAVES, NLH = (NL + 1) / 2;
#pragma unroll 1
          for (int q0 = 0; q0 < NL; q0 += NLH) { v4u tmp[NLH];
#pragma unroll
            for (int q = 0; q < NLH; ++q) { const int i = wave + NWAVES * (q0 + q), r = r0 + i; unsigned zz_ = 0u; OPAQUE_V(zz_); tmp[q].x = zz_; tmp[q].y = zz_; tmp[q].z = zz_; tmp[q].w = zz_;
                if (i < NIN && r >= 0 && r < rlim) { const size_t tok = isctx ? (size_t)(SEQ + r) : (size_t)r * GRID_W + gc; tmp[q] = *(const v4u*)(P + tok * NP + 8 * lane); } }
#pragma unroll
            for (int q = 0; q < NLH; ++q) { const int i = wave + NWAVES * (q0 + q); if (i < NIN) *(LAS v4u*)(inb + i * 512 + 8 * lane) = tmp[q]; } } }
        { constexpr int NW4 = CONF_K * CONF_D / 4, NQ = (NW4 + NTHR - 1) / NTHR, NQH = (NQ + 1) / 2; const float* cwl = p.in[I_CDWW] + (size_t)l * CONF_K * CONF_D;
#pragma unroll 1
          for (int q0 = 0; q0 < NQ; q0 += NQH) { f32x4 tw[NQH];
#pragma unroll
            for (int q = 0; q < NQH; ++q) { const int i4 = tid + NTHR * (q0 + q); tw[q] = *(const f32x4*)(cwl + 4 * (i4 < NW4 ? i4 : NW4 - 1)); }
#pragma unroll
            for (int q = 0; q < NQH; ++q) { const int i4 = tid + NTHR * (q0 + q); if (i4 < NW4) *(LAS f32x4*)(wsm + 4 * i4) = tw[q]; } } }
        __syncthreads();
#pragma unroll
        for (int a = 0; a < 8; ++a)
#pragma unroll
            for (int b = 0; b < 8; ++b) acc[a][b] = 0.f;
        if (8 * tg < RB) {
            float win[8][8];
#pragma unroll
            for (int a = 0; a < 8; ++a) unpack8(*(const LAS v4u*)(inb + (8 * tg + a) * 512 + 8 * cg), win[a]);
#pragma unroll 1
            for (int j0 = 0; j0 < 32; j0 += 8) {
#pragma unroll
                for (int jj = 0; jj < 8; ++jj) { const int j = j0 + jj, jc = j < CONF_K ? j : CONF_K - 1; const float m = j < CONF_K ? 1.f : 0.f;
                    const f32x4 w0 = *(const LAS f32x4*)(wsm + jc * CONF_D + 8 * cg) * m, w1 = *(const LAS f32x4*)(wsm + jc * CONF_D + 8 * cg + 4) * m;
                    const float wj[8] = {w0[0], w0[1], w0[2], w0[3], w1[0], w1[1], w1[2], w1[3]};
#pragma unroll
                    for (int a = 0; a < 8; ++a)
#pragma unroll
                        for (int b = 0; b < 8; ++b) acc[a][b] += wj[b] * win[(a + jj) & 7][b];
                    int inext = 8 * tg + j + 8; inext = inext < NIN ? inext : NIN - 1;
#ifndef CPU_EMU
                    asm volatile("" : "+v"(inext), "+v"(acc[7][7]));
#endif
                    unpack8(*(const LAS v4u*)(inb + inext * 512 + 8 * cg), win[jj]); }
            }
        }
        __syncthreads();
    }
    { const f32x4 b0 = *(const f32x4*)(p.in[I_CDWB] + l * CONF_D + 8 * cg), b1 = *(const f32x4*)(p.in[I_CDWB] + l * CONF_D + 8 * cg + 4);
#pragma unroll
      for (int a = 0; a < 8; ++a) { f32x4 o0, o1;
#pragma unroll
          for (int b = 0; b < 4; ++b) { o0[b] = acc[a][b] + b0[b]; o1[b] = acc[a][4 + b] + b1[b]; }
          *(LAS f32x4*)(tile + (8 * tg + a) * 512 + 8 * cg) = o0; *(LAS f32x4*)(tile + (8 * tg + a) * 512 + 8 * cg + 4) = o1; } }
    __syncthreads();
    const int nrow = RB;
    const float* lg = p.in[I_CLNG] + l * CONF_D + 8 * lane; const float* lb = p.in[I_CLNB] + l * CONF_D + 8 * lane;
    for (int w = wave; w < nrow; w += NWAVES) {
        const int t = isctx ? SEQ + rbase + w : (rbase + w) * GRID_W + gc;
        const f32x4 a = *(const LAS f32x4*)(tile + w * 512 + 8 * lane), b = *(const LAS f32x4*)(tile + w * 512 + 8 * lane + 4);
        const float mean = wave_sum((a[0] + a[1]) + (a[2] + a[3]) + (b[0] + b[1]) + (b[2] + b[3])) * (1.f / 512.f);
        const f32x4 da = a - mean, db = b - mean;
        const float var = wave_sum((da[0] * da[0] + da[1] * da[1]) + (da[2] * da[2] + da[3] * da[3]) + (db[0] * db[0] + db[1] * db[1]) + (db[2] * db[2] + db[3] * db[3])) * (1.f / 512.f);
        const float rstd = frsq(var + LN_EPS);
        float y[8];
#pragma unroll
        for (int i = 0; i < 4; ++i) { y[i] = siluf_(da[i] * rstd * lg[i] + lb[i]); y[4 + i] = siluf_(db[i] * rstd * lg[4 + i] + lb[4 + i]); }
        v4u o; o.x = pk2(y[0], y[1]); o.y = pk2(y[2], y[3]); o.z = pk2(y[4], y[5]); o.w = pk2(y[6], y[7]);
        *(v4u*)(WSP(bf16, WS_Y) + (size_t)t * YK + YOFF_A + 8 * lane) = o;
    }
    __syncthreads();
}
__device__ __forceinline__ void load_rows10(const bf16* src, int t0, int tg, int lo, int hi, float (&x)[10][8]) {
#pragma unroll
    for (int a = 0; a < 10; ++a) { const int t = t0 + 8 * tg + a - 1;
        if (t >= lo && t < hi) unpack8(*(const v4u*)(src + (size_t)t * NP), x[a]); else {
#pragma unroll
            for (int q = 0; q < 8; ++q) x[a][q] = 0.f; } }
}
__device__ __forceinline__ void c2_wave(KPR p, int l, int tile, int cgrp, int lane) {
    const bf16* P = WSP(bf16, WS_P);
    const int t0 = tile * 64, lo = t0 < SEQ ? 0 : SEQ, hi = t0 < SEQ ? SEQ : MT, cg = lane & 7, tg = lane >> 3, ch = cgrp * 64 + 8 * cg;
    const float* w = p.in[I_SCCW] + (size_t)l * 3 * SC_D + ch;
    float w0[8], w1[8], w2[8];
#pragma unroll
    for (int b = 0; b < 8; ++b) { w0[b] = w[b]; w1[b] = w[SC_D + b]; w2[b] = w[2 * SC_D + b]; }
    float c[10][8], x[10][8];
    load_rows10(P + OFF_D + 512 + ch, t0, tg, lo, hi, c); load_rows10(P + OFF_D + 1024 + ch, t0, tg, lo, hi, x);
#pragma unroll
    for (int a = 0; a < 10; ++a)
#pragma unroll
        for (int b = 0; b < 8; ++b) c[a][b] *= x[a][b];
    v4u graw[8];
#pragma unroll
    for (int a = 0; a < 8; ++a) graw[a] = *(const v4u*)(P + (size_t)(t0 + 8 * tg + a) * NP + OFF_D + ch);
#pragma unroll
    for (int a = 0; a < 8; ++a) { const int t = t0 + 8 * tg + a; float g[8]; unpack8(graw[a], g);
        float y[8];
#pragma unroll
        for (int b = 0; b < 8; ++b) y[b] = g[b] * (w0[b] * c[a][b] + w1[b] * c[a + 1][b] + w2[b] * c[a + 2][b]);
        v4u o; o.x = pk2(y[0], y[1]); o.y = pk2(y[2], y[3]); o.z = pk2(y[4], y[5]); o.w = pk2(y[6], y[7]);
        *(v4u*)(WSP(bf16, WS_Y) + (size_t)t * YK + YOFF_D + ch) = o; }
}
template <int MODE> __device__ __forceinline__ void c34_load(KPR p, int tile, int cgrp, int lane, v4u (&raw)[10]) {
    const bf16* P = WSP(bf16, WS_P);
    const int t0 = tile * 64, lo = t0 < SEQ ? 0 : SEQ, hi = t0 < SEQ ? SEQ : MT, cg = lane & 7, tg = lane >> 3, ch = cgrp * 64 + 8 * cg;
    constexpr int POFF = MODE == 0 ? OFF_B + SSD_D : OFF_C;
#pragma unroll
    for (int a = 0; a < 10; ++a) { const int t = t0 + 8 * tg + a - 1; v4u z; z.x = 0u; z.y = 0u; z.z = 0u; z.w = 0u;
        raw[a] = (t >= lo && t < hi) ? *(const v4u*)(P + (size_t)t * NP + POFF + ch) : z; }
}
template <int MODE> __device__ __forceinline__ void c34_compute(KPR p, int l, LAS unsigned char* wlds, int tile, int cgrp, int lane, const v4u (&raw)[10]) {
    const int t0 = tile * 64, cg = lane & 7, tg = lane >> 3, ch = cgrp * 64 + 8 * cg;
    constexpr int NC = MODE == 0 ? XBC : 1536;
    const float* w = p.in[MODE == 0 ? I_SCW : I_HSW] + (size_t)l * 3 * NC + ch; const float* b = p.in[MODE == 0 ? I_SCB : I_HSB] + (size_t)l * NC + ch;
    float w0[8], w1[8], w2[8], bb[8];
#pragma unroll
    for (int q = 0; q < 8; ++q) { w0[q] = w[q]; w1[q] = w[NC + q]; w2[q] = w[2 * NC + q]; bb[q] = b[q]; }
    LAS bf16* tile_ = (LAS bf16*)wlds;
    const bool tr = (MODE == 1) || (cgrp < 20);
    float xp[8], xc_[8], xn[8];
    unpack8(raw[0], xp); unpack8(raw[1], xc_);
#pragma unroll
    for (int a = 0; a < 8; ++a) { unsigned short y[8]; unpack8(raw[a + 2], xn);
#pragma unroll
        for (int q = 0; q < 8; ++q) { float v = w0[q] * xp[q] + w1[q] * xc_[q] + w2[q] * xn[q] + bb[q]; if (MODE == 0) v = siluf_(v); y[q] = (unsigned short)f2bf(v); xp[q] = xc_[q]; xc_[q] = xn[q]; }
        if (tr) {
#pragma unroll
            for (int q = 0; q < 8; ++q) tile_[(8 * cg + q) * 72 + 8 * tg + a] = y[q]; }
        if (MODE == 0 && cgrp >= 12) { v4u o; o.x = y[0] | ((unsigned)y[1] << 16); o.y = y[2] | ((unsigned)y[3] << 16); o.z = y[4] | ((unsigned)y[5] << 16); o.w = y[6] | ((unsigned)y[7] << 16);
            *(v4u*)(WSP(bf16, WS_XC) + (size_t)(t0 + 8 * tg + a) * XBC + ch) = o; } }
    if (tr) {
        WAVE_SYNC();
        bf16* dst = WSP(bf16, MODE == 0 ? WS_XCT : WS_QT) + (size_t)(cgrp * 64) * MT + t0;
#pragma unroll
        for (int j = 0; j < 8; ++j) { const int q = lane + 64 * j, row = q >> 3, cc = q & 7; *(v4u*)(dst + (size_t)row * MT + 8 * cc) = *(const LAS v4u*)(tile_ + row * 72 + 8 * cc); }
        WAVE_SYNC();
    }
}
template <int MODE> __device__ __forceinline__ void c34_wave_loop(KPR p, int l, LAS unsigned char* wlds, int first, int nitems, int NGW, int lane) {
    constexpr int NCG = MODE == 0 ? 28 : 24;
    if (first >= nitems) return;
    v4u cur[10], nxt[10];
    c34_load<MODE>(p, first / NCG, first % NCG, lane, cur);
    for (int it = first; it < nitems; it += NGW) {
        const int ni = it + NGW; const bool hn = ni < nitems;
        if (hn) c34_load<MODE>(p, ni / NCG, ni % NCG, lane, nxt);
        c34_compute<MODE>(p, l, wlds, it / NCG, it % NCG, lane, cur);
        if (hn) {
#pragma unroll
            for (int a = 0; a < 10; ++a) cur[a] = nxt[a]; }
    }
}
__device__ __forceinline__ void c_dt_wave(KPR p, int l, int tile, int lane) {
    const bf16* src = WSP(bf16, WS_P) + (size_t)(tile * 64 + lane) * NP + OFF_B + SSD_D + XBC;
    const v4u r0 = *(const v4u*)src, r1 = *(const v4u*)(src + 8), r2 = *(const v4u*)(src + 16);
    float xa[8], xb[8], xc[8]; unpack8(r0, xa); unpack8(r1, xb); unpack8(r2, xc);
    const float* bias = p.in[I_SDTB] + l * 24; float* dst = WSP(float, WS_DT) + (size_t)(tile * 64 + lane) * 24;
#pragma unroll
    for (int h = 0; h < 3; ++h) { f32x4 o0, o1;
#pragma unroll
        for (int j = 0; j < 4; ++j) { const float x0 = (h == 0 ? xa[j] : (h == 1 ? xb[j] : xc[j])) + bias[8 * h + j], x1 = (h == 0 ? xa[4 + j] : (h == 1 ? xb[4 + j] : xc[4 + j])) + bias[8 * h + 4 + j];
            o0[j] = fmaxf(x0, 0.f) + flog(1.0f + __expf(-fabsf(x0))); o1[j] = fmaxf(x1, 0.f) + flog(1.0f + __expf(-fabsf(x1))); }
        *(f32x4*)(dst + 8 * h) = o0; *(f32x4*)(dst + 8 * h + 4) = o1; }
}
constexpr int CW_C2 = (MT / 64) * 8, CW_C3 = (MT / 64) * 28, CW_C4 = (MT / 64) * 24, CW_DT = MT / 64, CW_ITEMS = CW_C3 + CW_C4 + CW_C2 + CW_DT;
__device__ __forceinline__ void c_wave_items(KPR p, int l, LAS unsigned char* lds, int gw, int NGW, int lane, int wave, int last) {
    LAS unsigned char* wlds = lds + wave * 16384;
    const int ntl = last ? SEQ / 64 : MT / 64;
    c34_wave_loop<0>(p, l, wlds, gw, CW_C3, NGW, lane);
    c34_wave_loop<1>(p, l, wlds, gw, ntl * 24, NGW, lane);
    for (int it = gw; it < ntl * 8; it += NGW) c2_wave(p, l, it / 8, it % 8, lane);
    for (int it = gw; it < CW_DT; it += NGW) c_dt_wave(p, l, it, lane);
}
__device__ __forceinline__ float sin_rad(float x) { float s_, c_; sincos_turns(x * 0.15915494309189535f, s_, c_); return s_; }
__device__ __forceinline__ void c5_item(KPR p, int l, LAS unsigned char* lds, int idx, int tid) {
    LAS float* ws = (LAS float*)lds;
    LAS float* h1s = (LAS float*)(lds + 32768);
    const int t = idx * 64 + (tid >> 3), oq = tid & 7, pl = tid >> 3;
    const bool isctx = t >= SEQ; const int n = isctx ? CTX : SEQ, tl = isctx ? t - SEQ : t;
    const float t01 = (float)tl * frcp((float)(n - 1)), tn = (float)tl * (1.0f / (float)n);
    float a[8];
#pragma unroll
    for (int i = 0; i < 8; ++i) a[i] = ws[2112 + 8 * oq + i];
#pragma unroll 1
    for (int f = 0; f < 33; ++f) {
        float ft;
        if (f == 0) ft = t01;
        else { const int bi = (f - 1) & 15; const float band = 1e-4f + (15.0f - 1e-4f) * (float)bi * (1.0f / 15.0f); float sn_, cs_; sincos_turns(band * tn, sn_, cs_); ft = (f <= 16) ? cs_ : -sn_; }
        const f32x4 w0 = *(const LAS f32x4*)(ws + f * 64 + 8 * oq), w1 = *(const LAS f32x4*)(ws + f * 64 + 8 * oq + 4);
#pragma unroll
        for (int i = 0; i < 4; ++i) { a[i] += ft * w0[i]; a[4 + i] += ft * w1[i]; }
    }
#pragma unroll
    for (int i = 0; i < 8; ++i) h1s[(8 * oq + i) * 64 + pl] = sin_rad(ws[2176 + 4096 + 64 + 8 * oq + i] * a[i]);
    WAVE_SYNC();
#pragma unroll
    for (int i = 0; i < 8; ++i) a[i] = ws[2176 + 4096 + 8 * oq + i];
#pragma unroll 4
    for (int j = 0; j < 64; ++j) { const float h = h1s[j * 64 + pl];
        const f32x4 w0 = *(const LAS f32x4*)(ws + 2176 + j * 64 + 8 * oq), w1 = *(const LAS f32x4*)(ws + 2176 + j * 64 + 8 * oq + 4);
#pragma unroll
        for (int i = 0; i < 4; ++i) { a[i] += h * w0[i]; a[4 + i] += h * w1[i]; } }
    f32x4 o0, o1;
#pragma unroll
    for (int i = 0; i < 4; ++i) { o0[i] = sin_rad(ws[2176 + 4096 + 128 + 8 * oq + i] * a[i]); o1[i] = sin_rad(ws[2176 + 4096 + 128 + 8 * oq + 4 + i] * a[4 + i]); }
    float* o = WSP(float, WS_HID2) + (size_t)t * 64 + 8 * oq;
    *(f32x4*)o = o0; *(f32x4*)(o + 4) = o1;
    WAVE_SYNC();
}
__device__ __forceinline__ void c5_load_weights(KPR p, int l, LAS unsigned char* lds, int tid) {
    LAS float* ws = (LAS float*)lds;
    const float* w1g = p.in[I_HW1] + (size_t)l * 33 * 64; const float* w2g = p.in[I_HW2] + (size_t)l * 64 * 64;
    { float t1[5], t2[8];
#pragma unroll
      for (int j = 0; j < 5; ++j) { const int i = tid + NTHR * j; t1[j] = (i < 33 * 64) ? w1g[i] : 0.f; }
#pragma unroll
      for (int j = 0; j < 8; ++j) t2[j] = w2g[tid + NTHR * j];
#pragma unroll
      for (int j = 0; j < 5; ++j) { const int i = tid + NTHR * j; if (i < 33 * 64) ws[i] = t1[j]; }
#pragma unroll
      for (int j = 0; j < 8; ++j) ws[2176 + tid + NTHR * j] = t2[j]; }
    for (int i = tid; i < 64; i += NTHR) { ws[2112 + i] = p.in[I_HB1][l * 64 + i]; ws[2176 + 4096 + i] = p.in[I_HB2][l * 64 + i]; }
    for (int i = tid; i < 128; i += NTHR) ws[2176 + 4096 + 64 + i] = p.in[I_HFREQ][l * 128 + i];
}
constexpr int C1_ITEMS = C1_LAT + CTX / 64, C23_ITEMS = MT / 64, C4_ITEMS = MT / 64, C5_ITEMS = MT / 64, C6_ITEMS = 8 * (MT / 256), C_ITEMS = C6_ITEMS + C1_ITEMS;

__device__ __forceinline__ float a_rate_of(KPR p, int l, int d, int h) { return -__expf(p.in[I_SALOG][(l * 2 + d) * NH + h]); }
__device__ __forceinline__ bf16x8 as_bf16x8(v4u v) { return __builtin_bit_cast(bf16x8, v); }
__device__ __forceinline__ void d_ssd_item(KPR p, int l, LAS unsigned char* lds, int idx, int e_only, int tid) {
    const int c = idx / NG, g = idx % NG, t0 = c * CHUNK, lane = tid & 63, wave = tid >> 6;
    const bf16* XCT = WSP(bf16, WS_XCT); const float* DTp = WSP(float, WS_DT);
    LAS bf16* XT = (LAS bf16*)lds;
    LAS bf16* BT = (LAS bf16*)(lds + 52224);
    LAS float* Wv = (LAS float*)(lds + 87040);
    __syncthreads();
    { v4u tl[10];
#pragma unroll
      for (int j = 0; j < 10; ++j) { const int q = tid + NTHR * j, row = q >> 4, cc = (q & 15) * 8; const int src = row < 192 ? g * 192 + row : 768 + g * NS + (row - 192);
          tl[j] = *(const v4u*)(XCT + (size_t)src * MT + t0 + cc); }
#pragma unroll
      for (int j = 0; j < 10; ++j) { const int q = tid + NTHR * j, row = q >> 4, cc = (q & 15) * 8; *(LAS v4u*)((row < 192 ? XT + row * 136 : BT + (row - 192) * 136) + cc) = tl[j]; } }
    if (wave < 6) {
        const int d = wave / 3, e = wave % 3, h = g * HPG + e; const float ar = a_rate_of(p, l, d, h);
        const int l0 = 2 * lane;
        const float dt0 = DTp[(size_t)(t0 + l0) * 24 + d * NH + h], dt1 = DTp[(size_t)(t0 + l0 + 1) * 24 + d * NH + h];
        const float ld0 = dt0 * ar, ld1 = dt1 * ar;
        float x = ld0 + ld1;
#pragma unroll
        for (int o = 1; o < 64; o <<= 1) { const float y = __shfl_up(x, o); if (lane >= o) x += y; }
        const float tot = __shfl(x, 63);
        float A1 = x, A0 = x - ld1;
        if (d == 1) { A0 = tot - A0 + ld0; A1 = tot - A1 + ld1; }
        float* ac = WSP(float, WS_ACUM) + (size_t)(d * NH + h) * MT + t0 + l0; ac[0] = A0; ac[1] = A1;
        Wv[wave * 128 + l0] = dt0 * __expf(tot - A0); Wv[wave * 128 + l0 + 1] = dt1 * __expf(tot - A1);
        if (lane == 0) WSP(float, WS_CDEC)[(size_t)(d * NCH + c) * NH + h] = __expf(tot);
    }
    __syncthreads();
    const int nb = wave & 3, pb = wave >> 2, r = lane & 31, hh = lane >> 5;
    for (int combo = 0; combo < 6; ++combo) {
        const int d = combo / 3, e = combo % 3, h = g * HPG + e;
        f32x16 acc;
#pragma unroll
        for (int i = 0; i < 16; ++i) acc[i] = 0.f;
#pragma unroll
        for (int ks = 0; ks < 8; ++ks) {
            const int lb_ = 16 * ks + 8 * hh;
            float xv[8]; unpack8(*(const LAS v4u*)(XT + (e * 64 + 32 * pb + r) * 136 + lb_), xv);
            const f32x4 w0 = *(const LAS f32x4*)(Wv + combo * 128 + lb_), w1 = *(const LAS f32x4*)(Wv + combo * 128 + lb_ + 4);
            v4u av; av.x = pk2(xv[0] * w0[0], xv[1] * w0[1]); av.y = pk2(xv[2] * w0[2], xv[3] * w0[3]); av.z = pk2(xv[4] * w1[0], xv[5] * w1[1]); av.w = pk2(xv[6] * w1[2], xv[7] * w1[3]);
            const bf16x8 bfrag = as_bf16x8(*(const LAS v4u*)(BT + (32 * nb + r) * 136 + lb_));
            acc = MFMA32(as_bf16x8(av), bfrag, acc);
        }
        float* st = WSP(float, WS_ST) + ((size_t)(d * NCH + c) * NH + h) * HD * NS + (size_t)(32 * pb) * NS + 32 * nb + r;
#pragma unroll
        for (int i = 0; i < 16; ++i) st[(size_t)((i & 3) + 8 * (i >> 2) + 4 * hh) * NS] = acc[i];
    }
    __syncthreads();
}
__device__ __forceinline__ int scan_chunk(int d, int i) {
    if (i < NCH - NCH_LAT) return (d == 0) ? NCH_LAT + i : NCH - 1 - i;
    const int k = i - (NCH - NCH_LAT); return (d == 0) ? k : NCH_LAT - 1 - k;
}
__device__ __forceinline__ void e_scan_item(KPR p, int idx, int tid) {
    const int el = idx * NTHR + tid;
    const int d = el / (NH * HD * NS), h = (el / (HD * NS)) % NH, pn = el % (HD * NS);
    const float* st = WSP(float, WS_ST); const float* cd = WSP(float, WS_CDEC); bf16* hb = WSP(bf16, WS_HIN);
    float hs = 0.f;
    constexpr int BATCH = 10; static_assert(NCH % BATCH == 0, "scan batch");
    for (int i0 = 0; i0 < NCH; i0 += BATCH) {
        float v[BATCH], dc[BATCH];
#pragma unroll
        for (int j = 0; j < BATCH; ++j) { const int c = scan_chunk(d, i0 + j); v[j] = st[((size_t)(d * NCH + c) * NH + h) * HD * NS + pn]; dc[j] = cd[(size_t)(d * NCH + c) * NH + h]; }
#pragma unroll
        for (int j = 0; j < BATCH; ++j) { const int c = scan_chunk(d, i0 + j); hb[((size_t)(d * NCH + c) * NH + h) * HD * NS + pn] = (bf16)f2bf(hs); hs = dc[j] * hs + v[j]; }
    }
}
__device__ __forceinline__ void f_ssd_item(KPR p, int l, LAS unsigned char* lds, int c, int g, int e0, int e1, int tid) {
    const int t0 = c * CHUNK, lane = tid & 63, wave = tid >> 6;
    const bf16* XCp = WSP(bf16, WS_XC); const bf16* XCT = WSP(bf16, WS_XCT); const float* DTp = WSP(float, WS_DT); const bf16* P = WSP(bf16, WS_P);
    LAS bf16* Bm = (LAS bf16*)lds;
    LAS bf16* Cm = (LAS bf16*)(lds + 34816);
    LAS bf16* XT = (LAS bf16*)(lds + 69632);
    LAS bf16* Hs = (LAS bf16*)(lds + 121856);
    LAS float* Ac = (LAS float*)(lds + 139264);
    LAS float* Dv = Ac + 768;
    const int ncombo = 2 * (e1 - e0);
    const bf16* hbase = WSP(bf16, WS_HIN);
    v4u hreg[2];
#define FSSD_HIN_LOAD(cc) do { const bf16* hin_ = hbase + ((size_t)(((cc) & 1) * NCH + c) * NH + g * HPG + e0 + ((cc) >> 1)) * HD * NS; _Pragma("unroll") for (int j_ = 0; j_ < 2; ++j_) { const int q_ = tid + NTHR * j_; hreg[j_] = *(const v4u*)(hin_ + (size_t)(q_ >> 4) * NS + (q_ & 15) * 8); } } while (0)
    FSSD_HIN_LOAD(0);
    __syncthreads();
    { v4u tb[4], tc[4], tx[6]; float ta[2], td[2];
#pragma unroll
      for (int j = 0; j < 4; ++j) { const int q = tid + NTHR * j, row = q >> 4, cc = (q & 15) * 8;
          tb[j] = *(const v4u*)(XCp + (size_t)(t0 + row) * XBC + SSD_D + g * NS + cc); tc[j] = *(const v4u*)(XCp + (size_t)(t0 + row) * XBC + SSD_D + NG * NS + g * NS + cc); }
#pragma unroll
      for (int j = 0; j < 6; ++j) { const int q = tid + NTHR * j, row = q >> 4, cc = (q & 15) * 8; tx[j] = *(const v4u*)(XCT + (size_t)(g * 192 + row) * MT + t0 + cc); }
#pragma unroll
      for (int j = 0; j < 2; ++j) { const int q = tid + NTHR * j; ta[j] = 0.f; td[j] = 0.f; if (q < 768) { const int combo = q >> 7, rr = q & 127, d = combo / 3, h = g * HPG + combo % 3;
          ta[j] = WSP(float, WS_ACUM)[(size_t)(d * NH + h) * MT + t0 + rr]; td[j] = DTp[(size_t)(t0 + rr) * 24 + d * NH + h]; } }
#pragma unroll
      for (int j = 0; j < 4; ++j) { const int q = tid + NTHR * j, row = q >> 4, cc = (q & 15) * 8; *(LAS v4u*)(Bm + row * 136 + cc) = tb[j]; *(LAS v4u*)(Cm + row * 136 + cc) = tc[j]; }
#pragma unroll
      for (int j = 0; j < 6; ++j) { const int q = tid + NTHR * j, row = q >> 4, cc = (q & 15) * 8; *(LAS v4u*)(XT + row * 136 + cc) = tx[j]; }
#pragma unroll
      for (int j = 0; j < 2; ++j) { const int q = tid + NTHR * j; if (q < 768) { Ac[q] = ta[j]; Dv[q] = td[j]; } } }
    __syncthreads();
    const int lb = wave & 3, ph = wave >> 2, r = lane & 31, hh = lane >> 5;
    f32x16 T[4];
#pragma unroll
    for (int sb = 0; sb < 4; ++sb)
#pragma unroll
        for (int i = 0; i < 16; ++i) T[sb][i] = 0.f;
#pragma unroll 2
    for (int ks = 0; ks < 8; ++ks) {
        const bf16x8 cf = as_bf16x8(*(const LAS v4u*)(Cm + (32 * lb + r) * 136 + 16 * ks + 8 * hh));
#pragma unroll
        for (int sb = 0; sb < 4; ++sb) T[sb] = MFMA32(as_bf16x8(*(const LAS v4u*)(Bm + (32 * sb + r) * 136 + 16 * ks + 8 * hh)), cf, T[sb]);
    }
    f32x16 Y;
    for (int cc = 0; cc < ncombo; ++cc) {
        const int e = e0 + (cc >> 1), d = cc & 1, h = g * HPG + e, combo = d * 3 + e;
        if (d == 0) {
#pragma unroll
            for (int i = 0; i < 16; ++i) Y[i] = 0.f;
        }
        __syncthreads();
#pragma unroll
        for (int j = 0; j < 2; ++j) { const int q = tid + NTHR * j; *(LAS v4u*)(Hs + (q >> 4) * 136 + (q & 15) * 8) = hreg[j]; }
        __syncthreads();
        if (cc + 1 < ncombo) FSSD_HIN_LOAD(cc + 1);
        const float Al = Ac[combo * 128 + 32 * lb + r]; const float eal = __expf(Al);
#pragma unroll 4
        for (int ks = 0; ks < 8; ++ks) { float cv[8]; unpack8(*(const LAS v4u*)(Cm + (32 * lb + r) * 136 + 16 * ks + 8 * hh), cv);
            v4u av; av.x = pk2(cv[0] * eal, cv[1] * eal); av.y = pk2(cv[2] * eal, cv[3] * eal); av.z = pk2(cv[4] * eal, cv[5] * eal); av.w = pk2(cv[6] * eal, cv[7] * eal);
            Y = MFMA32(as_bf16x8(av), as_bf16x8(*(const LAS v4u*)(Hs + (32 * ph + r) * 136 + 16 * ks + 8 * hh)), Y); }
#pragma unroll
        for (int sb = 0; sb < 4; ++sb) {
            if (d == 0 ? (sb > lb) : (sb < lb)) continue;
            const LAS bf16* xrow = XT + (e * 64 + 32 * ph + r) * 136 + 32 * sb + 4 * hh;
#pragma unroll
            for (int sp = 0; sp < 2; ++sp) {
                float tm[8];
                const int sbase = 32 * sb + 16 * sp + 4 * hh;
                const f32x4 a0 = *(const LAS f32x4*)(Ac + combo * 128 + sbase), a1 = *(const LAS f32x4*)(Ac + combo * 128 + sbase + 8);
                const f32x4 d0 = *(const LAS f32x4*)(Dv + combo * 128 + sbase), d1 = *(const LAS f32x4*)(Dv + combo * 128 + sbase + 8);
#pragma unroll
                for (int j = 0; j < 8; ++j) { const int i = 8 * sp + j, sl = (i & 3) + 8 * (i >> 2) + 4 * hh;
                    const bool valid = (sb != lb) || (d == 0 ? (sl <= r) : (sl >= r));
                    const float as = (j < 4) ? a0[j & 3] : a1[j & 3], ds = (j < 4) ? d0[j & 3] : d1[j & 3];
                    tm[j] = valid ? T[sb][i] * __expf(Al - as) * ds : 0.f; }
                v4u av; av.x = pk2(tm[0], tm[1]); av.y = pk2(tm[2], tm[3]); av.z = pk2(tm[4], tm[5]); av.w = pk2(tm[6], tm[7]);
                const v2u x0 = *(const LAS v2u*)(xrow + 16 * sp), x1 = *(const LAS v2u*)(xrow + 16 * sp + 8);
                v4u bv; bv.x = x0.x; bv.y = x0.y; bv.z = x1.x; bv.w = x1.y;
                Y = MFMA32(as_bf16x8(av), as_bf16x8(bv), Y);
                SCHED_FENCE();
            }
            SCHED_FENCE();
        }
        if (d == 1) {
            int t0v = t0; OPAQUE_V(t0v);
            const float Dh = p.in[I_SD][l * NH + h];
            const int colg = h * HD + 32 * ph + r; const float ngv = p.in[I_SNG][l * SSD_D + colg];
            const LAS bf16* xrow = XT + (e * 64 + 32 * ph + r) * 136 + 32 * lb;
            float ssq[16]; unsigned short zv[16];
#pragma unroll
            for (int i = 0; i < 16; ++i) zv[i] = P[(size_t)(t0v + 32 * lb + (i & 3) + 8 * (i >> 2) + 4 * hh) * NP + OFF_B + colg];
            v2u xq[4];
#pragma unroll
            for (int q = 0; q < 4; ++q) xq[q] = *(const LAS v2u*)(xrow + 8 * q + 4 * hh);
#pragma unroll
            for (int i = 0; i < 16; ++i) { const int lr = (i & 3) + 8 * (i >> 2) + 4 * hh, t = t0v + 32 * lb + lr;
                const unsigned xw = (i & 2) ? xq[i >> 2].y : xq[i >> 2].x; const float xv_ = (i & 1) ? bfhi(xw) : bflo(xw);
                const float y = Y[i] + Dh * xv_;
                const float u = y * siluf_(bf2f(zv[i]));
                ssq[i] = u * u;
                WSP(bf16, WS_Y)[(size_t)t * YK + YOFF_B + colg] = (bf16)f2bf(u * ngv); }
#pragma unroll
            for (int i = 0; i < 16; ++i) { const float v = half_sum32(ssq[i]);
                if (r == 16) WSP(float, WS_SSQ)[(size_t)(t0v + 32 * lb + (i & 3) + 8 * (i >> 2) + 4 * hh) * 24 + (g * HPG + e) * 2 + ph] = v; }
        }
    }
#undef FSSD_HIN_LOAD
    __syncthreads();
}

#define HPAD(i) ((i) + ((i) >> 5))
__device__ __forceinline__ f32x2 cmul(f32x2 a, f32x2 b) { return (f32x2){a.x * b.x - a.y * b.y, a.x * b.y + a.y * b.x}; }
__device__ __forceinline__ f32x2 cconj(f32x2 a) { return (f32x2){a.x, -a.y}; }
template <int LR> __device__ __forceinline__ constexpr int brevn(int i) { int r = 0; for (int b = 0; b < LR; ++b) r |= ((i >> b) & 1) << (LR - 1 - b); return r; }
__device__ __forceinline__ constexpr float w32_cos(int e) {
    constexpr float t[16] = {1.0f, 0.9807852804032304f, 0.9238795325112867f, 0.8314696123025452f, 0.7071067811865476f, 0.5555702330196022f, 0.3826834323650898f, 0.19509032201612825f,
                             0.0f, -0.19509032201612825f, -0.3826834323650898f, -0.5555702330196022f, -0.7071067811865476f, -0.8314696123025452f, -0.9238795325112867f, -0.9807852804032304f};
    return t[e]; }
__device__ __forceinline__ constexpr float w32_sin(int e) {
    constexpr float t[16] = {0.0f, 0.19509032201612825f, 0.3826834323650898f, 0.5555702330196022f, 0.7071067811865476f, 0.8314696123025452f, 0.9238795325112867f, 0.9807852804032304f,
                             1.0f, 0.9807852804032304f, 0.9238795325112867f, 0.8314696123025452f, 0.7071067811865476f, 0.5555702330196022f, 0.3826834323650898f, 0.19509032201612825f};
    return t[e]; }
template <bool INV> __device__ __forceinline__ f32x2 mul_w32(f32x2 d, int e) {
    const float sg = INV ? -1.f : 1.f;
    if (e == 0) return d;
    if (e == 8) return (f32x2){sg * d.y, -sg * d.x};
    if (e == 4) return (f32x2){(d.x + sg * d.y) * 0.7071067811865476f, (d.y - sg * d.x) * 0.7071067811865476f};
    if (e == 12) return (f32x2){(-d.x + sg * d.y) * 0.7071067811865476f, (-d.y - sg * d.x) * 0.7071067811865476f};
    const float c = w32_cos(e), sn = w32_sin(e);
    return (f32x2){d.x * c + sg * d.y * sn, d.y * c - sg * d.x * sn};
}
template <int R, bool INV> __device__ __forceinline__ void dft_r(f32x2 (&v)[R]) {
    constexpr int LR = (R == 32) ? 5 : 4;
#pragma unroll
    for (int hs = LR - 1; hs >= 0; --hs) { const int half = 1 << hs;
#pragma unroll
        for (int b = 0; b < R / 2; ++b) { const int j = b & (half - 1), i0 = ((b >> hs) << (hs + 1)) + j, i1 = i0 + half;
            const f32x2 a = v[i0], c = v[i1]; v[i0] = a + c; v[i1] = mul_w32<INV>(a - c, (j << (LR - 1 - hs)) * (32 / R)); }
        if (R == 32) SCHED_FENCE(); }
}
template <int n, int P> struct FftPlan { static constexpr int R = (n == 16384) ? (P < 2 ? 32 : (P == 2 ? 16 : 1)) : (n == 1024 ? (P < 2 ? 32 : 1) : (n == 256 ? (P < 2 ? 16 : 1) : 0)); };
template <int n, int P> struct FftM { static constexpr int value = FftM<n, P - 1>::value / FftPlan<n, P>::R; };
template <int n> struct FftM<n, -1> { static constexpr int value = n; };
static_assert(FftM<16384, 2>::value == 1 && FftM<256, 1>::value == 1, "fft plan");
template <int n> __device__ __forceinline__ int fft_pos(int k) {
    int pos = 0;
    if constexpr (FftPlan<n, 0>::R > 1) { constexpr int R = FftPlan<n, 0>::R, M = FftM<n, 0>::value; pos += (k % R) * M; k /= R; }
    if constexpr (FftPlan<n, 1>::R > 1) { constexpr int R = FftPlan<n, 1>::R, M = FftM<n, 1>::value; pos += (k % R) * M; k /= R; }
    if constexpr (FftPlan<n, 2>::R > 1) { constexpr int R = FftPlan<n, 2>::R, M = FftM<n, 2>::value; pos += (k % R) * M; k /= R; }
    return pos;
}
template <int n, int P, bool INV> __device__ __forceinline__ void fft_pass(LAS f32x2* xc, int tid) {
    constexpr int R = FftPlan<n, P>::R, M = FftM<n, P>::value, LR = (R == 32) ? 5 : 4, NB = n / R;
    constexpr int lm = (M == 1) ? 0 : (M == 16 ? 4 : (M == 32 ? 5 : (M == 512 ? 9 : (M == 1024 ? 10 : -1))));
    static_assert(lm >= 0 && (1 << lm) == M, "fft pass geometry");
#pragma unroll 1
    for (int uu = 0; uu < (NB + NTHR - 1) / NTHR; ++uu) { const int u = tid + uu * NTHR; if (u >= NB) continue; const int b = u & (M - 1), base = ((u >> lm) << (lm + LR)) + b;
        f32x2 v[R];
        const int hb = HPAD(base);
#define FOFF(S) ((S) * M + (((S) * M) >> 5))
        const float ang1 = (float)b * (1.0f / (float)(R * M));
        if constexpr (!INV) {
#pragma unroll
            for (int a = 0; a < R; ++a) v[a] = xc[hb + FOFF(a)];
            dft_r<R, false>(v);
            float ag = ang1;
#pragma unroll
            for (int i = 0; i < R; ++i) { const int s_ = brevn<LR>(i); f32x2 y = v[i];
                if ((i & 7) == 0) OPAQUE_V(ag);
                if (s_ != 0 && M > 1) { float sn, cs; sincos_turns((float)s_ * ag, sn, cs); y = cmul(y, (f32x2){cs, -sn}); }
                xc[hb + FOFF(s_)] = y;
                if ((i & 7) == 7) SCHED_FENCE(); }
        } else {
            float ag = ang1;
#pragma unroll
            for (int s_ = 0; s_ < R; ++s_) { f32x2 y = xc[hb + FOFF(s_)];
                if ((s_ & 7) == 0) OPAQUE_V(ag);
                if (s_ != 0 && M > 1) { float sn, cs; sincos_turns((float)s_ * ag, sn, cs); y = cmul(y, (f32x2){cs, sn}); }
                v[s_] = y;
                if ((s_ & 7) == 7) SCHED_FENCE(); }
            dft_r<R, true>(v);
#pragma unroll
            for (int i = 0; i < R; ++i) xc[hb + FOFF(brevn<LR>(i))] = v[i];
        }
#undef FOFF
    }
    __syncthreads();
}
template <int n> __device__ __forceinline__ void fft_fwd(LAS f32x2* xc, int tid) {
    if constexpr (FftPlan<n, 0>::R > 1) fft_pass<n, 0, false>(xc, tid);
    if constexpr (FftPlan<n, 1>::R > 1) fft_pass<n, 1, false>(xc, tid);
    if constexpr (FftPlan<n, 2>::R > 1) fft_pass<n, 2, false>(xc, tid);
}
template <int n> __device__ __forceinline__ void fft_inv(LAS f32x2* xc, int tid) {
    if constexpr (FftPlan<n, 2>::R > 1) fft_pass<n, 2, true>(xc, tid);
    if constexpr (FftPlan<n, 1>::R > 1) fft_pass<n, 1, true>(xc, tid);
    if constexpr (FftPlan<n, 0>::R > 1) fft_pass<n, 0, true>(xc, tid);
}
template <int n> __device__ __forceinline__ void hyena_item(KPR p, int l, LAS unsigned char* lds, int c, int toff, f32x4* fscr, f32x2* zscr, int tid) {
    LAS float* xr = (LAS float*)lds; LAS f32x2* xc = (LAS f32x2*)lds;
    LAS float* aux = (LAS float*)(lds + 139264);
    const bf16* QT = WSP(bf16, WS_QT); const bf16* TAPS = WSP(bf16, WS_TAPS);
    const int lane = tid & 63, wave = tid >> 6;
    constexpr int NM = (n / 2 + NTHR - 1) / NTHR, CH = NM >= 8 ? 8 : NM, NK = NM + 1, CK = 4;
    for (int o = 0; o < 2; ++o) {
        const bf16* tf = TAPS + (size_t)(o * 1024 + c) * MT + toff; const bf16* tb = TAPS + (size_t)(o * 1024 + 512 + c) * MT + toff;
        __syncthreads();
        float asum = 0.f;
#pragma unroll 1
        for (int j0 = 0; j0 < NM; j0 += CH) {
            unsigned wf[CH], wb[CH];
#pragma unroll
            for (int j = 0; j < CH; ++j) { const int m = tid + NTHR * (j0 + j); wf[j] = 0u; wb[j] = 0u; if (m < n / 2) { wf[j] = *(const unsigned*)(tf + 2 * m); wb[j] = *(const unsigned*)(tb + 2 * m); } }
#pragma unroll
            for (int j = 0; j < CH; ++j) { const int m = tid + NTHR * (j0 + j); if (m < n / 2) {
                const float f0 = bflo(wf[j]), f1 = bfhi(wf[j]), b0 = bflo(wb[j]), b1 = bfhi(wb[j]);
                xc[HPAD(m)] = (f32x2){f0, f1}; asum += fabsf(f0) + fabsf(f1) + fabsf(b1) + (m > 0 ? fabsf(b0) : 0.f);
                if (m > 0) xr[2 * HPAD(n - m)] = b0; else xr[2 * HPAD(n / 2)] = 0.f;
                xr[2 * HPAD(n - m - 1) + 1] = b1; } }
        }
        asum = wave_sum(asum);
        if (lane == 0) aux[128 + wave] = asum;
        __syncthreads();
        float norm = 0.f;
#pragma unroll
        for (int i = 0; i < NWAVES; ++i) norm += aux[128 + i];
        fft_fwd<n>(xc, tid);
        const float scale = frcp(norm * (float)n);
#pragma unroll 2
        for (int j = 0; j < NK; ++j) { const int k = tid + NTHR * j; if (k <= n / 2) {
            const int pk = HPAD(fft_pos<n>(k)), pq = HPAD(fft_pos<n>((n - k) & (n - 1)));
            const f32x2 A = xc[pk], Bc = cconj(xc[pq]);
            const f32x2 E = (A + Bc) * 0.5f, Dd = A - Bc; const f32x2 O = (f32x2){Dd.y * 0.5f, -Dd.x * 0.5f};
            float sn, cs; sincos_turns((float)k * (0.5f / (float)n), sn, cs);
            const f32x2 wO = cmul((f32x2){cs, -sn}, O);
            const f32x2 Kk = (E + wO) * scale, Kn = cconj(E - wO) * scale;
            fscr[k] = (f32x4){Kk.x, Kk.y, Kn.x, Kn.y}; } }
        __syncthreads();
#pragma unroll 1
        for (int j0 = 0; j0 < NM; j0 += CH) {
            f32x2 zz[CH];
#pragma unroll
            for (int j = 0; j < CH; ++j) { const int m = tid + NTHR * (j0 + j); zz[j] = (f32x2){0.f, 0.f};
                if (m < n / 2) { if (o == 0) { const unsigned w = *(const unsigned*)(QT + (size_t)c * MT + toff + 2 * m); zz[j] = (f32x2){bflo(w), bfhi(w)}; } else zz[j] = zscr[m]; } }
#pragma unroll
            for (int j = 0; j < CH; ++j) { const int m = tid + NTHR * (j0 + j); if (m < n / 2) { xc[HPAD(m)] = zz[j]; xc[HPAD(m + n / 2)] = (f32x2){0.f, 0.f}; } }
        }
        __syncthreads();
        fft_fwd<n>(xc, tid);
#pragma unroll 1
        for (int j0 = 0; j0 < NK; j0 += CK) {
            f32x4 kfv[CK];
#pragma unroll
            for (int j = 0; j < CK; ++j) { const int k = tid + NTHR * (j0 + j); kfv[j] = (f32x4){0.f, 0.f, 0.f, 0.f}; if (j0 + j < NK && k <= n / 2) kfv[j] = fscr[k]; }
#pragma unroll
            for (int j = 0; j < CK; ++j) { const int k = tid + NTHR * (j0 + j); if (j0 + j < NK && k <= n / 2) {
                const int pk = HPAD(fft_pos<n>(k)), pq = HPAD(fft_pos<n>((n - k) & (n - 1)));
                const f32x2 A = xc[pk], Bc = cconj(xc[pq]);
                const f32x2 E = (A + Bc) * 0.5f, Dd = A - Bc; const f32x2 O = (f32x2){Dd.y * 0.5f, -Dd.x * 0.5f};
                float sn, cs; sincos_turns((float)k * (0.5f / (float)n), sn, cs);
                const f32x2 w = (f32x2){cs, -sn}; const f32x2 wO = cmul(w, O);
                const f32x4 kf = kfv[j];
                const f32x2 Yk = cmul(E + wO, (f32x2){kf[0], kf[1]}), Yn = cmul(cconj(E - wO), (f32x2){kf[2], kf[3]});
                const f32x2 Ey = (Yk + cconj(Yn)) * 0.5f; const f32x2 Oy = cmul((Yk - cconj(Yn)) * 0.5f, cconj(w));
                xc[pk] = (f32x2){Ey.x - Oy.y, Ey.y + Oy.x};
                if (pq != pk) xc[pq] = (f32x2){Ey.x + Oy.y, Oy.x - Ey.y};
            } }
        }
        __syncthreads();
        fft_inv<n>(xc, tid);
        const float bias = p.in[I_HBIAS][(size_t)(l * 2 + o) * HY_D + c];
#pragma unroll 1
        for (int j0 = 0; j0 < NM; j0 += CH) {
            unsigned gwv[CH]; f32x2 zz[CH];
#pragma unroll
            for (int j = 0; j < CH; ++j) { const int m = tid + NTHR * (j0 + j); gwv[j] = 0u; zz[j] = (f32x2){0.f, 0.f};
                if (m < n / 2) { gwv[j] = *(const unsigned*)(QT + (size_t)((o + 1) * 512 + c) * MT + toff + 2 * m);
                    if (o == 0) { const unsigned w = *(const unsigned*)(QT + (size_t)c * MT + toff + 2 * m); zz[j] = (f32x2){bflo(w), bfhi(w)}; } else zz[j] = zscr[m]; } }
#pragma unroll
            for (int j = 0; j < CH; ++j) { const int m = tid + NTHR * (j0 + j); if (m < n / 2) {
                const f32x2 cv = xc[HPAD(m)];
                const float r0 = bflo(gwv[j]) * (cv.x + bias * zz[j].x), r1 = bfhi(gwv[j]) * (cv.y + bias * zz[j].y);
                if (o == 0) zscr[m] = (f32x2){r0, r1};
                else *(unsigned*)(WSP(bf16, WS_YCT) + (size_t)c * MT + toff + 2 * m) = pk2(r0, r1); } }
        }
    }
    __syncthreads();
}
__device__ __forceinline__ void c6_taps_item(KPR p, int l, LAS unsigned char* lds, int idx, int tid) {
    const int fg = idx % 8, tt = idx / 8, lane = tid & 63, wave = tid >> 6, r = lane & 31, hh = lane >> 5;
    LAS bf16* Hs = (LAS bf16*)lds;
    LAS bf16* Ws = (LAS bf16*)(lds + 36864);
    const float* hid = WSP(float, WS_HID2) + (size_t)tt * 256 * 64; const float* w3 = p.in[I_HW3] + (size_t)l * 64 * HY_NF + fg * 256;
    __syncthreads();
    { f32x4 tl[8];
#pragma unroll
      for (int j = 0; j < 8; ++j) { const int q = tid + NTHR * j, row = q >> 4, c4 = (q & 15) * 4; tl[j] = *(const f32x4*)(hid + (size_t)row * 64 + c4); }
#pragma unroll
      for (int j = 0; j < 8; ++j) { const int q = tid + NTHR * j, row = q >> 4, c4 = (q & 15) * 4; v2u w; w.x = pk2(tl[j][0], tl[j][1]); w.y = pk2(tl[j][2], tl[j][3]); *(LAS v2u*)(Hs + row * 72 + c4) = w; } }
#pragma unroll 1
    for (int j0 = 0; j0 < 32; j0 += 8) { float tw[8];
#pragma unroll
        for (int j = 0; j < 8; ++j) { const int q = tid + NTHR * (j0 + j), i = q >> 8, f = q & 255; tw[j] = w3[(size_t)i * HY_NF + f]; }
#pragma unroll
        for (int j = 0; j < 8; ++j) { const int q = tid + NTHR * (j0 + j), i = q >> 8, f = q & 255; Ws[f * 72 + i] = (bf16)f2bf(tw[j]); } }
    __syncthreads();
    const int t0 = tt * 256, isctx = t0 >= SEQ, n = isctx ? CTX : SEQ, tl0 = isctx ? t0 - SEQ : t0;
    const float DMIN = -3.0701134573253945f, DMAX = -15.350567286626973f;
    bf16x8 af[4];
#pragma unroll
    for (int ks = 0; ks < 4; ++ks) af[ks] = as_bf16x8(*(const LAS v4u*)(Ws + (32 * wave + r) * 72 + 16 * ks + 8 * hh));
    float dl[16];
#pragma unroll
    for (int i = 0; i < 16; ++i) { const int f = fg * 256 + 32 * wave + (i & 3) + 8 * (i >> 2) + 4 * hh; dl[i] = fabsf(DMIN + (DMAX - DMIN) * ((float)f / 2047.0f)); }
    for (int tb = 0; tb < 8; ++tb) {
        f32x16 acc;
#pragma unroll
        for (int i = 0; i < 16; ++i) acc[i] = 0.f;
#pragma unroll
        for (int ks = 0; ks < 4; ++ks) acc = MFMA32(af[ks], as_bf16x8(*(const LAS v4u*)(Hs + (32 * tb + r) * 72 + 16 * ks + 8 * hh)), acc);
        const float t01 = (float)(tl0 + 32 * tb + r) * frcp((float)(n - 1));
        bf16* o = WSP(bf16, WS_TAPS) + (size_t)(fg * 256 + 32 * wave) * MT + t0 + 32 * tb + r;
#pragma unroll
        for (int i = 0; i < 16; ++i) o[(size_t)((i & 3) + 8 * (i >> 2) + 4 * hh) * MT] = (bf16)f2bf(acc[i] * __expf(-t01 * dl[i]));
    }
    __syncthreads();
}
__device__ __forceinline__ void f_yct_item(KPR p, LAS unsigned char* lds, int idx, int tid) {
    LAS bf16* tile = (LAS bf16*)lds;
    const int t0 = idx * 64;
    { v4u tl[8];
#pragma unroll
      for (int j = 0; j < 8; ++j) { const int q = tid + NTHR * j, row = q >> 3, cc = q & 7; tl[j] = *(const v4u*)(WSP(bf16, WS_YCT) + (size_t)row * MT + t0 + 8 * cc); }
#pragma unroll
      for (int j = 0; j < 8; ++j) { const int q = tid + NTHR * j, row = q >> 3, cc = q & 7; *(LAS v4u*)(tile + row * 72 + 8 * cc) = tl[j]; } }
    __syncthreads();
    for (int q = tid; q < 64 * 64; q += NTHR) { const int tok = q >> 6, cc = q & 63;
        unsigned short e[8];
#pragma unroll
        for (int i = 0; i < 8; ++i) e[i] = tile[(8 * cc + i) * 72 + tok];
        v4u o; o.x = e[0] | ((unsigned)e[1] << 16); o.y = e[2] | ((unsigned)e[3] << 16); o.z = e[4] | ((unsigned)e[5] << 16); o.w = e[6] | ((unsigned)e[7] << 16);
        *(v4u*)(WSP(bf16, WS_Y) + (size_t)(t0 + tok) * YK + YOFF_C + 8 * cc) = o; }
    __syncthreads();
}
constexpr int D_HY_LAT = HY_D, D_SSD_LAT = NCH_LAT * NG, D_SSD_CTX = (NCH - NCH_LAT) * NG, D_SSD = D_SSD_LAT + D_SSD_CTX, D_HY_CTX = HY_D, D_ITEMS = D_HY_LAT + D_SSD + D_HY_CTX;
constexpr int E_ITEMS = 2 * NH * HD * NS / NTHR;
constexpr int F_SSD_LAT = NCH_LAT * NG, F_SSD_CTX = (NCH - NCH_LAT) * NG * HPG, F_YCT = MT / 64, F_ITEMS = F_SSD_LAT + F_SSD_CTX + F_YCT;

#ifndef GEMM1_ALIGN
#define GEMM1_ALIGN true
#endif
#ifndef GEMM1_SP2
#define GEMM1_SP2 true
#endif

#ifndef PROBE_DBL
#define PROBE_DBL 0
#endif

constexpr float DN_ALPHA = (DEPTH == 4) ? 1.681792830507429f : (DEPTH == 2 ? 1.4142135623730951f : (DEPTH == 1 ? 1.189207115002721f : 0.f));
static_assert(DN_ALPHA != 0.f, "add DN_ALPHA for this DEPTH");
__device__ __forceinline__ int tok_per_wg(int G) { return (MT + G - 1) / G; }
template <int NR> __device__ __forceinline__ void phase_r_rows(KPR p, int l, LAS float* rgw_s, LAS float* rew_s, LAS int* hist, const int (&t)[NR], const bool (&ok)[NR], int lane, bool dummy) {
    const bf16* T = WSP(bf16, WS_MG);
    const float* lg = p.in[I_LNG] + (size_t)(l * 2 + 0) * D; const float* lb = p.in[I_LNB] + (size_t)(l * 2 + 0) * D;
    f32x4 x[NR][D / 256]; float s[NR], s2[NR];
#pragma unroll
    for (int r = 0; r < NR; ++r) { s[r] = 0.f; const int which = t[r] < SEQ ? 0 : 1; const float* hr = hrow(p, t[r]); const float* g1 = modv(p, l, which, 2);
#pragma unroll
        for (int j = 0; j < D / 256; ++j) { const int c = 4 * lane + 256 * j; const v2u mx = *(const v2u*)(T + (size_t)t[r] * D + c); x[r][j] = *(const f32x4*)(hr + c) * DN_ALPHA + *(const f32x4*)(g1 + c) * (f32x4){bflo(mx.x), bfhi(mx.x), bflo(mx.y), bfhi(mx.y)}; s[r] += (x[r][j][0] + x[r][j][1]) + (x[r][j][2] + x[r][j][3]); } }
#pragma unroll
    for (int r = 0; r < NR; ++r) s[r] = wave_sum(s[r]) * (1.f / D);
#pragma unroll
    for (int r = 0; r < NR; ++r) { s2[r] = 0.f;
#pragma unroll
        for (int j = 0; j < D / 256; ++j) { x[r][j] = x[r][j] - s[r]; s2[r] += (x[r][j][0] * x[r][j][0] + x[r][j][1] * x[r][j][1]) + (x[r][j][2] * x[r][j][2] + x[r][j][3] * x[r][j][3]); } }
#pragma unroll
    for (int r = 0; r < NR; ++r) s2[r] = frsq(wave_sum(s2[r]) * (1.f / D) + LN_EPS);
    float gl[NR][4]; f32x2 gl2[NR][4];
#pragma unroll
    for (int r = 0; r < NR; ++r) { const int which = t[r] < SEQ ? 0 : 1; const float* sh = modv(p, l, which, 3); const float* sc = modv(p, l, which, 4);
        float* h = dummy ? WSP(float, WS_YS) + (size_t)t[r] * D : hrow(p, t[r]); bf16* u = WSP(bf16, WS_U) + (size_t)t[r] * D;
        gl2[r][0] = (f32x2){0.f, 0.f}; gl2[r][1] = gl2[r][0]; gl2[r][2] = gl2[r][0]; gl2[r][3] = gl2[r][0];
#pragma unroll
        for (int j = 0; j < D / 256; ++j) { const int c = 4 * lane + 256 * j;
            const f32x4 h1 = x[r][j] * s2[r] * *(const f32x4*)(lg + c) + *(const f32x4*)(lb + c);
            const f32x4 q = *(const f32x4*)(sc + c); const f32x4 sv = *(const f32x4*)(sh + c);
            f32x4 u2; u2[0] = h1[0] * (1.f + q[0]) + sv[0]; u2[1] = h1[1] * (1.f + q[1]) + sv[1]; u2[2] = h1[2] * (1.f + q[2]) + sv[2]; u2[3] = h1[3] * (1.f + q[3]) + sv[3];
            x[r][j] = u2;
            if (ok[r]) { *(f32x4*)(h + c) = h1; v2u w; w.x = pk2(u2[0], u2[1]); w.y = pk2(u2[2], u2[3]); *(v2u*)(u + c) = w; }
#pragma unroll
            for (int g = 0; g < 4; ++g) { const f32x4 gw4 = *(const LAS f32x4*)(rgw_s + g * D + c); gl2[r][g] += u2.lo * gw4.lo; gl2[r][g] += u2.hi * gw4.hi; } } }
#pragma unroll
    for (int r = 0; r < NR; ++r)
#pragma unroll
        for (int g = 0; g < 4; ++g) gl[r][g] = wave_sum(gl2[r][g].x + gl2[r][g].y) + p.in[I_RGB][l * 4 + g];
    int gs[NR]; float gprob[NR]; float el[NR][8]; f32x2 el2[NR][8];
#pragma unroll
    for (int r = 0; r < NR; ++r) { gs[r] = 0; float gm = gl[r][0];
#pragma unroll
        for (int g = 1; g < 4; ++g) if (gl[r][g] > gm) { gm = gl[r][g]; gs[r] = g; }
        gprob[r] = frcp(__expf(gl[r][0] - gm) + __expf(gl[r][1] - gm) + __expf(gl[r][2] - gm) + __expf(gl[r][3] - gm));
#pragma unroll
        for (int i = 0; i < 8; ++i) el2[r][i] = (f32x2){0.f, 0.f};
#pragma unroll
        for (int j = 0; j < D / 256; ++j) { const int c = 4 * lane + 256 * j;
#pragma unroll
            for (int i = 0; i < 8; ++i) { const f32x4 w4 = *(const LAS f32x4*)(rew_s + (gs[r] * 8 + i) * D + c); const f32x4 xv = x[r][j];
                el2[r][i] += xv.lo * w4.lo; el2[r][i] += xv.hi * w4.hi; } } }
#pragma unroll
    for (int r = 0; r < NR; ++r)
#pragma unroll
        for (int i = 0; i < 8; ++i) el[r][i] = wave_sum(el2[r][i].x + el2[r][i].y) + p.in[I_REB][l * NE + gs[r] * 8 + i];
#pragma unroll
    for (int r = 0; r < NR; ++r) {
        int i0 = 0; float v0 = el[r][0];
#pragma unroll
        for (int i = 1; i < 8; ++i) if (el[r][i] > v0) { v0 = el[r][i]; i0 = i; }
        int i1 = -1; float v1 = -3.0e38f;
#pragma unroll
        for (int i = 0; i < 8; ++i) if (i != i0 && el[r][i] > v1) { v1 = el[r][i]; i1 = i; }
        const float e1 = __expf(v1 - v0), w0 = gprob[r] * frcp(1.f + e1), w1 = gprob[r] * e1 * frcp(1.f + e1);
        if (lane == 0 && ok[r]) {
            v4u rr; rr.x = (unsigned)(gs[r] * 8 + i0); rr.y = (unsigned)(gs[r] * 8 + i1); rr.z = f2u(w0); rr.w = f2u(w1);
            *(v4u*)(WSP(unsigned, WS_ROUTE) + (size_t)t[r] * 4) = rr;
            atomicAdd((int*)&hist[gs[r] * 8 + i0], 1); atomicAdd((int*)&hist[gs[r] * 8 + i1], 1);
        }
    }
}
__device__ __forceinline__ void phase_r(KPR p, int l, LAS unsigned char* lds, int tid, int bid, int G, int tlim, bool dummy = false) {
    const int lane = tid & 63, wave = tid >> 6;
    LAS float* rew_s = (LAS float*)lds;
    LAS float* rgw_s = (LAS float*)(lds + (size_t)D * NE * 4);
    LAS int* hist = (LAS int*)(lds + (size_t)D * (NE + 4) * 4);
    __syncthreads();
    { const float* rgw = p.in[I_RGW] + (size_t)l * D * 4; const float* rew = p.in[I_REW] + (size_t)l * D * NE;
      constexpr int NQ = D * NE / 4 / NTHR;
#pragma unroll 1
      for (int j0 = 0; j0 < NQ; j0 += 8) { f32x4 tv[8];
#pragma unroll
          for (int j = 0; j < 8; ++j) { const int q = tid + NTHR * (j0 + j), c = q >> 3, e4 = (q & 7) * 4; tv[j] = (j0 + j < NQ) ? *(const f32x4*)(rew + (size_t)c * NE + e4) : (f32x4){0.f, 0.f, 0.f, 0.f}; }
#pragma unroll
          for (int j = 0; j < 8; ++j) if (j0 + j < NQ) { const int q = tid + NTHR * (j0 + j), c = q >> 3, e4 = (q & 7) * 4;
              rew_s[(e4 + 0) * D + c] = tv[j][0]; rew_s[(e4 + 1) * D + c] = tv[j][1]; rew_s[(e4 + 2) * D + c] = tv[j][2]; rew_s[(e4 + 3) * D + c] = tv[j][3]; } }
      for (int q = tid; q < D; q += NTHR) { const f32x4 v = *(const f32x4*)(rgw + 4 * q); rgw_s[q] = v[0]; rgw_s[D + q] = v[1]; rgw_s[2 * D + q] = v[2]; rgw_s[3 * D + q] = v[3]; } }
    if (tid < NE) hist[tid] = 0;
    __syncthreads();
    const int TPW = tok_per_wg(G), tb = bid * TPW, te = (tb + TPW < tlim) ? tb + TPW : tlim;
    constexpr int NR = 3;
    for (int k = tb + wave; k < te; k += NWAVES * NR) {
        int t[NR]; bool ok[NR];
#pragma unroll
        for (int r = 0; r < NR; ++r) { const int tt = k + r * NWAVES; ok[r] = tt < te; t[r] = ok[r] ? tt : k; }
        phase_r_rows<NR>(p, l, rgw_s, rew_s, hist, t, ok, lane, dummy);
    }
    __syncthreads();
    if (tid < NE) WSP(int, WS_HIST)[bid * NE + tid] = hist[tid];
    __syncthreads();
}
__device__ __forceinline__ void phase_g(KPR p, LAS unsigned char* lds, int tid, int bid, int G, int tlim) {
    const int lane = tid & 63, wave = tid >> 6;
    LAS int* cnt = (LAS int*)(lds + 131072);
    LAS int* bef = cnt + 32;
    LAS int* pst = cnt + 64;
    LAS int* base = cnt + 100;
    LAS int* alist = cnt + 160;
    const int TPW = tok_per_wg(G), tb = bid * TPW, te = (tb + TPW < tlim) ? tb + TPW : tlim, na = 2 * (te > tb ? te - tb : 0);
    const unsigned* route = WSP(unsigned, WS_ROUTE);
    { LAS int* part = cnt + 160 + 4096;
      const int e = tid & 31, pt = tid >> 5; int tot = 0, b = 0;
#pragma unroll 1
      for (int w0 = pt; w0 < G; w0 += 16 * 8) { int hv[8];
#pragma unroll
          for (int j = 0; j < 8; ++j) { const int w = w0 + 16 * j; hv[j] = (w < G) ? WSP(int, WS_HIST)[w * NE + e] : 0; }
#pragma unroll
          for (int j = 0; j < 8; ++j) { const int w = w0 + 16 * j; tot += hv[j]; if (w < bid) b += hv[j]; } }
      part[(pt * 2 + 0) * 32 + e] = tot; part[(pt * 2 + 1) * 32 + e] = b;
      __syncthreads();
      if (tid < NE) { int t2 = 0, b2 = 0; for (int q = 0; q < 16; ++q) { t2 += part[(q * 2) * 32 + tid]; b2 += part[(q * 2 + 1) * 32 + tid]; } cnt[tid] = t2; bef[tid] = b2; } }
    for (int a = tid; a < na; a += NTHR) alist[a] = (int)route[(size_t)(tb + (a >> 1)) * 4 + (a & 1)];
    __syncthreads();
    if (tid == 0) { int s = 0; for (int e = 0; e < NE; ++e) { pst[e] = s; s += (cnt[e] + 255) / 256 * 256; } pst[NE] = s; }
    __syncthreads();
    if (tid < NE) base[tid] = pst[tid] + bef[tid];
    __syncthreads();
    { int mypos[(2 * 1024 + NTHR - 1) / NTHR];
#pragma unroll
      for (int q = 0; q < (2 * 1024 + NTHR - 1) / NTHR; ++q) { const int a = tid + q * NTHR; mypos[q] = 0;
          if (q * NTHR < na) { const int e = a < na ? alist[a] : -1; int rank = 0;
#pragma unroll 8
              for (int a2 = 0; a2 < na; ++a2) rank += (a2 < a && alist[a2] == e) ? 1 : 0;
              if (a < na) mypos[q] = base[e] + rank; } }
      __syncthreads();
#pragma unroll
      for (int q = 0; q < (2 * 1024 + NTHR - 1) / NTHR; ++q) { const int a = tid + q * NTHR; if (a < na) alist[a] = mypos[q]; } }
    __syncthreads();
    for (int a = tid; a < na; a += NTHR) WSP(int, WS_POS)[(size_t)(tb + (a >> 1)) * 2 + (a & 1)] = alist[a];
    for (int a0 = wave * 4; a0 < na; a0 += NWAVES * 4) {
        constexpr int NJ = (D / 8 + 63) / 64; v4u buf[4][NJ];
#pragma unroll
        for (int r = 0; r < 4; ++r) { const int a = a0 + r < na ? a0 + r : a0; const bf16* src = WSP(bf16, WS_U) + (size_t)(tb + (a >> 1)) * D;
#pragma unroll
            for (int j = 0; j < NJ; ++j) if (lane + 64 * j < D / 8) buf[r][j] = *(const v4u*)(src + 8 * (lane + 64 * j)); }
#pragma unroll
        for (int r = 0; r < 4; ++r) if (a0 + r < na) { bf16* dst = WSP(bf16, WS_XS) + (size_t)alist[a0 + r] * D;
#pragma unroll
            for (int j = 0; j < NJ; ++j) if (lane + 64 * j < D / 8) *(v4u*)(dst + 8 * (lane + 64 * j)) = buf[r][j]; }
    }
    for (int e = bid; e < NE; e += G) {
        const int r0 = pst[e] + cnt[e], r1 = pst[e + 1]; unsigned zz_ = 0u; OPAQUE_V(zz_); v4u z; z.x = zz_; z.y = zz_; z.z = zz_; z.w = zz_;
        for (int q = tid; q < (r1 - r0) * (D / 8); q += NTHR) *(v4u*)(WSP(bf16, WS_XS) + (size_t)r0 * D + (size_t)q * 8) = z;
    }
    if (bid == 0) {
        const int nt = pst[NE] / 256;
        for (int i = tid; i < nt; i += NTHR) { int e = 0; while (e < NE - 1 && i * 256 >= pst[e + 1]) ++e; WSP(int, WS_TILEE)[i] = e; }
        if (tid == 0) WSP(int, WS_TILEE)[NTMAX] = nt;
    }
    __syncthreads();
}
__device__ __forceinline__ void phase_n(KPR p, int l, int gw, int NGW, int lane, int tlim, bool dummy = false) {
    const bf16* YS = WSP(bf16, WS_YS);
    const float* lg = p.in[I_LNG] + (size_t)(l * 2 + 1) * D; const float* lb = p.in[I_LNB] + (size_t)(l * 2 + 1) * D;
    constexpr int NR = 5;
    for (int k = gw; k < tlim; k += NGW * NR) {
        int t[NR]; bool ok[NR]; f32x4 x[NR][D / 256]; float s[NR], s2[NR];
#pragma unroll
        for (int r = 0; r < NR; ++r) { const int tt = k + r * NGW; ok[r] = tt < tlim; t[r] = ok[r] ? tt : k; }
        v4u rt[NR]; int p0[NR], p1[NR];
#pragma unroll
        for (int r = 0; r < NR; ++r) { rt[r] = *(const v4u*)(WSP(unsigned, WS_ROUTE) + (size_t)t[r] * 4); p0[r] = WSP(int, WS_POS)[(size_t)t[r] * 2]; p1[r] = WSP(int, WS_POS)[(size_t)t[r] * 2 + 1]; }
#pragma unroll
        for (int r = 0; r < NR; ++r) { const int which = t[r] < SEQ ? 0 : 1; const unsigned uz = rt[r].z, uw = rt[r].w; const float w0 = u2f(uz), w1 = u2f(uw);
            const float* g2 = modv(p, l, which, 5); const float* h = hrow(p, t[r]); s[r] = 0.f;
#pragma unroll
            for (int j = 0; j < D / 256; ++j) { const int c = 4 * lane + 256 * j;
                const v2u ya = *(const v2u*)(YS + (size_t)p0[r] * D + c), yb = *(const v2u*)(YS + (size_t)p1[r] * D + c);
                const f32x4 f = (f32x4){bflo(ya.x), bfhi(ya.x), bflo(ya.y), bfhi(ya.y)} * w0 + (f32x4){bflo(yb.x), bfhi(yb.x), bflo(yb.y), bfhi(yb.y)} * w1;
                x[r][j] = *(const f32x4*)(h + c) * DN_ALPHA + *(const f32x4*)(g2 + c) * f; s[r] += (x[r][j][0] + x[r][j][1]) + (x[r][j][2] + x[r][j][3]); } }
#pragma unroll
        for (int r = 0; r < NR; ++r) s[r] = wave_sum(s[r]) * (1.f / D);
#pragma unroll
        for (int r = 0; r < NR; ++r) { s2[r] = 0.f;
#pragma unroll
            for (int j = 0; j < D / 256; ++j) { x[r][j] = x[r][j] - s[r]; s2[r] += (x[r][j][0] * x[r][j][0] + x[r][j][1] * x[r][j][1]) + (x[r][j][2] * x[r][j][2] + x[r][j][3] * x[r][j][3]); } }
#pragma unroll
        for (int r = 0; r < NR; ++r) s2[r] = frsq(wave_sum(s2[r]) * (1.f / D) + LN_EPS);
#pragma unroll
        for (int r = 0; r < NR; ++r) { if (!ok[r]) continue; const int which = t[r] < SEQ ? 0 : 1; float* h = hrow(p, t[r]);
#pragma unroll
            for (int j = 0; j < D / 256; ++j) { const int c = 4 * lane + 256 * j;
                const f32x4 h2 = x[r][j] * s2[r] * *(const f32x4*)(lg + c) + *(const f32x4*)(lb + c);
                *(f32x4*)((dummy ? WSP(float, WS_XS) + (size_t)t[r] * D : h) + c) = h2;
                if (l + 1 < DEPTH) { const f32x4 q = *(const f32x4*)(modv(p, l + 1, which, 1) + c), sv = *(const f32x4*)(modv(p, l + 1, which, 0) + c);
                    v2u w; w.x = pk2(h2[0] * (1.f + q[0]) + sv[0], h2[1] * (1.f + q[1]) + sv[1]); w.y = pk2(h2[2] * (1.f + q[2]) + sv[2], h2[3] * (1.f + q[3]) + sv[3]);
                    *(v2u*)(WSP(bf16, WS_U) + (size_t)t[r] * D + c) = w; } } }
    }
}
__device__ __forceinline__ float ssd_rms_scale(const float* ssq, int row) {
    const float* q = ssq + (size_t)row * 24; float s = 0.f;
#pragma unroll
    for (int j = 0; j < 6; ++j) { const f32x4 v = *(const f32x4*)(q + 4 * j); s += (v[0] + v[1]) + (v[2] + v[3]); }
    return frsq(s * (1.0f / SSD_D) + LN_EPS);
}
constexpr int CTX_TILES = (CTX / 32) * (D / 32);
__device__ __forceinline__ void ctx_reduce_store(LAS unsigned char* lds, const f32x16& tot, int tid, float (&out2)[2]) {
    LAS float* red = (LAS float*)lds; const int lane = tid & 63, wave = tid >> 6;
    __syncthreads();
#pragma unroll
    for (int i = 0; i < 16; ++i) red[(wave * 16 + i) * 64 + lane] = tot[i];
    __syncthreads();
#pragma unroll
    for (int q = 0; q < 2; ++q) { const int e = tid + q * NTHR; float s = 0.f;
#pragma unroll
        for (int w = 0; w < NWAVES; ++w) s += red[w * 1024 + e];
        out2[q] = s; }
}
__device__ __forceinline__ void ctx_h_tile(KPR p, LAS unsigned char* lds, int tile, int tid) {
    const int rb = tile / (D / 32), cb = tile % (D / 32), lane = tid & 63, wave = tid >> 6, r = lane & 31, hh = lane >> 5;
    const int row0 = SEQ + 32 * rb, col0 = 32 * cb;
    const bf16* P = WSP(bf16, WS_P); const float* ssq = WSP(float, WS_SSQ);
    f32x16 tot;
#pragma unroll
    for (int i = 0; i < 16; ++i) tot[i] = 0.f;
    float rsc[16];
#pragma unroll
    for (int i = 0; i < 16; ++i) { rsc[i] = ssd_rms_scale(ssq, row0 + (i & 3) + 8 * (i >> 2) + 4 * hh); if ((i & 3) == 3) CFENCE(); }
#pragma unroll 1
    for (int br = 0; br < 4; ++br) {
        const int K = (br == 1) ? 768 : 512, ksl = K / 8;
        const int koff = br == 0 ? YOFF_A : (br == 1 ? YOFF_B : (br == 2 ? YOFF_C : YOFF_D));
        const bf16* A = WSP(bf16, WS_Y) + (size_t)(row0 + r) * YK + koff + wave * ksl + 8 * hh;
        const bf16* B = WSP(bf16, WS_WCAT) + (size_t)(col0 + r) * YK + koff + wave * ksl + 8 * hh;
        unsigned short g16[16];
#pragma unroll
        for (int i = 0; i < 16; ++i) g16[i] = P[(size_t)(row0 + (i & 3) + 8 * (i >> 2) + 4 * hh) * NP + OFF_G + br * D + col0 + r];
        f32x16 acc;
#pragma unroll
        for (int i = 0; i < 16; ++i) acc[i] = 0.f;
#pragma unroll 6
        for (int ks = 0; ks < ksl / 16; ++ks) acc = MFMA32(as_bf16x8(*(const v4u*)(A + 16 * ks)), as_bf16x8(*(const v4u*)(B + 16 * ks)), acc);
#pragma unroll
        for (int i = 0; i < 16; ++i) { float g = sigmoidf_(bf2f(g16[i]));
            if (br == 1) g *= rsc[i];
            tot[i] += g * acc[i]; }
    }
    float o2[2]; ctx_reduce_store(lds, tot, tid, o2);
#pragma unroll
    for (int q = 0; q < 2; ++q) { const int e = tid + q * NTHR, i = e >> 6, ln = e & 63; const int row = row0 + (i & 3) + 8 * (i >> 2) + 4 * (ln >> 5), col = col0 + (ln & 31);
        WSP(bf16, WS_U)[(size_t)row * D + col] = (bf16)f2bf(o2[q]); }
}
__device__ __forceinline__ void ctx_i_tile(KPR p, int l, LAS unsigned char* lds, int tile, int tid) {
    const int rb = tile / (D / 32), cb = tile % (D / 32), lane = tid & 63, wave = tid >> 6, r = lane & 31, hh = lane >> 5;
    const int row0 = SEQ + 32 * rb, col0 = 32 * cb; constexpr int ksl = D / 8;
    const bf16* A = WSP(bf16, WS_U) + (size_t)(row0 + r) * D + wave * ksl + 8 * hh;
    const bf16* B = WSP(bf16, WS_WOUT) + (size_t)(col0 + r) * D + wave * ksl + 8 * hh;
    f32x16 acc;
#pragma unroll
    for (int i = 0; i < 16; ++i) acc[i] = 0.f;
#pragma unroll
    for (int ks = 0; ks < ksl / 16; ++ks) acc = MFMA32(as_bf16x8(*(const v4u*)(A + 16 * ks)), as_bf16x8(*(const v4u*)(B + 16 * ks)), acc);
    float o2[2]; ctx_reduce_store(lds, acc, tid, o2);
#pragma unroll
    for (int q = 0; q < 2; ++q) { const int e = tid + q * NTHR, i = e >> 6, ln = e & 63; const int row = row0 + (i & 3) + 8 * (i >> 2) + 4 * (ln >> 5), col = col0 + (ln & 31);
        WSP(bf16, WS_MG)[(size_t)row * D + col] = (bf16)f2bf(o2[q]); }
}
__device__ NOINLINE void e_pre0() { ENTRY_BEGIN; phase_mod(p, lds, tid, bid, G); conv_weights(p, 0, lds, gw, NGW, lane, wave); }
__device__ NOINLINE void e_u0() { ENTRY_BEGIN; phase_u0(p, gw, NGW, lane); }
__device__ NOINLINE void e_gemm_b() { ENTRY_BEGIN;
    DenseOrder S; S.init(MT, NP, D, G, bid, WSP(bf16, WS_U), WSP(bf16, WS_WIN)); EpiPG E{WSP(bf16, WS_P), NP};
    pg8::gemm_phase<EpiPG, DenseOrder, GEMM1_ALIGN, GEMM1_SP2>(lds, D, S, E, tid); }
__device__ NOINLINE void e_c1(int l, int idx) { ENTRY_BEGIN; c1_conformer(p, UNI(l), lds, UNI(idx), tid); }
__device__ NOINLINE void e_cw(int l, int nheavy, int last) { ENTRY_BEGIN; __syncthreads();
    if (bid >= nheavy) c_wave_items(p, UNI(l), lds, (bid - nheavy) * NWAVES + wave, (G - nheavy) * NWAVES, lane, wave, UNI(last));
    __syncthreads(); }
__device__ NOINLINE void e_c5(int l) { ENTRY_BEGIN; __syncthreads(); c5_load_weights(p, UNI(l), lds, tid); __syncthreads(); for (int it = bid; it < C5_ITEMS; it += G) c5_item(p, UNI(l), lds, it, tid); __syncthreads(); }
__device__ NOINLINE void e_c6(int l, int idx) { ENTRY_BEGIN; c6_taps_item(p, UNI(l), lds, UNI(idx), tid); }
__device__ NOINLINE void e_hyena(int l, int c, int isctx) { ENTRY_BEGIN;
    f32x4* fscr = WSP(f32x4, WS_FSCR) + (size_t)bid * (SEQ / 2 + 1); f32x2* zscr = WSP(f32x2, WS_ZSCR) + (size_t)bid * (SEQ / 2);
    if (UNI(isctx)) hyena_item<CTX>(p, UNI(l), lds, UNI(c), SEQ, fscr, zscr, tid); else hyena_item<SEQ>(p, UNI(l), lds, UNI(c), 0, fscr, zscr, tid); }
__device__ NOINLINE void e_dssd(int l, int idx, int e_only) { ENTRY_BEGIN; d_ssd_item(p, UNI(l), lds, UNI(idx), UNI(e_only), tid); }
__device__ NOINLINE void e_scan() { ENTRY_BEGIN; for (int it = bid; it < E_ITEMS; it += G) e_scan_item(p, it, tid); }
__device__ NOINLINE void e_fssd(int l, int c, int g, int e0, int e1) { ENTRY_BEGIN; f_ssd_item(p, UNI(l), lds, UNI(c), UNI(g), UNI(e0), UNI(e1), tid); }
__device__ NOINLINE void e_fyct(int idx) { ENTRY_BEGIN; f_yct_item(p, lds, UNI(idx), tid); }
__device__ NOINLINE void e_gemm_h() { ENTRY_BEGIN;
    LAS float* rs = (LAS float*)(lds + 131072);
    { DenseOrder T; T.init(SEQ, D, YK, G, bid, nullptr, nullptr); pg8::Unit u; const float* ssq = WSP(float, WS_SSQ);
      __syncthreads();
      for (int i = 0; i < 8 && T.next(i, u); ++i) if (tid < 256) rs[i * 256 + tid] = ssd_rms_scale(ssq, u.pm * 256 + tid);
      __syncthreads(); }
    DenseOrder S; S.init(SEQ, D, YK, G, bid, WSP(bf16, WS_Y), WSP(bf16, WS_WCAT));
    EpiMerge E{WSP(bf16, WS_P) + OFF_G, WSP(bf16, WS_U), rs};
    int Kq = YK; OPAQUE_S(Kq);
    pg8::gemm_phase<EpiMerge, DenseOrder, true, true>(lds, Kq, S, E, tid); }
__device__ NOINLINE void e_gemm_i() { ENTRY_BEGIN;
    DenseOrder S; S.init(SEQ, D, D, G, bid, WSP(bf16, WS_U), WSP(bf16, WS_WOUT));
    EpiP E{WSP(bf16, WS_MG), D};
    pg8::gemm_phase<EpiP, DenseOrder, true, true>(lds, D, S, E, tid); }
__device__ NOINLINE void e_ctx_h() { ENTRY_BEGIN; for (int t = bid; t < CTX_TILES; t += G) ctx_h_tile(p, lds, t, tid); __syncthreads(); }
__device__ NOINLINE void e_ctx_i(int l) { ENTRY_BEGIN; for (int t = bid; t < CTX_TILES; t += G) ctx_i_tile(p, UNI(l), lds, t, tid); __syncthreads(); }
__device__ NOINLINE void e_r(int l, int tlim) { ENTRY_BEGIN; if (PROBE_DBL & 4194304) phase_r(p, UNI(l), lds, tid, bid, G, UNI(tlim), true); phase_r(p, UNI(l), lds, tid, bid, G, UNI(tlim)); }
__device__ NOINLINE void e_g(int tlim) { ENTRY_BEGIN; phase_g(p, lds, tid, bid, G, UNI(tlim)); }
__device__ NOINLINE void e_gemm_m1() { ENTRY_BEGIN;
    MoeOrder S{WSP(int, WS_TILEE), UNI(WSP(int, WS_TILEE)[NTMAX]), 2 * FF / 256, G, bid, (const char*)WSP(bf16, WS_XS), (const char*)WSP(bf16, WS_WGU), (size_t)256 * D * 2, (size_t)2 * FF * D * 2, (size_t)256 * D * 2};
    EpiSwiGLU E{WSP(bf16, WS_HS)};
    pg8::gemm_phase<EpiSwiGLU, MoeOrder, true, true>(lds, D, S, E, tid); }
__device__ NOINLINE void e_gemm_m2() { ENTRY_BEGIN;
    MoeOrder S{WSP(int, WS_TILEE), UNI(WSP(int, WS_TILEE)[NTMAX]), D / 256, G, bid, (const char*)WSP(bf16, WS_HS), (const char*)WSP(bf16, WS_WDN), (size_t)256 * FF * 2, (size_t)D * FF * 2, (size_t)256 * FF * 2};
    EpiP E{WSP(bf16, WS_YS), D};
    pg8::gemm_phase<EpiP, MoeOrder, true, true>(lds, FF, S, E, tid); }
__device__ NOINLINE void e_n(int l_) { ENTRY_BEGIN; const int l = UNI(l_); const int tlim = (l == DEPTH - 1) ? SEQ : MT; if (PROBE_DBL & 8388608) phase_n(p, l, gw, NGW, lane, tlim, true); phase_n(p, l, gw, NGW, lane, tlim); if (l + 1 < DEPTH) { conv_weights(p, l + 1, lds, gw, NGW, lane, wave); if (PROBE_DBL & 8) conv_weights(p, l + 1, lds, gw, NGW, lane, wave); } }

constexpr int NPH_PRE = 2, NPH_LAYER = 12, NPHASES = NPH_PRE + DEPTH * NPH_LAYER;
__global__ void __launch_bounds__(NTHR, 2) fwd_kernel(KParams kp) {
#ifdef CPU_EMU
    static KParams kp_static; kp_static = kp; g_emu_kp = &kp_static;
    const int lo = kp.ph_lo, hi = kp.ph_hi;
    XcdBarrier bar; bar.dummy = 0;
#else
    KP_DECL; LDS_DECL;
    const int lo = p.ph_lo, hi = p.ph_hi;
    volatile LAS unsigned* misc = (volatile LAS unsigned*)(lds + LDS_BYTES - 256);
    if (threadIdx.x < 64) misc[threadIdx.x] = 0u;
    __syncthreads();
    unsigned* ctl = WSP(unsigned, WS_CTL);
    XcdBarrier bar; bar.bar = ctl + CW_BAR; bar.x = 0; bar.st = misc;
    if (hi - lo > 1) bar = xcd_barrier_post(ctl + CW_BAR, misc);
#endif
    const int bid = blockIdx.x, G = gridDim.x;
#ifndef PH_MASK
#define PH_MASK 0xffffffu
#endif
#define PHON(k) ((PH_MASK >> (k)) & 1u)
#define IN(k) (lo <= (k) && (k) < hi)
#define SEAM(k) do { if (IN(k) && IN((k) + 1)) { xcd_barrier(bar); if (PROBE_DBL & 524288) { xcd_barrier(bar); xcd_barrier(bar); } } } while (0)
    if (PHON(0) && IN(0)) { e_pre0(); e_c5(0); if (PROBE_DBL & 4096) e_c5(0); }
    SEAM(0);
    if (PHON(1) && IN(1)) e_u0();
    SEAM(1);
    for (int l = 0; l < DEPTH; ++l) {
        const int b0 = NPH_PRE + l * NPH_LAYER;
        const int last = (l == DEPTH - 1) ? 1 : 0, tlim = last ? SEQ : MT;
        if (PHON(2) && IN(b0 + 0)) { e_gemm_b(); if (PROBE_DBL & 128) e_gemm_b(); }
        SEAM(b0 + 0);
        if (PHON(3) && IN(b0 + 1)) {
            for (int it = bid; it < C6_ITEMS; it += G) { if (last && (it / 8) * 256 >= SEQ) continue; e_c6(l, it); }
            {
                const int c1n = last ? C1_LAT : C1_ITEMS;
                const int xcd = bid & 7, slot = bid >> 3, per = (c1n + 7) / 8, nslot = (G + 7) / 8;
                int nheavy = 0;
                if ((G & 7) == 0) { for (int j = slot; j < per; j += nslot) { const int it = xcd * per + j; if (it < c1n) e_c1(l, it); }
                    if (nslot < per && per <= 2 * nslot) { for (int x = 0; x < 8; ++x) if (x * per + nslot < c1n) nheavy = x + 1; if (nheavy * 4 > G) nheavy = 0; } }
                else for (int it = bid; it < c1n; it += G) e_c1(l, it);
                e_cw(l, nheavy, last);
            }
            if (PROBE_DBL & 16) { for (int it = bid; it < C_ITEMS; it += G) { if (it < C6_ITEMS) e_c6(l, it); else e_c1(l, it - C6_ITEMS); } e_cw(l, 0, last); }
            if (PROBE_DBL & 65536) for (int it = bid; it < C6_ITEMS; it += G) e_c6(l, it);
            if (PROBE_DBL & 131072) for (int it = bid; it < C1_ITEMS; it += G) e_c1(l, it);
            if (PROBE_DBL & 262144) e_cw(l, 0, last); }
        SEAM(b0 + 1);
        if (PHON(4) && IN(b0 + 2)) for (int it = bid; it < D_ITEMS; it += G) {
            int r = it;
            if (r < D_HY_LAT) { e_hyena(l, r, 0); if (PROBE_DBL & 1) e_hyena(l, r, 0); continue; } r -= D_HY_LAT;
            if (r < D_SSD) { e_dssd(l, r, -1); if (PROBE_DBL & 2) e_dssd(l, r, -1); continue; } r -= D_SSD;
            if (!last) { e_hyena(l, r, 1); if (PROBE_DBL & 8192) e_hyena(l, r, 1); } }
        SEAM(b0 + 2);
        if (PHON(5) && IN(b0 + 3)) { e_scan(); if (PROBE_DBL & 1048576) e_scan(); }
        SEAM(b0 + 3);
        const int fgap = (!last && F_SSD_LAT % G == 0 && G > 2 * F_SSD_CTX) ? F_SSD_CTX : 0;
        if (PHON(6) && IN(b0 + 4)) for (int it = bid; it < F_ITEMS + fgap; it += G) { int r = it;
            if (r < F_SSD_LAT + F_SSD_CTX) { int c_, g_, e0_, e1_;
                if (r >= F_SSD_LAT && last) continue;
                if (r < F_SSD_LAT) { c_ = r / NG; g_ = r % NG; e0_ = 0; e1_ = HPG; } else { const int q = r - F_SSD_LAT, cg = q / HPG; c_ = NCH_LAT + cg / NG; g_ = cg % NG; e0_ = q % HPG; e1_ = e0_ + 1; }
                e_fssd(l, c_, g_, e0_, e1_); if (PROBE_DBL & 4) e_fssd(l, c_, g_, e0_, e1_); continue; }
            r -= F_SSD_LAT + F_SSD_CTX;
            if (fgap) { if (r >= G - fgap && r < G) continue; if (r >= G) r -= fgap; }
            if (last && r >= SEQ / 64) continue;
            e_fyct(r); if (PROBE_DBL & 2097152) e_fyct(r); }
        SEAM(b0 + 4);
        if (PHON(7) && IN(b0 + 5)) { if (!last) e_ctx_h(); if (PROBE_DBL & 16384) e_ctx_h(); e_gemm_h(); if (PROBE_DBL & 256) e_gemm_h(); }
        SEAM(b0 + 5);
        if (PHON(8) && IN(b0 + 6)) { if (!last) e_ctx_i(l); if (PROBE_DBL & 16384) e_ctx_i(l); e_gemm_i(); if (PROBE_DBL & 512) e_gemm_i(); }
        SEAM(b0 + 6);
        if (PHON(9) && IN(b0 + 7)) { e_r(l, tlim); if (PROBE_DBL & 32) e_r(l, tlim); }
        SEAM(b0 + 7);
        if (PHON(10) && IN(b0 + 8)) { e_g(tlim); if (PROBE_DBL & 64) e_g(tlim); }
        SEAM(b0 + 8);
        if (PHON(11) && IN(b0 + 9)) { e_gemm_m1(); if (PROBE_DBL & 1024) e_gemm_m1(); }
        SEAM(b0 + 9);
        if (PHON(12) && IN(b0 + 10)) { e_gemm_m2(); if (PROBE_DBL & 2048) e_gemm_m2(); }
        SEAM(b0 + 10);
        if (PHON(13) && IN(b0 + 11)) { e_n(l); if (l + 1 < DEPTH) { e_c5(l + 1); if (PROBE_DBL & 4096) e_c5(l + 1); } }
        SEAM(b0 + 11);
    }
#undef IN
#undef SEAM
}

#ifndef CPU_EMU
extern "C" void kernel_launch(void* const* d_in, const int* in_sizes, int n_in, void* d_out, int out_size, void* d_ws, size_t ws_size, hipStream_t stream) {
    static int grid = 0;
    if (grid == 0) {
        if (n_in != N_IN || out_size != SEQ * D || ws_size < WS_END) { fprintf(stderr, "kernel_launch: unexpected shapes (n_in %d out %d ws %zu need %zu)\n", n_in, out_size, ws_size, (size_t)WS_END); grid = -1; return; }
        int dev = 0, cus = 0, per_cu = 0;
        if (hipGetDevice(&dev) != hipSuccess || hipDeviceGetAttribute(&cus, hipDeviceAttributeMultiprocessorCount, dev) != hipSuccess) { grid = -1; return; }
        if (hipFuncSetAttribute((const void*)fwd_kernel, hipFuncAttributeMaxDynamicSharedMemorySize, LDS_BYTES) != hipSuccess) { fprintf(stderr, "kernel_launch: hipFuncSetAttribute failed\n"); grid = -1; return; }
        if (hipOccupancyMaxActiveBlocksPerMultiprocessor(&per_cu, (const void*)fwd_kernel, NTHR, LDS_BYTES) != hipSuccess || per_cu < 1) fprintf(stderr, "kernel_launch: occupancy query reports %d\n", per_cu);
        (void)hipGetLastError();
        grid = cus < 256 ? cus : 256;
    }
    if (grid < 0) return;
    if (hipMemsetAsync((char*)d_ws + WS_CTL, 0, CTL_BYTES, stream) != hipSuccess) return;
    KParams a{};
    for (int i = 0; i < N_IN; ++i) a.in[i] = (const float*)d_in[i];
    a.out = (float*)d_out; a.ws = (unsigned char*)d_ws;
#if MK_MULTI
    for (int ph = 0; ph < NPHASES; ++ph) { a.ph_lo = ph; a.ph_hi = ph + 1; hipLaunchKernelGGL(fwd_kernel, dim3(grid), dim3(NTHR), LDS_BYTES, stream, a); }
#else
    a.ph_lo = 0; a.ph_hi = NPHASES; hipLaunchKernelGGL(fwd_kernel, dim3(grid), dim3(NTHR), LDS_BYTES, stream, a);
#endif
}
#endif
```

```cpp
#ifndef CPU_EMU
#include <hip/hip_runtime.h>
#endif
#include <stdint.h>
#include <stdio.h>

#ifndef CFG_D
#define CFG_D 1024
#define CFG_SEQ 16384
#define CFG_DEPTH 4
#endif
#ifndef MK_MULTI
#define MK_MULTI 0
#endif

constexpr int D = CFG_D, SEQ = CFG_SEQ, DEPTH = CFG_DEPTH, CTX = 256, MT = SEQ + CTX;
constexpr int GRID_W = 64, ROWS = SEQ / GRID_W;
constexpr int CONF_D = 512, CONF_K = 31;
constexpr int SSD_D = 768, NH = 12, HD = 64, NG = 4, HPG = 3, NS = 128, XBC = 1792, SSD_PROJ = 2584, CHUNK = 128, NCH = MT / CHUNK, NCH_LAT = SEQ / CHUNK;
constexpr int HY_D = 512, SC_D = 512, HY_NF = 2048;
constexpr int OFF_A = 0, OFF_B = 1024, OFF_C = 3608, OFF_D = 5144, OFF_G = 6680, PROJ = OFF_G + 4 * D, NP = (PROJ + 255) / 256 * 256;
constexpr int NE = 32, FF = 512, NRMAX = ((2 * MT + NE * 255) / 256 + 1) * 256, NTMAX = NRMAX / 256;
constexpr float LN_EPS = 1e-5f;
constexpr int NTHR = 512, NWAVES = 8;
constexpr int LDS_BYTES = 163840, STAGE_REGION = 131072, MISC_OFF = 131072 + 16384;

enum { I_X = 0, I_C, I_CTX, I_CCTX, I_WMOD, I_BMOD, I_LNG, I_LNB, I_WIN, I_CDWW, I_CDWB, I_CLNG, I_CLNB, I_SCW, I_SCB, I_SALOG, I_SDTB, I_SD, I_SNG,
       I_HSW, I_HSB, I_HW1, I_HB1, I_HW2, I_HB2, I_HFREQ, I_HW3, I_HBIAS, I_SCCW, I_WBA, I_WBB, I_WBC, I_WBD, I_WOUT, I_RGW, I_RGB, I_REW, I_REB, I_EWG, I_EWU, I_EWD, N_IN };

constexpr size_t al256(size_t x) { return (x + 255) & ~(size_t)255; }
constexpr size_t WS_CTL = 0, CTL_BYTES = 1u << 20;
constexpr size_t WS_MODV = WS_CTL + CTL_BYTES;
constexpr size_t WS_WIN = al256(WS_MODV + (size_t)DEPTH * 2 * 6 * D * 4);
constexpr size_t WS_WCAT = al256(WS_WIN + (size_t)NP * D * 2);
constexpr size_t WS_WOUT = al256(WS_WCAT + (size_t)D * 2304 * 2);
constexpr size_t WS_WGU = al256(WS_WOUT + (size_t)D * D * 2);
constexpr size_t WS_WDN = al256(WS_WGU + (size_t)NE * 2 * FF * D * 2);
constexpr size_t WS_HC = al256(WS_WDN + (size_t)NE * D * FF * 2);
constexpr size_t WS_U = al256(WS_HC + (size_t)CTX * D * 4);
constexpr size_t WS_P = al256(WS_U + (size_t)MT * D * 2);
constexpr size_t P_BYTES = (size_t)MT * NP * 2;
constexpr size_t WS_XS = WS_P;
constexpr size_t WS_HS = al256(WS_XS + (size_t)NRMAX * D * 2);
constexpr size_t WS_YS = al256(WS_HS + (size_t)NRMAX * FF * 2);
constexpr size_t MOE_END = WS_YS + (size_t)NRMAX * D * 4;
constexpr size_t WS_Y = al256(WS_P + (P_BYTES > (MOE_END - WS_P) ? P_BYTES : (MOE_END - WS_P)));
constexpr int YK = 2304, YOFF_A = 0, YOFF_B = 512, YOFF_C = 1280, YOFF_D = 1792;
constexpr size_t WS_MG = al256(WS_Y + (size_t)MT * YK * 2);
constexpr size_t WS_TAPS = WS_MG;
constexpr size_t MG_BYTES = (size_t)MT * D * 4 > (size_t)2048 * MT * 2 ? (size_t)MT * D * 4 : (size_t)2048 * MT * 2;
constexpr size_t WS_XC = al256(WS_MG + MG_BYTES);
constexpr size_t WS_XCT = al256(WS_XC + (size_t)MT * XBC * 2);
constexpr size_t WS_DT = al256(WS_XCT + (size_t)1280 * MT * 2);
constexpr size_t WS_ACUM = al256(WS_DT + (size_t)MT * 24 * 4);
constexpr size_t WS_CDEC = al256(WS_ACUM + (size_t)2 * NH * MT * 4);
constexpr size_t WS_ST = al256(WS_CDEC + (size_t)2 * NCH * NH * 4);
constexpr size_t WS_HIN = al256(WS_ST + (size_t)2 * NCH * NH * HD * NS * 4);
constexpr size_t WS_SSQ = al256(WS_HIN + (size_t)2 * NCH * NH * HD * NS * 2);
constexpr size_t WS_QT = al256(WS_SSQ + (size_t)MT * 24 * 4);
constexpr size_t WS_HID2 = al256(WS_QT + (size_t)1536 * MT * 2);
constexpr size_t WS_YCT = al256(WS_HID2 + (size_t)MT * 64 * 4);
constexpr size_t WS_FSCR = al256(WS_YCT + (size_t)512 * MT * 2);
constexpr size_t WS_ZSCR = al256(WS_FSCR + (size_t)256 * (SEQ / 2 + 1) * 16);
constexpr size_t WS_ROUTE = al256(WS_ZSCR + (size_t)256 * (SEQ / 2) * 8);
constexpr size_t WS_POS = al256(WS_ROUTE + (size_t)MT * 16);
constexpr size_t WS_HIST = al256(WS_POS + (size_t)MT * 8);
constexpr size_t WS_TILEE = al256(WS_HIST + 256 * 32 * 4);
constexpr size_t WS_END = al256(WS_TILEE + (NTMAX + 64) * 4);
constexpr int CW_BAR = 0;
constexpr int CW_QUEUE = 4096;

#ifdef CPU_EMU
#define LAS
#define GAS
#else
#define LAS __attribute__((address_space(3)))
#define GAS __attribute__((address_space(1)))
#endif
typedef unsigned short bf16;
typedef unsigned v4u __attribute__((ext_vector_type(4)));
typedef unsigned v2u __attribute__((ext_vector_type(2)));
typedef float f32x4 __attribute__((ext_vector_type(4)));
typedef float f32x2 __attribute__((ext_vector_type(2)));
typedef short bf16x8 __attribute__((ext_vector_type(8)));
typedef float f32x16 __attribute__((ext_vector_type(16)));
#define MFMA32(a, b, c) __builtin_amdgcn_mfma_f32_32x32x16_bf16(a, b, c, 0, 0, 0)
#ifdef CPU_EMU
__device__ __forceinline__ unsigned f2bf(float f) { unsigned u = __builtin_bit_cast(unsigned, f); return (u + 0x7fffu + ((u >> 16) & 1u)) >> 16; }
__device__ __forceinline__ unsigned pk2(float lo, float hi) { return f2bf(lo) | (f2bf(hi) << 16); }
#else
__device__ __forceinline__ unsigned f2bf(float f) { unsigned r; asm("v_cvt_pk_bf16_f32 %0, %1, 0" : "=v"(r) : "v"(f)); return r; }
__device__ __forceinline__ unsigned pk2(float lo, float hi) { unsigned r; asm("v_cvt_pk_bf16_f32 %0, %1, %2" : "=v"(r) : "v"(lo), "v"(hi)); return r; }
#endif
__device__ __forceinline__ float bf2f(unsigned h) { return __builtin_bit_cast(float, (h & 0xffffu) << 16); }
__device__ __forceinline__ float u2f(unsigned u) { return __builtin_bit_cast(float, u); }
__device__ __forceinline__ unsigned f2u(float f) { return __builtin_bit_cast(unsigned, f); }
__device__ __forceinline__ float bflo(unsigned w) { return __builtin_bit_cast(float, w << 16); }
__device__ __forceinline__ float bfhi(unsigned w) { return __builtin_bit_cast(float, w & 0xffff0000u); }
#ifdef CPU_EMU
__device__ __forceinline__ float frcp(float x) { return 1.0f / x; }
__device__ __forceinline__ float frsq(float x) { return 1.0f / sqrtf(x); }
__device__ __forceinline__ float flog(float x) { return logf(x); }
#else
__device__ __forceinline__ float frcp(float x) { return __builtin_amdgcn_rcpf(x); }
__device__ __forceinline__ float frsq(float x) { return __builtin_amdgcn_rsqf(x); }
__device__ __forceinline__ float flog(float x) { return __logf(x); }
#endif
__device__ __forceinline__ float sigmoidf_(float x) { return frcp(1.0f + __expf(-x)); }
__device__ __forceinline__ float siluf_(float x) { return x * frcp(1.0f + __expf(-x)); }
#ifdef CPU_EMU
__device__ __forceinline__ float wave_sum(float v) {
#pragma unroll
    for (int o = 1; o < 64; o <<= 1) v += __shfl_xor(v, o);
    return v;
}
__device__ __forceinline__ float half_sum32(float v) {
#pragma unroll
    for (int o = 1; o < 32; o <<= 1) v += __shfl_xor(v, o);
    return v;
}
#else
template <int CTRL, int RMASK> __device__ __forceinline__ float dpp_add(float v) { return v + u2f((unsigned)__builtin_amdgcn_update_dpp(0, (int)f2u(v), CTRL, RMASK, 0xF, false)); }
__device__ __forceinline__ float row_sum16(float v) {
    v = dpp_add<0xB1, 0xF>(v);
    v = dpp_add<0x4E, 0xF>(v);
    v = dpp_add<0x141, 0xF>(v);
    v = dpp_add<0x140, 0xF>(v);
    return v;
}
__device__ __forceinline__ float half_sum32(float v) {
    v = row_sum16(v);
    return dpp_add<0x142, 0xA>(v);
}
__device__ __forceinline__ float wave_sum(float v) {
    v = half_sum32(v);
    v = dpp_add<0x143, 0xC>(v);
    return u2f((unsigned)__builtin_amdgcn_readlane((int)f2u(v), 63));
}
#endif
#ifdef CPU_EMU
#define LDS_WAIT()
#define VM_WAIT()
__device__ __forceinline__ void sincos_turns(float t, float& s, float& c) { s = sinf(6.283185307179586f * t); c = cosf(6.283185307179586f * t); }
#else
#define LDS_WAIT() asm volatile("s_waitcnt lgkmcnt(0)" ::: "memory")
#define VM_WAIT() asm volatile("s_waitcnt vmcnt(0)" ::: "memory")
__device__ __forceinline__ void sincos_turns(float t, float& s, float& c) { s = __builtin_amdgcn_sinf(t); c = __builtin_amdgcn_cosf(t); }
#endif

#ifndef CPU_EMU
#define XB_TMO      128
#define XB_XCNT(j)  (256  + 64 * (j))
#define XB_XSUB(j)  (1280 + 64 * (j))
#define XB_XGEN(j)  (2304 + 64 * (j))
#define XB_TOP      3328
#define XB_TOPGEN   3392
#define XCD_BAR_WORDS 3456
#define XB_SPIN_CAP (1u << 18)
__device__ __forceinline__ unsigned xb_ld(unsigned* p)              { return __hip_atomic_load(p, __ATOMIC_RELAXED, __HIP_MEMORY_SCOPE_AGENT); }
__device__ __forceinline__ unsigned xb_add(unsigned* p, unsigned v) { return __hip_atomic_fetch_add(p, v, __ATOMIC_RELAXED, __HIP_MEMORY_SCOPE_AGENT); }
__device__ __forceinline__ unsigned xb_xcc_id() { return (unsigned)__builtin_amdgcn_s_getreg((3 << 11) | 20) & 0xFu; }
#define XB_SPIN(cond, bar) do { unsigned _sp = 0; while (cond) { __builtin_amdgcn_s_sleep(1); \
    if ((++_sp & 255u) == 0u) { if (xb_ld(&(bar)[XB_TMO])) break; if (_sp > XB_SPIN_CAP) { atomicAdd(&(bar)[XB_TMO], 1u); break; } } } } while (0)
struct XcdBarrier { unsigned* bar; unsigned x; volatile LAS unsigned* st; };
__device__ __forceinline__ XcdBarrier xcd_barrier_post(unsigned* bar, volatile LAS unsigned* st) {
    XcdBarrier b; b.bar = bar; b.x = xb_xcc_id(); b.st = st;
    if (threadIdx.x == 0) (void)xb_add(&bar[XB_XCNT(b.x)], 1u);
    return b;
}
__device__ __forceinline__ void xcd_barrier_complete(unsigned* bar, unsigned x, unsigned& nloc, unsigned& nx) {
    const unsigned G = gridDim.x * gridDim.y * gridDim.z;
    unsigned sum, cnt, mine, sp = 0u;
    for (;;) {
        sum = 0u; cnt = 0u; mine = 0u;
#pragma unroll
        for (unsigned j = 0; j < 16; ++j) { const unsigned c = xb_ld(&bar[XB_XCNT(j)]); sum += c; cnt += (c > 0u) ? 1u : 0u; mine = (j == x) ? c : mine; }
        if (sum == G) break;
        __builtin_amdgcn_s_sleep(1);
        if ((++sp & 255u) == 0u) { if (xb_ld(&bar[XB_TMO])) break; if (sp > XB_SPIN_CAP) { atomicAdd(&bar[XB_TMO], 1u); break; } }
    }
    nloc = mine > 0u ? mine : 1u; nx = cnt > 0u ? cnt : 1u;
}
__device__ __forceinline__ void xcd_barrier(const XcdBarrier& b) {
    asm volatile("s_waitcnt vmcnt(0)" ::: "memory");
    __syncthreads();
    if (threadIdx.x == 0) {
        unsigned* bar = b.bar;
        __builtin_amdgcn_s_waitcnt(0);
        unsigned nloc = b.st[0], nx = b.st[1];
        if (nloc == 0u) { xcd_barrier_complete(bar, b.x, nloc, nx); b.st[0] = nloc; b.st[1] = nx; }
        const unsigned old = xb_add(&bar[XB_XSUB(b.x)], 1u);
        const unsigned gen = old / nloc;
        if (old + 1u == (gen + 1u) * nloc) {
            __builtin_amdgcn_fence(__ATOMIC_RELEASE, "agent");
            asm volatile("s_waitcnt vmcnt(0)" ::: "memory");
            const unsigned og = xb_add(&bar[XB_TOP], 1u);
            const unsigned tg = og / nx;
            if (og + 1u == (tg + 1u) * nx) xb_add(&bar[XB_TOPGEN], 1u);
            else XB_SPIN(xb_ld(&bar[XB_TOPGEN]) == tg, bar);
            __builtin_amdgcn_fence(__ATOMIC_ACQUIRE, "agent");
            xb_add(&bar[XB_XGEN(b.x)], 1u);
            asm volatile("s_waitcnt vmcnt(0)" ::: "memory");
        } else {
            XB_SPIN(xb_ld(&bar[XB_XGEN(b.x)]) == gen, bar);
            __builtin_amdgcn_fence(__ATOMIC_ACQUIRE, "agent");
            asm volatile("s_waitcnt vmcnt(0)" ::: "memory");
        }
    }
    __syncthreads();
}
#else
struct XcdBarrier { int dummy; };
__device__ __forceinline__ void xcd_barrier(const XcdBarrier&) { emu_grid_sync(); }
#endif

namespace pg8 {
constexpr int BM = 256, BK = 64, HALF = 128, HTB = HALF * BK * 2, STAGE_BYTES = 8 * HTB;
__host__ __device__ __forceinline__ int lds_byte(int r, int c) { const int st = (r >> 4) * 2 + (c >> 5), rr = r & 15, cc = c & 31, ob = rr * 64 + cc * 2; return st * 1024 + (ob ^ (((ob >> 9) & 1) << 5)); }
__host__ __device__ __forceinline__ void stage_rc(int b, int& R, int& C) { const int st = b / 1024, sb = b % 1024, swz = sb ^ (((sb >> 9) & 1) << 5); R = (st >> 1) * 16 + swz / 64; C = (st & 1) * 32 + (swz % 64) / 2; }
__host__ __device__ __forceinline__ int perm32(int rho) { const int n = rho >> 4, i = rho & 15; return 8 * (i >> 2) + 4 * n + (i & 3); }
struct Unit { int pm, pn; const char* A; const char* B; int tag; };
#ifndef CPU_EMU
__device__ __forceinline__ unsigned cvt_pk_bf16(float lo, float hi) { unsigned r; asm volatile("v_cvt_pk_bf16_f32 %0, %1, %2" : "=v"(r) : "v"(lo), "v"(hi)); return r; }
#else
__device__ __forceinline__ unsigned cvt_pk_bf16(float lo, float hi) { return pk2(lo, hi); }
#endif

template <class Epi, class Sched, bool ALIGN_EPI = false, bool SP2 = false>
__device__ __forceinline__ void gemm_phase(LAS unsigned char* lds, const int K, const Sched& S, const Epi& E, const int tid) {
    const int lane = tid & 63;
#ifdef CPU_EMU
    const int wid = tid >> 6, wr = wid >> 2, wc = wid & 3, fr = lane & 15, fq = lane >> 4;
    Unit cur;
    for (int ui = 0; S.next(ui, cur); ++ui) {
        f32x4 acc[2][2][4][2];
        const bf16* A = (const bf16*)cur.A; const bf16* B = (const bf16*)cur.B;
        for (int ai = 0; ai < 2; ++ai) for (int bj = 0; bj < 2; ++bj) for (int m = 0; m < 4; ++m) for (int n = 0; n < 2; ++n) for (int j = 0; j < 4; ++j) {
            const int r = 128 * ai + 64 * wr + 16 * m + fr;
            const int c = Epi::PERM ? (128 * bj + 32 * wc + 8 * fq + 4 * n + j) : (128 * bj + 32 * wc + 16 * n + 4 * fq + j);
            acc[ai][bj][m][n][j] = 0.f; }
        for (int t = 0; t < K / BK; ++t) {
            if constexpr (Epi::SEG) { if (t == Epi::S1 || t == Epi::S2 || t == Epi::S3) E.segment(acc, cur, t, wr, wc, fr, fq); }
            for (int ai = 0; ai < 2; ++ai) for (int bj = 0; bj < 2; ++bj) for (int m = 0; m < 4; ++m) for (int n = 0; n < 2; ++n) for (int j = 0; j < 4; ++j) {
                const int r = 128 * ai + 64 * wr + 16 * m + fr;
                const int c = Epi::PERM ? (128 * bj + 32 * wc + 8 * fq + 4 * n + j) : (128 * bj + 32 * wc + 16 * n + 4 * fq + j);
                float s = 0.f; const bf16* ar = A + (size_t)r * K + t * BK; const bf16* br = B + (size_t)c * K + t * BK;
                for (int k = 0; k < BK; ++k) s += bf2f(ar[k]) * bf2f(br[k]);
                acc[ai][bj][m][n][j] += s; }
        }
        E(acc, cur, wr, wc, fr, fq);
    }
    __syncthreads();
#else
    const int wid = __builtin_amdgcn_readfirstlane(tid >> 6), wr = wid >> 2, wc = wid & 3, fr = lane & 15, fq = lane >> 4;
    const int nt = K / BK;
    unsigned voffA[2], voffB[2];
#pragma unroll
    for (int i = 0; i < 2; ++i) { int R, C; stage_rc(tid * 16 + i * 8192, R, C); const int Rb = Epi::PERM ? ((R & ~31) + perm32(R & 31)) : R;
        voffA[i] = (unsigned)(R * K + C) * 2u; voffB[i] = (unsigned)(Rb * K + C) * 2u; }
    const size_t kstep = (size_t)(BK * 2);
    const size_t hstep = (size_t)HALF * K * 2;
    const unsigned ldsw = (unsigned)wid * 1024u;
    const int aoff = lds_byte(wr * 64 + fr, fq * 8), boff = lds_byte(wc * 32 + fr, fq * 8);
#define PG8_SA(b, h) (((b) * 2 + (h)) * HTB)
#define PG8_SB(b, h) ((4 + (b) * 2 + (h)) * HTB)
#define PG8_STAGE(bufoff, gbase, voff) do { _Pragma("unroll") for (int _i = 0; _i < 2; ++_i) \
        __builtin_amdgcn_global_load_lds((const unsigned*)((const char*)(gbase) + (voff)[_i]), (LAS unsigned*)(lds + (bufoff) + ldsw + _i * 8192), 16, 0, 0); } while (0)
#define PG8_LDA(dst, b, h) do { _Pragma("unroll") for (int m = 0; m < 4; ++m) _Pragma("unroll") for (int k = 0; k < 2; ++k) dst[m][k] = *(const LAS bf16x8*)(lds + PG8_SA(b, h) + aoff + m * 2048 + k * 1024); } while (0)
#define PG8_LDB(dst, b, h) do { _Pragma("unroll") for (int n = 0; n < 2; ++n) _Pragma("unroll") for (int k = 0; k < 2; ++k) dst[n][k] = *(const LAS bf16x8*)(lds + PG8_SB(b, h) + boff + n * 2048 + k * 1024); } while (0)
#define PG8_MMA(ai, bj, At, Bt) do { __builtin_amdgcn_s_setprio(1); _Pragma("unroll") for (int m = 0; m < 4; ++m) _Pragma("unroll") for (int n = 0; n < 2; ++n) _Pragma("unroll") for (int k = 0; k < 2; ++k) \
        acc[ai][bj][m][n] = __builtin_amdgcn_mfma_f32_16x16x32_bf16(Bt[n][k], At[m][k], acc[ai][bj][m][n], 0, 0, 0); __builtin_amdgcn_s_setprio(0); } while (0)
#define PG8_WAIT_V(n) asm volatile("s_waitcnt vmcnt(" #n ")" ::: "memory")
#define PG8_WAIT_L(n) asm volatile("s_waitcnt lgkmcnt(" #n ")" ::: "memory")
#define PG8_BAR __builtin_amdgcn_s_barrier()
#define PG8_SCHED __builtin_amdgcn_sched_barrier(0)
    Unit cur, nxt; int ui = 0;
    if (!S.next(0, cur)) return;
    f32x4 acc[2][2][4][2];
#pragma unroll
    for (int a = 0; a < 2; ++a)
#pragma unroll
        for (int b = 0; b < 2; ++b)
#pragma unroll
            for (int m = 0; m < 4; ++m)
#pragma unroll
                for (int n = 0; n < 2; ++n) acc[a][b][m][n] = (f32x4){0.f, 0.f, 0.f, 0.f};
    bf16x8 At[4][2], B0[2][2], B1[2][2];
    const char* cA = cur.A; const char* cB = cur.B;
    if constexpr (SP2) {
        PG8_STAGE(PG8_SB(0, 0), cB, voffB); PG8_STAGE(PG8_SB(0, 1), cB + hstep, voffB); PG8_STAGE(PG8_SA(0, 0), cA, voffA); PG8_STAGE(PG8_SA(0, 1), cA + hstep, voffA);
        if (wr == 1) PG8_BAR;
        PG8_WAIT_V(2); PG8_BAR;
        PG8_STAGE(PG8_SB(1, 0), cB + kstep, voffB); PG8_STAGE(PG8_SA(1, 0), cA + kstep, voffA); PG8_STAGE(PG8_SB(1, 1), cB + hstep + kstep, voffB);
        PG8_WAIT_V(6); PG8_BAR;
    } else {
        PG8_STAGE(PG8_SB(0, 0), cB, voffB); PG8_STAGE(PG8_SA(0, 0), cA, voffA); PG8_STAGE(PG8_SB(0, 1), cB + hstep, voffB); PG8_STAGE(PG8_SA(0, 1), cA + hstep, voffA);
        if (wr == 1) PG8_BAR;
        PG8_WAIT_V(4); PG8_BAR;
        PG8_STAGE(PG8_SB(1, 0), cB + kstep, voffB); PG8_STAGE(PG8_SA(1, 0), cA + kstep, voffA); PG8_STAGE(PG8_SB(1, 1), cB + hstep + kstep, voffB);
        PG8_WAIT_V(6); PG8_BAR;
    }
    for (;;) {
        const bool has_next = S.next(ui + 1, nxt);
        const char* nA = has_next ? nxt.A : cA; const char* nB = has_next ? nxt.B : cB;
        for (int t = 0; t < nt; t += 2) {
            const bool last = (t == nt - 2);
            const char* a1 = cA + (size_t)(t + 1) * kstep;
            const char* a2 = last ? nA : cA + (size_t)(t + 2) * kstep; const char* b2 = last ? nB : cB + (size_t)(t + 2) * kstep;
            const char* a3 = a2 + kstep; const char* b3 = b2 + kstep;
            if constexpr (Epi::SEG) { if (wr == 0 && (t == Epi::S1 || t == Epi::S2 || t == Epi::S3)) E.segment(acc, cur, t, wr, wc, fr, fq); }
            if constexpr (SP2) {
            PG8_LDB(B0, 0, 0); PG8_LDB(B1, 0, 1); PG8_SCHED; PG8_LDA(At, 0, 0); PG8_STAGE(PG8_SA(1, 1), a1 + hstep, voffA);
            PG8_WAIT_V(8); PG8_WAIT_L(0); PG8_BAR; PG8_MMA(0, 0, At, B0); PG8_MMA(0, 1, At, B1); PG8_BAR; PG8_SCHED;
            PG8_LDA(At, 0, 1); PG8_STAGE(PG8_SB(0, 0), b2, voffB); PG8_STAGE(PG8_SB(0, 1), b2 + hstep, voffB); PG8_STAGE(PG8_SA(0, 0), a2, voffA);
            PG8_WAIT_V(8); PG8_WAIT_L(0); PG8_BAR; PG8_MMA(1, 0, At, B0); PG8_MMA(1, 1, At, B1); PG8_BAR; PG8_SCHED;
            PG8_LDB(B0, 1, 0); PG8_LDB(B1, 1, 1); PG8_SCHED; PG8_LDA(At, 1, 0); PG8_STAGE(PG8_SA(0, 1), a2 + hstep, voffA);
            PG8_WAIT_V(8); PG8_WAIT_L(0); PG8_BAR; PG8_MMA(0, 0, At, B0); PG8_MMA(0, 1, At, B1); PG8_BAR; PG8_SCHED;
            PG8_LDA(At, 1, 1); PG8_STAGE(PG8_SB(1, 0), b3, voffB); PG8_STAGE(PG8_SB(1, 1), b3 + hstep, voffB); PG8_STAGE(PG8_SA(1, 0), a3, voffA);
            PG8_WAIT_V(8); PG8_WAIT_L(0); PG8_BAR; PG8_MMA(1, 0, At, B0); PG8_MMA(1, 1, At, B1);
            if constexpr (Epi::SEG) { if (wr == 1 && (t + 2 == Epi::S1 || t + 2 == Epi::S2 || t + 2 == Epi::S3)) E.segment(acc, cur, t + 2, wr, wc, fr, fq); }
            PG8_BAR; PG8_SCHED;
            } else {
            PG8_LDB(B0, 0, 0); PG8_SCHED; PG8_LDA(At, 0, 0); PG8_STAGE(PG8_SA(1, 1), a1 + hstep, voffA);
            PG8_WAIT_L(8); PG8_BAR; PG8_WAIT_L(0); PG8_MMA(0, 0, At, B0); PG8_BAR; PG8_SCHED;
            PG8_LDB(B1, 0, 1); PG8_STAGE(PG8_SB(0, 0), b2, voffB);
            PG8_BAR; PG8_WAIT_L(0); PG8_MMA(0, 1, At, B1); PG8_BAR;
            PG8_LDA(At, 0, 1); PG8_STAGE(PG8_SA(0, 0), a2, voffA);
            PG8_BAR; PG8_WAIT_L(0); PG8_MMA(1, 0, At, B0); PG8_BAR; PG8_SCHED;
            PG8_STAGE(PG8_SB(0, 1), b2 + hstep, voffB);
            PG8_WAIT_V(6); PG8_BAR; PG8_MMA(1, 1, At, B1); PG8_BAR;
            PG8_LDB(B0, 1, 0); PG8_SCHED; PG8_LDA(At, 1, 0); PG8_STAGE(PG8_SA(0, 1), a2 + hstep, voffA);
            PG8_WAIT_L(8); PG8_BAR; PG8_WAIT_L(0); PG8_MMA(0, 0, At, B0); PG8_BAR; PG8_SCHED;
            PG8_LDB(B1, 1, 1); PG8_STAGE(PG8_SB(1, 0), b3, voffB);
            PG8_BAR; PG8_WAIT_L(0); PG8_MMA(0, 1, At, B1); PG8_BAR;
            PG8_LDA(At, 1, 1); PG8_STAGE(PG8_SA(1, 0), a3, voffA);
            PG8_BAR; PG8_WAIT_L(0); PG8_MMA(1, 0, At, B0); PG8_BAR; PG8_SCHED;
            PG8_STAGE(PG8_SB(1, 1), b3 + hstep, voffB);
            PG8_WAIT_V(6); PG8_BAR; PG8_MMA(1, 1, At, B1); PG8_BAR;
            }
        }
        if constexpr (ALIGN_EPI) { if (wr == 0) PG8_BAR; }
        E(acc, cur, wr, wc, fr, fq);
        if (!has_next) break;
#pragma unroll
        for (int a = 0; a < 2; ++a)
#pragma unroll
            for (int b = 0; b < 2; ++b)
#pragma unroll
                for (int m = 0; m < 4; ++m)
#pragma unroll
                    for (int n = 0; n < 2; ++n) acc[a][b][m][n] = (f32x4){0.f, 0.f, 0.f, 0.f};
        cur = nxt; cA = nA; cB = nB; ++ui;
        if constexpr (ALIGN_EPI) { if (wr == 1) PG8_BAR; }
    }
    PG8_WAIT_V(0);
    if constexpr (!ALIGN_EPI) { if (wr == 0) PG8_BAR; }
    PG8_BAR;
#undef PG8_SA
#undef PG8_SB
#undef PG8_STAGE
#undef PG8_LDA
#undef PG8_LDB
#undef PG8_MMA
#undef PG8_WAIT_V
#undef PG8_WAIT_L
#undef PG8_BAR
#undef PG8_SCHED
#endif
}
}

struct KParams { const float* in[N_IN]; float* out; unsigned char* ws; int ph_lo, ph_hi; };
#ifdef CPU_EMU
typedef const KParams& KPR;
static const KParams* g_emu_kp = nullptr;
#define KP_DECL KPR p = *g_emu_kp
#define NOINLINE inline
#define UNI(x) (x)
#define LDS_DECL LAS unsigned char* lds = emu_lds_ptr
#define OPAQUE_V(x)
#define OPAQUE_S(x)
#else
typedef const KParams __attribute__((address_space(4)))& KPR;
#define KP_DECL const KParams __attribute__((address_space(4)))* kp_ = (const KParams __attribute__((address_space(4)))*)__builtin_amdgcn_kernarg_segment_ptr(); asm volatile("" : "+s"(kp_)); KPR p = *kp_
#define NOINLINE __forceinline__
#define UNI(x) __builtin_amdgcn_readfirstlane(x)
extern __shared__ __attribute__((aligned(16))) unsigned char lds_raw[];
#define LDS_DECL LAS unsigned char* lds = (LAS unsigned char*)lds_raw
#define OPAQUE_V(x) asm volatile("" : "+v"(x))
#define OPAQUE_S(x) asm volatile("" : "+s"(x))
#endif
#define ENTRY_BEGIN KP_DECL; LDS_DECL; int tid = threadIdx.x; OPAQUE_V(tid); int bid = blockIdx.x; OPAQUE_S(bid); const int lane = tid & 63, G = gridDim.x; const int wave = UNI(tid >> 6); const int gw = bid * NWAVES + wave, NGW = G * NWAVES; (void)lane; (void)gw; (void)NGW; (void)lds
#ifdef CPU_EMU
#define WAVE_SYNC() emu_wave_sync()
#else
#define WAVE_SYNC() do { asm volatile("s_waitcnt lgkmcnt(0)" ::: "memory"); __builtin_amdgcn_wave_barrier(); } while (0)
#endif
#define WSP(T, off) ((T*)(p.ws + (off)))
#ifdef CPU_EMU
#define CFENCE()
#define SCHED_FENCE()
#else
#define CFENCE() asm volatile("" ::: "memory")
#define SCHED_FENCE() __builtin_amdgcn_sched_barrier(0)
#endif
__device__ __forceinline__ float* hrow(KPR p, int t) { return t < SEQ ? p.out + (size_t)t * D : WSP(float, WS_HC) + (size_t)(t - SEQ) * D; }
__device__ __forceinline__ const float* modv(KPR p, int l, int which, int part) { return WSP(float, WS_MODV) + ((size_t)(l * 2 + which) * 6 + part) * D; }

struct DenseOrder {
    int nM, nN, nwg, G, c; const char* A; const char* B; size_t astep, bstep;
    __device__ __forceinline__ void init(int M, int N, int K, int G_, int c_, const void* A_, const void* B_) { nM = M / 256; nN = N / 256; nwg = nM * nN; G = G_; c = c_; A = (const char*)A_; B = (const char*)B_; astep = (size_t)256 * K * 2; bstep = astep; }
    __device__ __forceinline__ bool next(int i, pg8::Unit& u) const {
        const long L = (long)i * G + c; if (L >= nwg) return false;
        int wgid = (int)L; { const int q = nwg / 8, r = nwg % 8, xcd = wgid % 8, off = wgid / 8; wgid = (xcd < r ? xcd * (q + 1) : r * (q + 1) + (xcd - r) * q) + off; }
        const int nig = 8 * nN, gid = wgid / nig, fm = gid * 8, gsz = (nM - fm) < 8 ? (nM - fm) : 8;
        u.pm = fm + ((wgid % nig) % gsz); u.pn = (wgid % nig) / gsz; u.A = A + (size_t)u.pm * astep; u.B = B + (size_t)u.pn * bstep; u.tag = i; return true;
    }
};
struct MoeOrder {
    const int* tile_e; int ntiles, nN, G, c; const char* A; const char* B; size_t astep, bstepE, bstepN;
    __device__ __forceinline__ bool next(int i, pg8::Unit& u) const {
        int tile, pn;
        if ((G & 7) == 0) {
            const int xcd = c & 7, rank = c >> 3, W = G >> 3, q = ntiles / 8, r = ntiles % 8;
            const int tb = xcd < r ? xcd * (q + 1) : r * (q + 1) + (xcd - r) * q, nt = xcd < r ? q + 1 : q;
            const int L = i * W + rank; if (L >= nt * nN) return false;
            tile = tb + L / nN; pn = L % nN;
        } else { const long L = (long)i * G + c; if (L >= (long)ntiles * nN) return false; tile = (int)(L / nN); pn = (int)(L % nN); }
        const int e = tile_e[tile];
        u.pm = tile; u.pn = pn; u.A = A + (size_t)tile * astep; u.B = B + (size_t)e * bstepE + (size_t)pn * bstepN; u.tag = 0; return true;
    }
};

__device__ __forceinline__ void unpack8(const v4u w, float (&f)[8]) { f[0] = bflo(w.x); f[1] = bfhi(w.x); f[2] = bflo(w.y); f[3] = bfhi(w.y); f[4] = bflo(w.z); f[5] = bfhi(w.z); f[6] = bflo(w.w); f[7] = bfhi(w.w); }
struct EpiPG {
    static constexpr bool PERM = true, SEG = false; static constexpr int S1 = -1, S2 = -1, S3 = -1;
    bf16* O; int ldc;
    __device__ __forceinline__ void operator()(const f32x4 (&acc)[2][2][4][2], const pg8::Unit& u, int wr, int wc, int fr, int fq) const {
        const int row0 = u.pm * 256 + wr * 64 + fr;
        if (u.pn < 4) {
            const int col0 = (u.pn * 256 + wc * 32 + 8 * fq) / 2;
#pragma unroll
            for (int ai = 0; ai < 2; ++ai)
#pragma unroll
                for (int m = 0; m < 4; ++m) { bf16* rowp = O + (size_t)(row0 + ai * 128 + m * 16) * ldc + col0;
#pragma unroll
                    for (int bj = 0; bj < 2; ++bj) { const f32x4 v0 = acc[ai][bj][m][0], v1 = acc[ai][bj][m][1];
                        v2u w; w.x = pg8::cvt_pk_bf16(v0[0] * sigmoidf_(v0[1]), v0[2] * sigmoidf_(v0[3])); w.y = pg8::cvt_pk_bf16(v1[0] * sigmoidf_(v1[1]), v1[2] * sigmoidf_(v1[3]));
                        *(v2u*)(rowp + bj * 64) = w; } }
        } else {
            const int col0 = u.pn * 256 + wc * 32 + 8 * fq;
#pragma unroll
            for (int ai = 0; ai < 2; ++ai)
#pragma unroll
                for (int m = 0; m < 4; ++m) { bf16* rowp = O + (size_t)(row0 + ai * 128 + m * 16) * ldc + col0;
#pragma unroll
                    for (int bj = 0; bj < 2; ++bj) { const f32x4 v0 = acc[ai][bj][m][0], v1 = acc[ai][bj][m][1];
                        v4u w; w.x = pg8::cvt_pk_bf16(v0[0], v0[1]); w.y = pg8::cvt_pk_bf16(v0[2], v0[3]); w.z = pg8::cvt_pk_bf16(v1[0], v1[1]); w.w = pg8::cvt_pk_bf16(v1[2], v1[3]);
                        *(v4u*)(rowp + bj * 128) = w; } }
        }
    }
};
struct EpiP {
    static constexpr bool PERM = true, SEG = false; static constexpr int S1 = -1, S2 = -1, S3 = -1;
    bf16* O; int ldc;
    __device__ __forceinline__ void operator()(const f32x4 (&acc)[2][2][4][2], const pg8::Unit& u, int wr, int wc, int fr, int fq) const {
        const int row0 = u.pm * 256 + wr * 64 + fr, col0 = u.pn * 256 + wc * 32 + 8 * fq;
#pragma unroll
        for (int ai = 0; ai < 2; ++ai)
#pragma unroll
            for (int m = 0; m < 4; ++m) { bf16* rowp = O + (size_t)(row0 + ai * 128 + m * 16) * ldc + col0;
#pragma unroll
                for (int bj = 0; bj < 2; ++bj) { const f32x4 v0 = acc[ai][bj][m][0], v1 = acc[ai][bj][m][1];
                    v4u w; w.x = pg8::cvt_pk_bf16(v0[0], v0[1]); w.y = pg8::cvt_pk_bf16(v0[2], v0[3]); w.z = pg8::cvt_pk_bf16(v1[0], v1[1]); w.w = pg8::cvt_pk_bf16(v1[2], v1[3]);
                    *(v4u*)(rowp + bj * 128) = w; } }
    }
};
#ifdef CPU_EMU
__device__ __forceinline__ float gate_den(float x) { return 1.0f + __expf(-fminf(fmaxf(x, -30.f), 30.f)); }
#else
__device__ __forceinline__ float gate_den(float x) { return 1.0f + __expf(-__builtin_amdgcn_fmed3f(x, -30.f, 30.f)); }
#endif
struct EpiMerge {
    static constexpr bool PERM = true, SEG = true; static constexpr int S1 = 8, S2 = 20, S3 = 28;
    const bf16* Pg; bf16* MGb; const LAS float* rs;
    __device__ __forceinline__ void segment(f32x4 (&acc)[2][2][4][2], const pg8::Unit& u, int t, int wr, int wc, int fr, int fq) const {
        const int br = (t == S1) ? 0 : (t == S2 ? 1 : 2);
        int row0 = u.pm * 256 + wr * 64 + fr; OPAQUE_V(row0);
        const int col0 = u.pn * 256 + wc * 32 + 8 * fq;
#pragma unroll
        for (int ai = 0; ai < 2; ++ai)
#pragma unroll
            for (int m = 0; m < 4; ++m) { const int rl = wr * 64 + fr + ai * 128 + m * 16, row = row0 + ai * 128 + m * 16;
                const float rsv = rs[u.tag * 256 + rl]; const float sc = (br == 0) ? frcp(rsv) : (br == 1 ? rsv : 1.f);
                const bf16* gp = Pg + (size_t)row * NP + br * D + col0;
#pragma unroll
                for (int bj = 0; bj < 2; ++bj) { float a[8], b[8]; unpack8(*(const v4u*)(gp + bj * 128), a); unpack8(*(const v4u*)(gp + D + bj * 128), b);
#pragma unroll
                    for (int j = 0; j < 4; ++j) { acc[ai][bj][m][0][j] *= gate_den(b[j]) * frcp(gate_den(a[j])) * sc; acc[ai][bj][m][1][j] *= gate_den(b[4 + j]) * frcp(gate_den(a[4 + j])) * sc; } }
                if (m & 1) CFENCE(); }
    }
    __device__ __forceinline__ void operator()(const f32x4 (&acc)[2][2][4][2], const pg8::Unit& u, int wr, int wc, int fr, int fq) const {
        const int row0 = u.pm * 256 + wr * 64 + fr, col0 = u.pn * 256 + wc * 32 + 8 * fq;
#pragma unroll
        for (int ai = 0; ai < 2; ++ai)
#pragma unroll
            for (int m = 0; m < 4; ++m) { const int row = row0 + ai * 128 + m * 16; const bf16* gp = Pg + (size_t)row * NP + 3 * D + col0;
#pragma unroll
                for (int bj = 0; bj < 2; ++bj) { float g[8]; unpack8(*(const v4u*)(gp + bj * 128), g); const f32x4 v0 = acc[ai][bj][m][0], v1 = acc[ai][bj][m][1];
                    v4u w; w.x = pg8::cvt_pk_bf16(v0[0] * frcp(gate_den(g[0])), v0[1] * frcp(gate_den(g[1]))); w.y = pg8::cvt_pk_bf16(v0[2] * frcp(gate_den(g[2])), v0[3] * frcp(gate_den(g[3])));
                    w.z = pg8::cvt_pk_bf16(v1[0] * frcp(gate_den(g[4])), v1[1] * frcp(gate_den(g[5]))); w.w = pg8::cvt_pk_bf16(v1[2] * frcp(gate_den(g[6])), v1[3] * frcp(gate_den(g[7])));
                    *(v4u*)(MGb + (size_t)row * D + col0 + bj * 128) = w; }
                if (m & 1) CFENCE(); }
    }
};
struct EpiSwiGLU {
    static constexpr bool PERM = true, SEG = false; static constexpr int S1 = -1, S2 = -1, S3 = -1;
    bf16* HS;
    __device__ __forceinline__ void operator()(const f32x4 (&acc)[2][2][4][2], const pg8::Unit& u, int wr, int wc, int fr, int fq) const {
        const int row0 = u.pm * 256 + wr * 64 + fr, col0 = (u.pn * 256 + wc * 32 + 8 * fq) / 2;
#pragma unroll
        for (int ai = 0; ai < 2; ++ai)
#pragma unroll
            for (int m = 0; m < 4; ++m) { bf16* rowp = HS + (size_t)(row0 + ai * 128 + m * 16) * FF + col0;
#pragma unroll
                for (int bj = 0; bj < 2; ++bj) { const f32x4 v0 = acc[ai][bj][m][0], v1 = acc[ai][bj][m][1];
                    v2u w; w.x = pg8::cvt_pk_bf16(siluf_(v0[0]) * v0[1], siluf_(v0[2]) * v0[3]); w.y = pg8::cvt_pk_bf16(siluf_(v1[0]) * v1[1], siluf_(v1[2]) * v1[3]);
                    *(v2u*)(rowp + bj * 64) = w; } }
    }
};
struct EpiF32 {
    static constexpr bool PERM = false, SEG = false; static constexpr int S1 = -1, S2 = -1, S3 = -1;
    float* C; int ldc;
    __device__ __forceinline__ void operator()(const f32x4 (&acc)[2][2][4][2], const pg8::Unit& u, int wr, int wc, int fr, int fq) const {
        const int row0 = u.pm * 256 + wr * 64 + fr, col0 = u.pn * 256 + wc * 32 + 4 * fq;
#pragma unroll
        for (int ai = 0; ai < 2; ++ai)
#pragma unroll
            for (int m = 0; m < 4; ++m) { float* rowp = C + (size_t)(row0 + ai * 128 + m * 16) * ldc + col0;
#pragma unroll
                for (int bj = 0; bj < 2; ++bj)
#pragma unroll
                    for (int n = 0; n < 2; ++n) *(f32x4*)(rowp + bj * 128 + n * 16) = acc[ai][bj][m][n]; }
    }
};

struct TrDesc { const float* W; bf16* WT; int ldw, N, drow0, rstride, kb, nb, ldk, koff; };
__device__ __forceinline__ void tr_load(const TrDesc& d, int lane, f32x4 (&v)[16]) {
    const int k0 = 64 * d.kb, n = 64 * d.nb + (lane & 15) * 4, r4 = lane >> 4;
#pragma unroll
    for (int i = 0; i < 16; ++i) { const int kk = 4 * i + r4; const float* src = d.W + (size_t)(k0 + kk) * d.ldw + n;
        f32x4 t = (f32x4){0.f, 0.f, 0.f, 0.f};
        if (n + 3 < d.N) t = *(const f32x4*)src;
        else { if (n < d.N) t[0] = src[0]; if (n + 1 < d.N) t[1] = src[1]; if (n + 2 < d.N) t[2] = src[2]; }
        v[i] = t; }
}
__device__ __forceinline__ void tr_store(const TrDesc& d, LAS float* scr, int lane, const f32x4 (&v)[16]) {
    const int k0 = 64 * d.kb, n0 = 64 * d.nb, c4 = (lane & 15) * 4, r4 = lane >> 4;
#pragma unroll
    for (int i = 0; i < 16; ++i) { LAS float* q = scr + (4 * i + r4) * 65 + c4; q[0] = v[i][0]; q[1] = v[i][1]; q[2] = v[i][2]; q[3] = v[i][3]; }
    WAVE_SYNC();
#pragma unroll
    for (int j = 0; j < 8; ++j) { const int q = lane + 64 * j, n = q >> 3, kc = q & 7; const LAS float* s = scr + (8 * kc) * 65 + n;
        v4u o; o.x = pk2(s[0 * 65], s[1 * 65]); o.y = pk2(s[2 * 65], s[3 * 65]); o.z = pk2(s[4 * 65], s[5 * 65]); o.w = pk2(s[6 * 65], s[7 * 65]);
        if (n0 + n < d.N) *(v4u*)(d.WT + (size_t)(d.drow0 + (n0 + n) * d.rstride) * d.ldk + d.koff + k0 + 8 * kc) = o; }
    WAVE_SYNC();
}
constexpr int CV_NB0 = (PROJ + 63) / 64, CV_S0 = (D / 64) * CV_NB0, CV_S1 = (512 / 64) * (D / 64), CV_S2 = (768 / 64) * (D / 64), CV_S5 = (D / 64) * (D / 64),
              CV_S6 = NE * (D / 64) * (FF / 64), CV_S8 = NE * (FF / 64) * (D / 64), CV_TOT = CV_S0 + 3 * CV_S1 + CV_S2 + CV_S5 + 2 * CV_S6 + CV_S8;
__device__ __forceinline__ TrDesc conv_desc(KPR p, int l, int it) {
    TrDesc d; int r = it;
    if (r < CV_S0) { const int nb = r % CV_NB0, n0 = 64 * nb;
        d.W = p.in[I_WIN] + (size_t)l * D * PROJ; d.WT = WSP(bf16, WS_WIN); d.ldw = PROJ; d.N = PROJ; d.drow0 = n0 < 512 ? 0 : (n0 < 1024 ? -1023 : 0); d.rstride = n0 < 1024 ? 2 : 1; d.kb = r / CV_NB0; d.nb = nb; d.ldk = D; d.koff = 0; return d; } r -= CV_S0;
    d.ldw = D; d.N = D; d.drow0 = 0; d.rstride = 1; d.kb = r / (D / 64); d.nb = r % (D / 64); d.WT = WSP(bf16, WS_WCAT); d.ldk = YK;
    if (r < CV_S1) { d.W = p.in[I_WBA] + (size_t)l * 512 * D; d.koff = YOFF_A; return d; } r -= CV_S1; d.kb = r / (D / 64); d.nb = r % (D / 64);
    if (r < CV_S2) { d.W = p.in[I_WBB] + (size_t)l * 768 * D; d.koff = YOFF_B; return d; } r -= CV_S2; d.kb = r / (D / 64); d.nb = r % (D / 64);
    if (r < CV_S1) { d.W = p.in[I_WBC] + (size_t)l * 512 * D; d.koff = YOFF_C; return d; } r -= CV_S1; d.kb = r / (D / 64); d.nb = r % (D / 64);
    if (r < CV_S1) { d.W = p.in[I_WBD] + (size_t)l * 512 * D; d.koff = YOFF_D; return d; } r -= CV_S1; d.kb = r / (D / 64); d.nb = r % (D / 64);
    if (r < CV_S5) { d.W = p.in[I_WOUT] + (size_t)l * D * D; d.WT = WSP(bf16, WS_WOUT); d.ldk = D; d.koff = 0; return d; } r -= CV_S5;
    if (r < 2 * CV_S6) { const int up = r >= CV_S6; if (up) r -= CV_S6; const int e = r / ((D / 64) * (FF / 64)), q = r % ((D / 64) * (FF / 64));
        d.W = p.in[up ? I_EWU : I_EWG] + ((size_t)l * NE + e) * D * FF; d.WT = WSP(bf16, WS_WGU) + (size_t)e * 2 * FF * D; d.ldw = FF; d.N = FF; d.drow0 = up; d.rstride = 2; d.kb = q / (FF / 64); d.nb = q % (FF / 64); d.ldk = D; d.koff = 0; return d; } r -= 2 * CV_S6;
    { const int e = r / ((FF / 64) * (D / 64)), q = r % ((FF / 64) * (D / 64));
      d.W = p.in[I_EWD] + ((size_t)l * NE + e) * FF * D; d.WT = WSP(bf16, WS_WDN) + (size_t)e * D * FF; d.ldw = D; d.N = D; d.drow0 = 0; d.rstride = 1; d.kb = q / (D / 64); d.nb = q % (D / 64); d.ldk = FF; d.koff = 0; }
    return d;
}
__device__ __forceinline__ void conv_weights(KPR p, int l, LAS unsigned char* lds, int gw, int NGW, int lane, int wave) {
    LAS float* scr = (LAS float*)(lds + wave * 17408);
    if (gw < CV_TOT) {
        f32x4 cur[16], nxt[16];
        TrDesc dc = conv_desc(p, l, gw); tr_load(dc, lane, cur);
        for (int it = gw; it < CV_TOT; it += NGW) {
            const int ni = it + NGW; const bool hn = ni < CV_TOT; TrDesc dn = dc;
            if (hn) { dn = conv_desc(p, l, ni); tr_load(dn, lane, nxt); }
            tr_store(dc, scr, lane, cur);
            if (hn) { dc = dn;
#pragma unroll
                for (int i = 0; i < 16; ++i) cur[i] = nxt[i]; }
        }
    }
    { const int nchunks = (NP - PROJ) * D / 8; unsigned zz_ = 0u; OPAQUE_V(zz_); v4u z; z.x = zz_; z.y = zz_; z.z = zz_; z.w = zz_;
      for (int i = gw * 64 + lane; i < nchunks; i += NGW * 64) *(v4u*)(WSP(bf16, WS_WIN) + (size_t)PROJ * D + (size_t)i * 8) = z; }
}

__device__ __forceinline__ void phase_mod(KPR p, LAS unsigned char* lds, int tid, int bid, int G) {
    LAS float* red = (LAS float*)lds;
    const int lane = tid & 63, kg = tid >> 6;
    constexpr int NCB = 6 * D / 64;
    for (int it = bid; it < DEPTH * NCB; it += G) {
        const int l = it / NCB, col = (it % NCB) * 64 + lane;
        const float* W = p.in[I_WMOD] + (size_t)l * D * 6 * D;
        float a0 = 0.f, a1 = 0.f;
        for (int k0 = kg * (D / 8); k0 < (kg + 1) * (D / 8); k0 += 16) {
            float w[16];
#pragma unroll
            for (int j = 0; j < 16; ++j) w[j] = W[(size_t)(k0 + j) * 6 * D + col];
#pragma unroll
            for (int j = 0; j < 16; ++j) { a0 += siluf_(p.in[I_C][k0 + j]) * w[j]; a1 += siluf_(p.in[I_CCTX][k0 + j]) * w[j]; } }
        red[(kg * 64 + lane) * 2 + 0] = a0; red[(kg * 64 + lane) * 2 + 1] = a1;
        __syncthreads();
        if (tid < 64) { float s0 = 0.f, s1 = 0.f;
            for (int q = 0; q < 8; ++q) { s0 += red[(q * 64 + lane) * 2]; s1 += red[(q * 64 + lane) * 2 + 1]; }
            const float b = p.in[I_BMOD][(size_t)l * 6 * D + col];
            WSP(float, WS_MODV)[(size_t)(l * 2 + 0) * 6 * D + col] = s0 + b; WSP(float, WS_MODV)[(size_t)(l * 2 + 1) * 6 * D + col] = s1 + b; }
        __syncthreads();
    }
}
__device__ __forceinline__ void phase_u0(KPR p, int gw, int NGW, int lane) {
    for (int t = gw; t < MT; t += NGW) {
        const int which = t < SEQ ? 0 : 1;
        const float* src = t < SEQ ? p.in[I_X] + (size_t)t * D : p.in[I_CTX] + (size_t)(t - SEQ) * D;
        float* h = hrow(p, t); const float* sh = modv(p, 0, which, 0); const float* sc = modv(p, 0, which, 1);
        bf16* u = WSP(bf16, WS_U) + (size_t)t * D;
#pragma unroll
        for (int j = 0; j < D / 256; ++j) { const int c = 4 * lane + 256 * j;
            const f32x4 x = *(const f32x4*)(src + c), s = *(const f32x4*)(sh + c), q = *(const f32x4*)(sc + c);
            *(f32x4*)(h + c) = x;
            v2u w; w.x = pk2(x[0] * (1.f + q[0]) + s[0], x[1] * (1.f + q[1]) + s[1]); w.y = pk2(x[2] * (1.f + q[2]) + s[2], x[3] * (1.f + q[3]) + s[3]);
            *(v2u*)(u + c) = w; }
    }
}

constexpr int C1_RB = ROWS >= 64 ? 64 : ROWS, C1_NRB = ROWS / C1_RB, C1_LAT = GRID_W * C1_NRB, C1_IN = C1_RB + CONF_K - 1, C1_INMAX = 64 + CONF_K - 1;
static_assert(ROWS % C1_RB == 0 && C1_RB % 8 == 0 && C1_INMAX * 1024 + CONF_K * CONF_D * 4 <= 163840 - 256 && CTX % 64 == 0 && CONF_K == 31 && CONF_D == 512, "c1 geometry");
__device__ __forceinline__ void c1_conformer(KPR p, int l, LAS unsigned char* lds, int idx, int tid) {
    const bf16* P = WSP(bf16, WS_P);
    const int lane = tid & 63, wave = tid >> 6;
    const int cg = tid & 63, tg = tid >> 6;
    const bool isctx = idx >= C1_LAT;
    LAS float* tile = (LAS float*)lds;
    LAS bf16* inb = (LAS bf16*)lds;
    LAS float* wsm = (LAS float*)(lds + C1_INMAX * 1024);
    const int gc = idx % GRID_W, rb = idx / GRID_W;
    const int RB = isctx ? 64 : C1_RB, NIN = RB + CONF_K - 1, rlim = isctx ? CTX : ROWS;
    const int rbase = isctx ? (idx - C1_LAT) * 64 : rb * C1_RB, r0 = rbase - 15;
    float acc[8][8];
    {
        { constexpr int NL = (C1_INMAX + NWAVES - 1) / NWAVES, NLH = (NL + 1) / 2;
#pragma unroll 1
          for (int q0 = 0; q0 < NL; q0 += NLH) { v4u tmp[NLH];
#pragma unroll
            for (int q = 0; q < NLH; ++q) { const int i = wave + NWAVES * (q0 + q), r = r0 + i; unsigned zz_ = 0u; OPAQUE_V(zz_); tmp[q].x = zz_; tmp[q].y = zz_; tmp[q].z = zz_; tmp[q].w = zz_;
                if (i < NIN && r >= 0 && r < rlim) { const size_t tok = isctx ? (size_t)(SEQ + r) : (size_t)r * GRID_W + gc; tmp[q] = *(const v4u*)(P + tok * NP + 8 * lane); } }
#pragma unroll
            for (int q = 0; q < NLH; ++q) { const int i = wave + NWAVES * (q0 + q); if (i < NIN) *(LAS v4u*)(inb + i * 512 + 8 * lane) = tmp[q]; } } }
        { constexpr int NW4 = CONF_K * CONF_D / 4, NQ = (NW4 + NTHR - 1) / NTHR, NQH = (NQ + 1) / 2; const float* cwl = p.in[I_CDWW] + (size_t)l * CONF_K * CONF_D;
#pragma unroll 1
          for (int q0 = 0; q0 < NQ; q0 += NQH) { f32x4 tw[NQH];
#pragma unroll
            for (int q = 0; q < NQH; ++q) { const int i4 = tid + NTHR * (q0 + q); tw[q] = *(const f32x4*)(cwl + 4 * (i4 < NW4 ? i4 : NW4 - 1)); }
#pragma unroll
            for (int q = 0; q < NQH; ++q) { const int i4 = tid + NTHR * (q0 + q); if (i4 < NW4) *(LAS f32x4*)(wsm + 4 * i4) = tw[q]; } } }
        __syncthreads();
#pragma unroll
        for (int a = 0; a < 8; ++a)
#pragma unroll
            for (int b = 0; b < 8; ++b) acc[a][b] = 0.f;
        if (8 * tg < RB) {
            float win[8][8];
#pragma unroll
            for (int a = 0; a < 8; ++a) unpack8(*(const LAS v4u*)(inb + (8 * tg + a) * 512 + 8 * cg), win[a]);
#pragma unroll 1
            for (int j0 = 0; j0 < 32; j0 += 8) {
#pragma unroll
                for (int jj = 0; jj < 8; ++jj) { const int j = j0 + jj, jc = j < CONF_K ? j : CONF_K - 1; const float m = j < CONF_K ? 1.f : 0.f;
                    const f32x4 w0 = *(const LAS f32x4*)(wsm + jc * CONF_D + 8 * cg) * m, w1 = *(const LAS f32x4*)(wsm + jc * CONF_D + 8 * cg + 4) * m;
                    const float wj[8] = {w0[0], w0[1], w0[2], w0[3], w1[0], w1[1], w1[2], w1[3]};
#pragma unroll
                    for (int a = 0; a < 8; ++a)
#pragma unroll
                        for (int b = 0; b < 8; ++b) acc[a][b] += wj[b] * win[(a + jj) & 7][b];
                    int inext = 8 * tg + j + 8; inext = inext < NIN ? inext : NIN - 1;
#ifndef CPU_EMU
                    asm volatile("" : "+v"(inext), "+v"(acc[7][7]));
#endif
                    unpack8(*(const LAS v4u*)(inb + inext * 512 + 8 * cg), win[jj]); }
            }
        }
        __syncthreads();
    }
    { const f32x4 b0 = *(const f32x4*)(p.in[I_CDWB] + l * CONF_D + 8 * cg), b1 = *(const f32x4*)(p.in[I_CDWB] + l * CONF_D + 8 * cg + 4);
#pragma unroll
      for (int a = 0; a < 8; ++a) { f32x4 o0, o1;
#pragma unroll
          for (int b = 0; b < 4; ++b) { o0[b] = acc[a][b] + b0[b]; o1[b] = acc[a][4 + b] + b1[b]; }
          *(LAS f32x4*)(tile + (8 * tg + a) * 512 + 8 * cg) = o0; *(LAS f32x4*)(tile + (8 * tg + a) * 512 + 8 * cg + 4) = o1; } }
    __syncthreads();
    const int nrow = RB;
    const float* lg = p.in[I_CLNG] + l * CONF_D + 8 * lane; const float* lb = p.in[I_CLNB] + l * CONF_D + 8 * lane;
    for (int w = wave; w < nrow; w += NWAVES) {
        const int t = isctx ? SEQ + rbase + w : (rbase + w) * GRID_W + gc;
        const f32x4 a = *(const LAS f32x4*)(tile + w * 512 + 8 * lane), b = *(const LAS f32x4*)(tile + w * 512 + 8 * lane + 4);
        const float mean = wave_sum((a[0] + a[1]) + (a[2] + a[3]) + (b[0] + b[1]) + (b[2] + b[3])) * (1.f / 512.f);
        const f32x4 da = a - mean, db = b - mean;
        const float var = wave_sum((da[0] * da[0] + da[1] * da[1]) + (da[2] * da[2] + da[3] * da[3]) + (db[0] * db[0] + db[1] * db[1]) + (db[2] * db[2] + db[3] * db[3])) * (1.f / 512.f);
        const float rstd = frsq(var + LN_EPS);
        float y[8];
#pragma unroll
        for (int i = 0; i < 4; ++i) { y[i] = siluf_(da[i] * rstd * lg[i] + lb[i]); y[4 + i] = siluf_(db[i] * rstd * lg[4 + i] + lb[4 + i]); }
        v4u o; o.x = pk2(y[0], y[1]); o.y = pk2(y[2], y[3]); o.z = pk2(y[4], y[5]); o.w = pk2(y[6], y[7]);
        *(v4u*)(WSP(bf16, WS_Y) + (size_t)t * YK + YOFF_A + 8 * lane) = o;
    }
    __syncthreads();
}
__device__ __forceinline__ void load_rows10(const bf16* src, int t0, int tg, int lo, int hi, float (&x)[10][8]) {
#pragma unroll
    for (int a = 0; a < 10; ++a) { const int t = t0 + 8 * tg + a - 1;
        if (t >= lo && t < hi) unpack8(*(const v4u*)(src + (size_t)t * NP), x[a]); else {
#pragma unroll
            for (int q = 0; q < 8; ++q) x[a][q] = 0.f; } }
}
__device__ __forceinline__ void c2_wave(KPR p, int l, int tile, int cgrp, int lane) {
    const bf16* P = WSP(bf16, WS_P);
    const int t0 = tile * 64, lo = t0 < SEQ ? 0 : SEQ, hi = t0 < SEQ ? SEQ : MT, cg = lane & 7, tg = lane >> 3, ch = cgrp * 64 + 8 * cg;
    const float* w = p.in[I_SCCW] + (size_t)l * 3 * SC_D + ch;
    float w0[8], w1[8], w2[8];
#pragma unroll
    for (int b = 0; b < 8; ++b) { w0[b] = w[b]; w1[b] = w[SC_D + b]; w2[b] = w[2 * SC_D + b]; }
    float c[10][8], x[10][8];
    load_rows10(P + OFF_D + 512 + ch, t0, tg, lo, hi, c); load_rows10(P + OFF_D + 1024 + ch, t0, tg, lo, hi, x);
#pragma unroll
    for (int a = 0; a < 10; ++a)
#pragma unroll
        for (int b = 0; b < 8; ++b) c[a][b] *= x[a][b];
    v4u graw[8];
#pragma unroll
    for (int a = 0; a < 8; ++a) graw[a] = *(const v4u*)(P + (size_t)(t0 + 8 * tg + a) * NP + OFF_D + ch);
#pragma unroll
    for (int a = 0; a < 8; ++a) { const int t = t0 + 8 * tg + a; float g[8]; unpack8(graw[a], g);
        float y[8];
#pragma unroll
        for (int b = 0; b < 8; ++b) y[b] = g[b] * (w0[b] * c[a][b] + w1[b] * c[a + 1][b] + w2[b] * c[a + 2][b]);
        v4u o; o.x = pk2(y[0], y[1]); o.y = pk2(y[2], y[3]); o.z = pk2(y[4], y[5]); o.w = pk2(y[6], y[7]);
        *(v4u*)(WSP(bf16, WS_Y) + (size_t)t * YK + YOFF_D + ch) = o; }
}
template <int MODE> __device__ __forceinline__ void c34_load(KPR p, int tile, int cgrp, int lane, v4u (&raw)[10]) {
    const bf16* P = WSP(bf16, WS_P);
    const int t0 = tile * 64, lo = t0 < SEQ ? 0 : SEQ, hi = t0 < SEQ ? SEQ : MT, cg = lane & 7, tg = lane >> 3, ch = cgrp * 64 + 8 * cg;
    constexpr int POFF = MODE == 0 ? OFF_B + SSD_D : OFF_C;
#pragma unroll
    for (int a = 0; a < 10; ++a) { const int t = t0 + 8 * tg + a - 1; v4u z; z.x = 0u; z.y = 0u; z.z = 0u; z.w = 0u;
        raw[a] = (t >= lo && t < hi) ? *(const v4u*)(P + (size_t)t * NP + POFF + ch) : z; }
}
template <int MODE> __device__ __forceinline__ void c34_compute(KPR p, int l, LAS unsigned char* wlds, int tile, int cgrp, int lane, const v4u (&raw)[10]) {
    const int t0 = tile * 64, cg = lane & 7, tg = lane >> 3, ch = cgrp * 64 + 8 * cg;
    constexpr int NC = MODE == 0 ? XBC : 1536;
    const float* w = p.in[MODE == 0 ? I_SCW : I_HSW] + (size_t)l * 3 * NC + ch; const float* b = p.in[MODE == 0 ? I_SCB : I_HSB] + (size_t)l * NC + ch;
    float w0[8], w1[8], w2[8], bb[8];
#pragma unroll
    for (int q = 0; q < 8; ++q) { w0[q] = w[q]; w1[q] = w[NC + q]; w2[q] = w[2 * NC + q]; bb[q] = b[q]; }
    LAS bf16* tile_ = (LAS bf16*)wlds;
    const bool tr = (MODE == 1) || (cgrp < 20);
    float xp[8], xc_[8], xn[8];
    unpack8(raw[0], xp); unpack8(raw[1], xc_);
#pragma unroll
    for (int a = 0; a < 8; ++a) { unsigned short y[8]; unpack8(raw[a + 2], xn);
#pragma unroll
        for (int q = 0; q < 8; ++q) { float v = w0[q] * xp[q] + w1[q] * xc_[q] + w2[q] * xn[q] + bb[q]; if (MODE == 0) v = siluf_(v); y[q] = (unsigned short)f2bf(v); xp[q] = xc_[q]; xc_[q] = xn[q]; }
        if (tr) {
#pragma unroll
            for (int q = 0; q < 8; ++q) tile_[(8 * cg + q) * 72 + 8 * tg + a] = y[q]; }
        if (MODE == 0 && cgrp >= 12) { v4u o; o.x = y[0] | ((unsigned)y[1] << 16); o.y = y[2] | ((unsigned)y[3] << 16); o.z = y[4] | ((unsigned)y[5] << 16); o.w = y[6] | ((unsigned)y[7] << 16);
            *(v4u*)(WSP(bf16, WS_XC) + (size_t)(t0 + 8 * tg + a) * XBC + ch) = o; } }
    if (tr) {
        WAVE_SYNC();
        bf16* dst = WSP(bf16, MODE == 0 ? WS_XCT : WS_QT) + (size_t)(cgrp * 64) * MT + t0;
#pragma unroll
        for (int j = 0; j < 8; ++j) { const int q = lane + 64 * j, row = q >> 3, cc = q & 7; *(v4u*)(dst + (size_t)row * MT + 8 * cc) = *(const LAS v4u*)(tile_ + row * 72 + 8 * cc); }
        WAVE_SYNC();
    }
}
template <int MODE> __device__ __forceinline__ void c34_wave_loop(KPR p, int l, LAS unsigned char* wlds, int first, int nitems, int NGW, int lane) {
    constexpr int NCG = MODE == 0 ? 28 : 24;
    if (first >= nitems) return;
    v4u cur[10], nxt[10];
    c34_load<MODE>(p, first / NCG, first % NCG, lane, cur);
    for (int it = first; it < nitems; it += NGW) {
        const int ni = it + NGW; const bool hn = ni < nitems;
        if (hn) c34_load<MODE>(p, ni / NCG, ni % NCG, lane, nxt);
        c34_compute<MODE>(p, l, wlds, it / NCG, it % NCG, lane, cur);
        if (hn) {
#pragma unroll
            for (int a = 0; a < 10; ++a) cur[a] = nxt[a]; }
    }
}
__device__ __forceinline__ void c_dt_wave(KPR p, int l, int tile, int lane) {
    const bf16* src = WSP(bf16, WS_P) + (size_t)(tile * 64 + lane) * NP + OFF_B + SSD_D + XBC;
    const v4u r0 = *(const v4u*)src, r1 = *(const v4u*)(src + 8), r2 = *(const v4u*)(src + 16);
    float xa[8], xb[8], xc[8]; unpack8(r0, xa); unpack8(r1, xb); unpack8(r2, xc);
    const float* bias = p.in[I_SDTB] + l * 24; float* dst = WSP(float, WS_DT) + (size_t)(tile * 64 + lane) * 24;
#pragma unroll
    for (int h = 0; h < 3; ++h) { f32x4 o0, o1;
#pragma unroll
        for (int j = 0; j < 4; ++j) { const float x0 = (h == 0 ? xa[j] : (h == 1 ? xb[j] : xc[j])) + bias[8 * h + j], x1 = (h == 0 ? xa[4 + j] : (h == 1 ? xb[4 + j] : xc[4 + j])) + bias[8 * h + 4 + j];
            o0[j] = fmaxf(x0, 0.f) + flog(1.0f + __expf(-fabsf(x0))); o1[j] = fmaxf(x1, 0.f) + flog(1.0f + __expf(-fabsf(x1))); }
        *(f32x4*)(dst + 8 * h) = o0; *(f32x4*)(dst + 8 * h + 4) = o1; }
}
constexpr int CW_C2 = (MT / 64) * 8, CW_C3 = (MT / 64) * 28, CW_C4 = (MT / 64) * 24, CW_DT = MT / 64, CW_ITEMS = CW_C3 + CW_C4 + CW_C2 + CW_DT;
__device__ __forceinline__ void c_wave_items(KPR p, int l, LAS unsigned char* lds, int gw, int NGW, int lane, int wave, int last) {
    LAS unsigned char* wlds = lds + wave * 16384;
    const int ntl = last ? SEQ / 64 : MT / 64;
    c34_wave_loop<0>(p, l, wlds, gw, CW_C3, NGW, lane);
    c34_wave_loop<1>(p, l, wlds, gw, ntl * 24, NGW, lane);
    for (int it = gw; it < ntl * 8; it += NGW) c2_wave(p, l, it / 8, it % 8, lane);
    for (int it = gw; it < CW_DT; it += NGW) c_dt_wave(p, l, it, lane);
}
__device__ __forceinline__ float sin_rad(float x) { float s_, c_; sincos_turns(x * 0.15915494309189535f, s_, c_); return s_; }
__device__ __forceinline__ void c5_item(KPR p, int l, LAS unsigned char* lds, int idx, int tid) {
    LAS float* ws = (LAS float*)lds;
    LAS float* h1s = (LAS float*)(lds + 32768);
    const int t = idx * 64 + (tid >> 3), oq = tid & 7, pl = tid >> 3;
    const bool isctx = t >= SEQ; const int n = isctx ? CTX : SEQ, tl = isctx ? t - SEQ : t;
    const float t01 = (float)tl * frcp((float)(n - 1)), tn = (float)tl * (1.0f / (float)n);
    float a[8];
#pragma unroll
    for (int i = 0; i < 8; ++i) a[i] = ws[2112 + 8 * oq + i];
#pragma unroll 1
    for (int f = 0; f < 33; ++f) {
        float ft;
        if (f == 0) ft = t01;
        else { const int bi = (f - 1) & 15; const float band = 1e-4f + (15.0f - 1e-4f) * (float)bi * (1.0f / 15.0f); float sn_, cs_; sincos_turns(band * tn, sn_, cs_); ft = (f <= 16) ? cs_ : -sn_; }
        const f32x4 w0 = *(const LAS f32x4*)(ws + f * 64 + 8 * oq), w1 = *(const LAS f32x4*)(ws + f * 64 + 8 * oq + 4);
#pragma unroll
        for (int i = 0; i < 4; ++i) { a[i] += ft * w0[i]; a[4 + i] += ft * w1[i]; }
    }
#pragma unroll
    for (int i = 0; i < 8; ++i) h1s[(8 * oq + i) * 64 + pl] = sin_rad(ws[2176 + 4096 + 64 + 8 * oq + i] * a[i]);
    WAVE_SYNC();
#pragma unroll
    for (int i = 0; i < 8; ++i) a[i] = ws[2176 + 4096 + 8 * oq + i];
#pragma unroll 4
    for (int j = 0; j < 64; ++j) { const float h = h1s[j * 64 + pl];
        const f32x4 w0 = *(const LAS f32x4*)(ws + 2176 + j * 64 + 8 * oq), w1 = *(const LAS f32x4*)(ws + 2176 + j * 64 + 8 * oq + 4);
#pragma unroll
        for (int i = 0; i < 4; ++i) { a[i] += h * w0[i]; a[4 + i] += h * w1[i]; } }
    f32x4 o0, o1;
#pragma unroll
    for (int i = 0; i < 4; ++i) { o0[i] = sin_rad(ws[2176 + 4096 + 128 + 8 * oq + i] * a[i]); o1[i] = sin_rad(ws[2176 + 4096 + 128 + 8 * oq + 4 + i] * a[4 + i]); }
    float* o = WSP(float, WS_HID2) + (size_t)t * 64 + 8 * oq;
    *(f32x4*)o = o0; *(f32x4*)(o + 4) = o1;
    WAVE_SYNC();
}
__device__ __forceinline__ void c5_load_weights(KPR p, int l, LAS unsigned char* lds, int tid) {
    LAS float* ws = (LAS float*)lds;
    const float* w1g = p.in[I_HW1] + (size_t)l * 33 * 64; const float* w2g = p.in[I_HW2] + (size_t)l * 64 * 64;
    { float t1[5], t2[8];
#pragma unroll
      for (int j = 0; j < 5; ++j) { const int i = tid + NTHR * j; t1[j] = (i < 33 * 64) ? w1g[i] : 0.f; }
#pragma unroll
      for (int j = 0; j < 8; ++j) t2[j] = w2g[tid + NTHR * j];
#pragma unroll
      for (int j = 0; j < 5; ++j) { const int i = tid + NTHR * j; if (i < 33 * 64) ws[i] = t1[j]; }
#pragma unroll
      for (int j = 0; j < 8; ++j) ws[2176 + tid + NTHR * j] = t2[j]; }
    for (int i = tid; i < 64; i += NTHR) { ws[2112 + i] = p.in[I_HB1][l * 64 + i]; ws[2176 + 4096 + i] = p.in[I_HB2][l * 64 + i]; }
    for (int i = tid; i < 128; i += NTHR) ws[2176 + 4096 + 64 + i] = p.in[I_HFREQ][l * 128 + i];
}
constexpr int C1_ITEMS = C1_LAT + CTX / 64, C23_ITEMS = MT / 64, C4_ITEMS = MT / 64, C5_ITEMS = MT / 64, C6_ITEMS = 8 * (MT / 256), C_ITEMS = C6_ITEMS + C1_ITEMS;

__device__ __forceinline__ float a_rate_of(KPR p, int l, int d, int h) { return -__expf(p.in[I_SALOG][(l * 2 + d) * NH + h]); }
__device__ __forceinline__ bf16x8 as_bf16x8(v4u v) { return __builtin_bit_cast(bf16x8, v); }
__device__ __forceinline__ void d_ssd_item(KPR p, int l, LAS unsigned char* lds, int idx, int e_only, int tid) {
    const int c = idx / NG, g = idx % NG, t0 = c * CHUNK, lane = tid & 63, wave = tid >> 6;
    const bf16* XCT = WSP(bf16, WS_XCT); const float* DTp = WSP(float, WS_DT);
    LAS bf16* XT = (LAS bf16*)lds;
    LAS bf16* BT = (LAS bf16*)(lds + 52224);
    LAS float* Wv = (LAS float*)(lds + 87040);
    __syncthreads();
    { v4u tl[10];
#pragma unroll
      for (int j = 0; j < 10; ++j) { const int q = tid + NTHR * j, row = q >> 4, cc = (q & 15) * 8; const int src = row < 192 ? g * 192 + row : 768 + g * NS + (row - 192);
          tl[j] = *(const v4u*)(XCT + (size_t)src * MT + t0 + cc); }
#pragma unroll
      for (int j = 0; j < 10; ++j) { const int q = tid + NTHR * j, row = q >> 4, cc = (q & 15) * 8; *(LAS v4u*)((row < 192 ? XT + row * 136 : BT + (row - 192) * 136) + cc) = tl[j]; } }
    if (wave < 6) {
        const int d = wave / 3, e = wave % 3, h = g * HPG + e; const float ar = a_rate_of(p, l, d, h);
        const int l0 = 2 * lane;
        const float dt0 = DTp[(size_t)(t0 + l0) * 24 + d * NH + h], dt1 = DTp[(size_t)(t0 + l0 + 1) * 24 + d * NH + h];
        const float ld0 = dt0 * ar, ld1 = dt1 * ar;
        float x = ld0 + ld1;
#pragma unroll
        for (int o = 1; o < 64; o <<= 1) { const float y = __shfl_up(x, o); if (lane >= o) x += y; }
        const float tot = __shfl(x, 63);
        float A1 = x, A0 = x - ld1;
        if (d == 1) { A0 = tot - A0 + ld0; A1 = tot - A1 + ld1; }
        float* ac = WSP(float, WS_ACUM) + (size_t)(d * NH + h) * MT + t0 + l0; ac[0] = A0; ac[1] = A1;
        Wv[wave * 128 + l0] = dt0 * __expf(tot - A0); Wv[wave * 128 + l0 + 1] = dt1 * __expf(tot - A1);
        if (lane == 0) WSP(float, WS_CDEC)[(size_t)(d * NCH + c) * NH + h] = __expf(tot);
    }
    __syncthreads();
    const int nb = wave & 3, pb = wave >> 2, r = lane & 31, hh = lane >> 5;
    for (int combo = 0; combo < 6; ++combo) {
        const int d = combo / 3, e = combo % 3, h = g * HPG + e;
        f32x16 acc;
#pragma unroll
        for (int i = 0; i < 16; ++i) acc[i] = 0.f;
#pragma unroll
        for (int ks = 0; ks < 8; ++ks) {
            const int lb_ = 16 * ks + 8 * hh;
            float xv[8]; unpack8(*(const LAS v4u*)(XT + (e * 64 + 32 * pb + r) * 136 + lb_), xv);
            const f32x4 w0 = *(const LAS f32x4*)(Wv + combo * 128 + lb_), w1 = *(const LAS f32x4*)(Wv + combo * 128 + lb_ + 4);
            v4u av; av.x = pk2(xv[0] * w0[0], xv[1] * w0[1]); av.y = pk2(xv[2] * w0[2], xv[3] * w0[3]); av.z = pk2(xv[4] * w1[0], xv[5] * w1[1]); av.w = pk2(xv[6] * w1[2], xv[7] * w1[3]);
            const bf16x8 bfrag = as_bf16x8(*(const LAS v4u*)(BT + (32 * nb + r) * 136 + lb_));
            acc = MFMA32(as_bf16x8(av), bfrag, acc);
        }
        float* st = WSP(float, WS_ST) + ((size_t)(d * NCH + c) * NH + h) * HD * NS + (size_t)(32 * pb) * NS + 32 * nb + r;
#pragma unroll
        for (int i = 0; i < 16; ++i) st[(size_t)((i & 3) + 8 * (i >> 2) + 4 * hh) * NS] = acc[i];
    }
    __syncthreads();
}
__device__ __forceinline__ int scan_chunk(int d, int i) {
    if (i < NCH - NCH_LAT) return (d == 0) ? NCH_LAT + i : NCH - 1 - i;
    const int k = i - (NCH - NCH_LAT); return (d == 0) ? k : NCH_LAT - 1 - k;
}
__device__ __forceinline__ void e_scan_item(KPR p, int idx, int tid) {
    const int el = idx * NTHR + tid;
    const int d = el / (NH * HD * NS), h = (el / (HD * NS)) % NH, pn = el % (HD * NS);
    const float* st = WSP(float, WS_ST); const float* cd = WSP(float, WS_CDEC); bf16* hb = WSP(bf16, WS_HIN);
    float hs = 0.f;
    constexpr int BATCH = 10; static_assert(NCH % BATCH == 0, "scan batch");
    for (int i0 = 0; i0 < NCH; i0 += BATCH) {
        float v[BATCH], dc[BATCH];
#pragma unroll
        for (int j = 0; j < BATCH; ++j) { const int c = scan_chunk(d, i0 + j); v[j] = st[((size_t)(d * NCH + c) * NH + h) * HD * NS + pn]; dc[j] = cd[(size_t)(d * NCH + c) * NH + h]; }
#pragma unroll
        for (int j = 0; j < BATCH; ++j) { const int c = scan_chunk(d, i0 + j); hb[((size_t)(d * NCH + c) * NH + h) * HD * NS + pn] = (bf16)f2bf(hs); hs = dc[j] * hs + v[j]; }
    }
}
__device__ __forceinline__ void f_ssd_item(KPR p, int l, LAS unsigned char* lds, int c, int g, int e0, int e1, int tid) {
    const int t0 = c * CHUNK, lane = tid & 63, wave = tid >> 6;
    const bf16* XCp = WSP(bf16, WS_XC); const bf16* XCT = WSP(bf16, WS_XCT); const float* DTp = WSP(float, WS_DT); const bf16* P = WSP(bf16, WS_P);
    LAS bf16* Bm = (LAS bf16*)lds;
    LAS bf16* Cm = (LAS bf16*)(lds + 34816);
    LAS bf16* XT = (LAS bf16*)(lds + 69632);
    LAS bf16* Hs = (LAS bf16*)(lds + 121856);
    LAS float* Ac = (LAS float*)(lds + 139264);
    LAS float* Dv = Ac + 768;
    const int ncombo = 2 * (e1 - e0);
    const bf16* hbase = WSP(bf16, WS_HIN);
    v4u hreg[2];
#define FSSD_HIN_LOAD(cc) do { const bf16* hin_ = hbase + ((size_t)(((cc) & 1) * NCH + c) * NH + g * HPG + e0 + ((cc) >> 1)) * HD * NS; _Pragma("unroll") for (int j_ = 0; j_ < 2; ++j_) { const int q_ = tid + NTHR * j_; hreg[j_] = *(const v4u*)(hin_ + (size_t)(q_ >> 4) * NS + (q_ & 15) * 8); } } while (0)
    FSSD_HIN_LOAD(0);
    __syncthreads();
    { v4u tb[4], tc[4], tx[6]; float ta[2], td[2];
#pragma unroll
      for (int j = 0; j < 4; ++j) { const int q = tid + NTHR * j, row = q >> 4, cc = (q & 15) * 8;
          tb[j] = *(const v4u*)(XCp + (size_t)(t0 + row) * XBC + SSD_D + g * NS + cc); tc[j] = *(const v4u*)(XCp + (size_t)(t0 + row) * XBC + SSD_D + NG * NS + g * NS + cc); }
#pragma unroll
      for (int j = 0; j < 6; ++j) { const int q = tid + NTHR * j, row = q >> 4, cc = (q & 15) * 8; tx[j] = *(const v4u*)(XCT + (size_t)(g * 192 + row) * MT + t0 + cc); }
#pragma unroll
      for (int j = 0; j < 2; ++j) { const int q = tid + NTHR * j; ta[j] = 0.f; td[j] = 0.f; if (q < 768) { const int combo = q >> 7, rr = q & 127, d = combo / 3, h = g * HPG + combo % 3;
          ta[j] = WSP(float, WS_ACUM)[(size_t)(d * NH + h) * MT + t0 + rr]; td[j] = DTp[(size_t)(t0 + rr) * 24 + d * NH + h]; } }
#pragma unroll
      for (int j = 0; j < 4; ++j) { const int q = tid + NTHR * j, row = q >> 4, cc = (q & 15) * 8; *(LAS v4u*)(Bm + row * 136 + cc) = tb[j]; *(LAS v4u*)(Cm + row * 136 + cc) = tc[j]; }
#pragma unroll
      for (int j = 0; j < 6; ++j) { const int q = tid + NTHR * j, row = q >> 4, cc = (q & 15) * 8; *(LAS v4u*)(XT + row * 136 + cc) = tx[j]; }
#pragma unroll
      for (int j = 0; j < 2; ++j) { const int q = tid + NTHR * j; if (q < 768) { Ac[q] = ta[j]; Dv[q] = td[j]; } } }
    __syncthreads();
    const int lb = wave & 3, ph = wave >> 2, r = lane & 31, hh = lane >> 5;
    f32x16 T[4];
#pragma unroll
    for (int sb = 0; sb < 4; ++sb)
#pragma unroll
        for (int i = 0; i < 16; ++i) T[sb][i] = 0.f;
#pragma unroll 2
    for (int ks = 0; ks < 8; ++ks) {
        const bf16x8 cf = as_bf16x8(*(const LAS v4u*)(Cm + (32 * lb + r) * 136 + 16 * ks + 8 * hh));
#pragma unroll
        for (int sb = 0; sb < 4; ++sb) T[sb] = MFMA32(as_bf16x8(*(const LAS v4u*)(Bm + (32 * sb + r) * 136 + 16 * ks + 8 * hh)), cf, T[sb]);
    }
    f32x16 Y;
    for (int cc = 0; cc < ncombo; ++cc) {
        const int e = e0 + (cc >> 1), d = cc & 1, h = g * HPG + e, combo = d * 3 + e;
        if (d == 0) {
#pragma unroll
            for (int i = 0; i < 16; ++i) Y[i] = 0.f;
        }
        __syncthreads();
#pragma unroll
        for (int j = 0; j < 2; ++j) { const int q = tid + NTHR * j; *(LAS v4u*)(Hs + (q >> 4) * 136 + (q & 15) * 8) = hreg[j]; }
        __syncthreads();
        if (cc + 1 < ncombo) FSSD_HIN_LOAD(cc + 1);
        const float Al = Ac[combo * 128 + 32 * lb + r]; const float eal = __expf(Al);
#pragma unroll 4
        for (int ks = 0; ks < 8; ++ks) { float cv[8]; unpack8(*(const LAS v4u*)(Cm + (32 * lb + r) * 136 + 16 * ks + 8 * hh), cv);
            v4u av; av.x = pk2(cv[0] * eal, cv[1] * eal); av.y = pk2(cv[2] * eal, cv[3] * eal); av.z = pk2(cv[4] * eal, cv[5] * eal); av.w = pk2(cv[6] * eal, cv[7] * eal);
            Y = MFMA32(as_bf16x8(av), as_bf16x8(*(const LAS v4u*)(Hs + (32 * ph + r) * 136 + 16 * ks + 8 * hh)), Y); }
#pragma unroll
        for (int sb = 0; sb < 4; ++sb) {
            if (d == 0 ? (sb > lb) : (sb < lb)) continue;
            const LAS bf16* xrow = XT + (e * 64 + 32 * ph + r) * 136 + 32 * sb + 4 * hh;
#pragma unroll
            for (int sp = 0; sp < 2; ++sp) {
                float tm[8];
                const int sbase = 32 * sb + 16 * sp + 4 * hh;
                const f32x4 a0 = *(const LAS f32x4*)(Ac + combo * 128 + sbase), a1 = *(const LAS f32x4*)(Ac + combo * 128 + sbase + 8);
                const f32x4 d0 = *(const LAS f32x4*)(Dv + combo * 128 + sbase), d1 = *(const LAS f32x4*)(Dv + combo * 128 + sbase + 8);
#pragma unroll
                for (int j = 0; j < 8; ++j) { const int i = 8 * sp + j, sl = (i & 3) + 8 * (i >> 2) + 4 * hh;
                    const bool valid = (sb != lb) || (d == 0 ? (sl <= r) : (sl >= r));
                    const float as = (j < 4) ? a0[j & 3] : a1[j & 3], ds = (j < 4) ? d0[j & 3] : d1[j & 3];
                    tm[j] = valid ? T[sb][i] * __expf(Al - as) * ds : 0.f; }
                v4u av; av.x = pk2(tm[0], tm[1]); av.y = pk2(tm[2], tm[3]); av.z = pk2(tm[4], tm[5]); av.w = pk2(tm[6], tm[7]);
                const v2u x0 = *(const LAS v2u*)(xrow + 16 * sp), x1 = *(const LAS v2u*)(xrow + 16 * sp + 8);
                v4u bv; bv.x = x0.x; bv.y = x0.y; bv.z = x1.x; bv.w = x1.y;
                Y = MFMA32(as_bf16x8(av), as_bf16x8(bv), Y);
                SCHED_FENCE();
            }
            SCHED_FENCE();
        }
        if (d == 1) {
            int t0v = t0; OPAQUE_V(t0v);
            const float Dh = p.in[I_SD][l * NH + h];
            const int colg = h * HD + 32 * ph + r; const float ngv = p.in[I_SNG][l * SSD_D + colg];
            const LAS bf16* xrow = XT + (e * 64 + 32 * ph + r) * 136 + 32 * lb;
            float ssq[16]; unsigned short zv[16];
#pragma unroll
            for (int i = 0; i < 16; ++i) zv[i] = P[(size_t)(t0v + 32 * lb + (i & 3) + 8 * (i >> 2) + 4 * hh) * NP + OFF_B + colg];
            v2u xq[4];
#pragma unroll
            for (int q = 0; q < 4; ++q) xq[q] = *(const LAS v2u*)(xrow + 8 * q + 4 * hh);
#pragma unroll
            for (int i = 0; i < 16; ++i) { const int lr = (i & 3) + 8 * (i >> 2) + 4 * hh, t = t0v + 32 * lb + lr;
                const unsigned xw = (i & 2) ? xq[i >> 2].y : xq[i >> 2].x; const float xv_ = (i & 1) ? bfhi(xw) : bflo(xw);
                const float y = Y[i] + Dh * xv_;
                const float u = y * siluf_(bf2f(zv[i]));
                ssq[i] = u * u;
                WSP(bf16, WS_Y)[(size_t)t * YK + YOFF_B + colg] = (bf16)f2bf(u * ngv); }
#pragma unroll
            for (int i = 0; i < 16; ++i) { const float v = half_sum32(ssq[i]);
                if (r == 16) WSP(float, WS_SSQ)[(size_t)(t0v + 32 * lb + (i & 3) + 8 * (i >> 2) + 4 * hh) * 24 + (g * HPG + e) * 2 + ph] = v; }
        }
    }
#undef FSSD_HIN_LOAD
    __syncthreads();
}

#define HPAD(i) ((i) + ((i) >> 5))
__device__ __forceinline__ f32x2 cmul(f32x2 a, f32x2 b) { return (f32x2){a.x * b.x - a.y * b.y, a.x * b.y + a.y * b.x}; }
__device__ __forceinline__ f32x2 cconj(f32x2 a) { return (f32x2){a.x, -a.y}; }
template <int LR> __device__ __forceinline__ constexpr int brevn(int i) { int r = 0; for (int b = 0; b < LR; ++b) r |= ((i >> b) & 1) << (LR - 1 - b); return r; }
__device__ __forceinline__ constexpr float w32_cos(int e) {
    constexpr float t[16] = {1.0f, 0.9807852804032304f, 0.9238795325112867f, 0.8314696123025452f, 0.7071067811865476f, 0.5555702330196022f, 0.3826834323650898f, 0.19509032201612825f,
                             0.0f, -0.19509032201612825f, -0.3826834323650898f, -0.5555702330196022f, -0.7071067811865476f, -0.8314696123025452f, -0.9238795325112867f, -0.9807852804032304f};
    return t[e]; }
__device__ __forceinline__ constexpr float w32_sin(int e) {
    constexpr float t[16] = {0.0f, 0.19509032201612825f, 0.3826834323650898f, 0.5555702330196022f, 0.7071067811865476f, 0.8314696123025452f, 0.9238795325112867f, 0.9807852804032304f,
                             1.0f, 0.9807852804032304f, 0.9238795325112867f, 0.8314696123025452f, 0.7071067811865476f, 0.5555702330196022f, 0.3826834323650898f, 0.19509032201612825f};
    return t[e]; }
template <bool INV> __device__ __forceinline__ f32x2 mul_w32(f32x2 d, int e) {
    const float sg = INV ? -1.f : 1.f;
    if (e == 0) return d;
    if (e == 8) return (f32x2){sg * d.y, -sg * d.x};
    if (e == 4) return (f32x2){(d.x + sg * d.y) * 0.7071067811865476f, (d.y - sg * d.x) * 0.7071067811865476f};
    if (e == 12) return (f32x2){(-d.x + sg * d.y) * 0.7071067811865476f, (-d.y - sg * d.x) * 0.7071067811865476f};
    const float c = w32_cos(e), sn = w32_sin(e);
    return (f32x2){d.x * c + sg * d.y * sn, d.y * c - sg * d.x * sn};
}
template <int R, bool INV> __device__ __forceinline__ void dft_r(f32x2 (&v)[R]) {
    constexpr int LR = (R == 32) ? 5 : 4;
#pragma unroll
    for (int hs = LR - 1; hs >= 0; --hs) { const int half = 1 << hs;
#pragma unroll
        for (int b = 0; b < R / 2; ++b) { const int j = b & (half - 1), i0 = ((b >> hs) << (hs + 1)) + j, i1 = i0 + half;
            const f32x2 a = v[i0], c = v[i1]; v[i0] = a + c; v[i1] = mul_w32<INV>(a - c, (j << (LR - 1 - hs)) * (32 / R)); }
        if (R == 32) SCHED_FENCE(); }
}
template <int n, int P> struct FftPlan { static constexpr int R = (n == 16384) ? (P < 2 ? 32 : (P == 2 ? 16 : 1)) : (n == 1024 ? (P < 2 ? 32 : 1) : (n == 256 ? (P < 2 ? 16 : 1) : 0)); };
template <int n, int P> struct FftM { static constexpr int value = FftM<n, P - 1>::value / FftPlan<n, P>::R; };
template <int n> struct FftM<n, -1> { static constexpr int value = n; };
static_assert(FftM<16384, 2>::value == 1 && FftM<256, 1>::value == 1, "fft plan");
template <int n> __device__ __forceinline__ int fft_pos(int k) {
    int pos = 0;
    if constexpr (FftPlan<n, 0>::R > 1) { constexpr int R = FftPlan<n, 0>::R, M = FftM<n, 0>::value; pos += (k % R) * M; k /= R; }
    if constexpr (FftPlan<n, 1>::R > 1) { constexpr int R = FftPlan<n, 1>::R, M = FftM<n, 1>::value; pos += (k % R) * M; k /= R; }
    if constexpr (FftPlan<n, 2>::R > 1) { constexpr int R = FftPlan<n, 2>::R, M = FftM<n, 2>::value; pos += (k % R) * M; k /= R; }
    return pos;
}
template <int n, int P, bool INV> __device__ __forceinline__ void fft_pass(LAS f32x2* xc, int tid) {
    constexpr int R = FftPlan<n, P>::R, M = FftM<n, P>::value, LR = (R == 32) ? 5 : 4, NB = n / R;
    constexpr int lm = (M == 1) ? 0 : (M == 16 ? 4 : (M == 32 ? 5 : (M == 512 ? 9 : (M == 1024 ? 10 : -1))));
    static_assert(lm >= 0 && (1 << lm) == M, "fft pass geometry");
#pragma unroll 1
    for (int uu = 0; uu < (NB + NTHR - 1) / NTHR; ++uu) { const int u = tid + uu * NTHR; if (u >= NB) continue; const int b = u & (M - 1), base = ((u >> lm) << (lm + LR)) + b;
        f32x2 v[R];
        const int hb = HPAD(base);
#define FOFF(S) ((S) * M + (((S) * M) >> 5))
        const float ang1 = (float)b * (1.0f / (float)(R * M));
        if constexpr (!INV) {
#pragma unroll
            for (int a = 0; a < R; ++a) v[a] = xc[hb + FOFF(a)];
            dft_r<R, false>(v);
            float ag = ang1;
#pragma unroll
            for (int i = 0; i < R; ++i) { const int s_ = brevn<LR>(i); f32x2 y = v[i];
                if ((i & 7) == 0) OPAQUE_V(ag);
                if (s_ != 0 && M > 1) { float sn, cs; sincos_turns((float)s_ * ag, sn, cs); y = cmul(y, (f32x2){cs, -sn}); }
                xc[hb + FOFF(s_)] = y;
                if ((i & 7) == 7) SCHED_FENCE(); }
        } else {
            float ag = ang1;
#pragma unroll
            for (int s_ = 0; s_ < R; ++s_) { f32x2 y = xc[hb + FOFF(s_)];
                if ((s_ & 7) == 0) OPAQUE_V(ag);
                if (s_ != 0 && M > 1) { float sn, cs; sincos_turns((float)s_ * ag, sn, cs); y = cmul(y, (f32x2){cs, sn}); }
                v[s_] = y;
                if ((s_ & 7) == 7) SCHED_FENCE(); }
            dft_r<R, true>(v);
#pragma unroll
            for (int i = 0; i < R; ++i) xc[hb + FOFF(brevn<LR>(i))] = v[i];
        }
#undef FOFF
    }
    __syncthreads();
}
template <int n> __device__ __forceinline__ void fft_fwd(LAS f32x2* xc, int tid) {
    if constexpr (FftPlan<n, 0>::R > 1) fft_pass<n, 0, false>(xc, tid);
    if constexpr (FftPlan<n, 1>::R > 1) fft_pass<n, 1, false>(xc, tid);
    if constexpr (FftPlan<n, 2>::R > 1) fft_pass<n, 2, false>(xc, tid);
}
template <int n> __device__ __forceinline__ void fft_inv(LAS f32x2* xc, int tid) {
    if constexpr (FftPlan<n, 2>::R > 1) fft_pass<n, 2, true>(xc, tid);
    if constexpr (FftPlan<n, 1>::R > 1) fft_pass<n, 1, true>(xc, tid);
    if constexpr (FftPlan<n, 0>::R > 1) fft_pass<n, 0, true>(xc, tid);
}
template <int n> __device__ __forceinline__ void hyena_item(KPR p, int l, LAS unsigned char* lds, int c, int toff, f32x4* fscr, f32x2* zscr, int tid) {
    LAS float* xr = (LAS float*)lds; LAS f32x2* xc = (LAS f32x2*)lds;
    LAS float* aux = (LAS float*)(lds + 139264);
    const bf16* QT = WSP(bf16, WS_QT); const bf16* TAPS = WSP(bf16, WS_TAPS);
    const int lane = tid & 63, wave = tid >> 6;
    constexpr int NM = (n / 2 + NTHR - 1) / NTHR, CH = NM >= 8 ? 8 : NM, NK = NM + 1, CK = 4;
    for (int o = 0; o < 2; ++o) {
        const bf16* tf = TAPS + (size_t)(o * 1024 + c) * MT + toff; const bf16* tb = TAPS + (size_t)(o * 1024 + 512 + c) * MT + toff;
        __syncthreads();
        float asum = 0.f;
#pragma unroll 1
        for (int j0 = 0; j0 < NM; j0 += CH) {
            unsigned wf[CH], wb[CH];
#pragma unroll
            for (int j = 0; j < CH; ++j) { const int m = tid + NTHR * (j0 + j); wf[j] = 0u; wb[j] = 0u; if (m < n / 2) { wf[j] = *(const unsigned*)(tf + 2 * m); wb[j] = *(const unsigned*)(tb + 2 * m); } }
#pragma unroll
            for (int j = 0; j < CH; ++j) { const int m = tid + NTHR * (j0 + j); if (m < n / 2) {
                const float f0 = bflo(wf[j]), f1 = bfhi(wf[j]), b0 = bflo(wb[j]), b1 = bfhi(wb[j]);
                xc[HPAD(m)] = (f32x2){f0, f1}; asum += fabsf(f0) + fabsf(f1) + fabsf(b1) + (m > 0 ? fabsf(b0) : 0.f);
                if (m > 0) xr[2 * HPAD(n - m)] = b0; else xr[2 * HPAD(n / 2)] = 0.f;
                xr[2 * HPAD(n - m - 1) + 1] = b1; } }
        }
        asum = wave_sum(asum);
        if (lane == 0) aux[128 + wave] = asum;
        __syncthreads();
        float norm = 0.f;
#pragma unroll
        for (int i = 0; i < NWAVES; ++i) norm += aux[128 + i];
        fft_fwd<n>(xc, tid);
        const float scale = frcp(norm * (float)n);
#pragma unroll 2
        for (int j = 0; j < NK; ++j) { const int k = tid + NTHR * j; if (k <= n / 2) {
            const int pk = HPAD(fft_pos<n>(k)), pq = HPAD(fft_pos<n>((n - k) & (n - 1)));
            const f32x2 A = xc[pk], Bc = cconj(xc[pq]);
            const f32x2 E = (A + Bc) * 0.5f, Dd = A - Bc; const f32x2 O = (f32x2){Dd.y * 0.5f, -Dd.x * 0.5f};
            float sn, cs; sincos_turns((float)k * (0.5f / (float)n), sn, cs);
            const f32x2 wO = cmul((f32x2){cs, -sn}, O);
            const f32x2 Kk = (E + wO) * scale, Kn = cconj(E - wO) * scale;
            fscr[k] = (f32x4){Kk.x, Kk.y, Kn.x, Kn.y}; } }
        __syncthreads();
#pragma unroll 1
        for (int j0 = 0; j0 < NM; j0 += CH) {
            f32x2 zz[CH];
#pragma unroll
            for (int j = 0; j < CH; ++j) { const int m = tid + NTHR * (j0 + j); zz[j] = (f32x2){0.f, 0.f};
                if (m < n / 2) { if (o == 0) { const unsigned w = *(const unsigned*)(QT + (size_t)c * MT + toff + 2 * m); zz[j] = (f32x2){bflo(w), bfhi(w)}; } else zz[j] = zscr[m]; } }
#pragma unroll
            for (int j = 0; j < CH; ++j) { const int m = tid + NTHR * (j0 + j); if (m < n / 2) { xc[HPAD(m)] = zz[j]; xc[HPAD(m + n / 2)] = (f32x2){0.f, 0.f}; } }
        }
        __syncthreads();
        fft_fwd<n>(xc, tid);
#pragma unroll 1
        for (int j0 = 0; j0 < NK; j0 += CK) {
            f32x4 kfv[CK];
#pragma unroll
            for (int j = 0; j < CK; ++j) { const int k = tid + NTHR * (j0 + j); kfv[j] = (f32x4){0.f, 0.f, 0.f, 0.f}; if (j0 + j < NK && k <= n / 2) kfv[j] = fscr[k]; }
#pragma unroll
            for (int j = 0; j < CK; ++j) { const int k = tid + NTHR * (j0 + j); if (j0 + j < NK && k <= n / 2) {
                const int pk = HPAD(fft_pos<n>(k)), pq = HPAD(fft_pos<n>((n - k) & (n - 1)));
                const f32x2 A = xc[pk], Bc = cconj(xc[pq]);
                const f32x2 E = (A + Bc) * 0.5f, Dd = A - Bc; const f32x2 O = (f32x2){Dd.y * 0.5f, -Dd.x * 0.5f};
                float sn, cs; sincos_turns((float)k * (0.5f / (float)n), sn, cs);
                const f32x2 w = (f32x2){cs, -sn}; const f32x2 wO = cmul(w, O);
                const f32x4 kf = kfv[j];
                const f32x2 Yk = cmul(E + wO, (f32x2){kf[0], kf[1]}), Yn = cmul(cconj(E - wO), (f32x2){kf[2], kf[3]});
                const f32x2 Ey = (Yk + cconj(Yn)) * 0.5f; const f32x2 Oy = cmul((Yk - cconj(Yn)) * 0.5f, cconj(w));
                xc[pk] = (f32x2){Ey.x - Oy.y, Ey.y + Oy.x};
                if (pq != pk) xc[pq] = (f32x2){Ey.x + Oy.y, Oy.x - Ey.y};
            } }
        }
        __syncthreads();
        fft_inv<n>(xc, tid);
        const float bias = p.in[I_HBIAS][(size_t)(l * 2 + o) * HY_D + c];
#pragma unroll 1
        for (int j0 = 0; j0 < NM; j0 += CH) {
            unsigned gwv[CH]; f32x2 zz[CH];
#pragma unroll
            for (int j = 0; j < CH; ++j) { const int m = tid + NTHR * (j0 + j); gwv[j] = 0u; zz[j] = (f32x2){0.f, 0.f};
                if (m < n / 2) { gwv[j] = *(const unsigned*)(QT + (size_t)((o + 1) * 512 + c) * MT + toff + 2 * m);
                    if (o == 0) { const unsigned w = *(const unsigned*)(QT + (size_t)c * MT + toff + 2 * m); zz[j] = (f32x2){bflo(w), bfhi(w)}; } else zz[j] = zscr[m]; } }
#pragma unroll
            for (int j = 0; j < CH; ++j) { const int m = tid + NTHR * (j0 + j); if (m < n / 2) {
                const f32x2 cv = xc[HPAD(m)];
                const float r0 = bflo(gwv[j]) * (cv.x + bias * zz[j].x), r1 = bfhi(gwv[j]) * (cv.y + bias * zz[j].y);
                if (o == 0) zscr[m] = (f32x2){r0, r1};
                else *(unsigned*)(WSP(bf16, WS_YCT) + (size_t)c * MT + toff + 2 * m) = pk2(r0, r1); } }
        }
    }
    __syncthreads();
}
__device__ __forceinline__ void c6_taps_item(KPR p, int l, LAS unsigned char* lds, int idx, int tid) {
    const int fg = idx % 8, tt = idx / 8, lane = tid & 63, wave = tid >> 6, r = lane & 31, hh = lane >> 5;
    LAS bf16* Hs = (LAS bf16*)lds;
    LAS bf16* Ws = (LAS bf16*)(lds + 36864);
    const float* hid = WSP(float, WS_HID2) + (size_t)tt * 256 * 64; const float* w3 = p.in[I_HW3] + (size_t)l * 64 * HY_NF + fg * 256;
    __syncthreads();
    { f32x4 tl[8]; float tw[32];
#pragma unroll
      for (int j = 0; j < 8; ++j) { const int q = tid + NTHR * j, row = q >> 4, c4 = (q & 15) * 4; tl[j] = *(const f32x4*)(hid + (size_t)row * 64 + c4); }
#pragma unroll
      for (int j = 0; j < 32; ++j) { const int q = tid + NTHR * j, i = q >> 8, f = q & 255; tw[j] = w3[(size_t)i * HY_NF + f]; }
#pragma unroll
      for (int j = 0; j < 8; ++j) { const int q = tid + NTHR * j, row = q >> 4, c4 = (q & 15) * 4; v2u w; w.x = pk2(tl[j][0], tl[j][1]); w.y = pk2(tl[j][2], tl[j][3]); *(LAS v2u*)(Hs + row * 72 + c4) = w; }
#pragma unroll
      for (int j = 0; j < 32; ++j) { const int q = tid + NTHR * j, i = q >> 8, f = q & 255; Ws[f * 72 + i] = (bf16)f2bf(tw[j]); } }
    __syncthreads();
    const int t0 = tt * 256, isctx = t0 >= SEQ, n = isctx ? CTX : SEQ, tl0 = isctx ? t0 - SEQ : t0;
    const float DMIN = -3.0701134573253945f, DMAX = -15.350567286626973f;
    bf16x8 af[4];
#pragma unroll
    for (int ks = 0; ks < 4; ++ks) af[ks] = as_bf16x8(*(const LAS v4u*)(Ws + (32 * wave + r) * 72 + 16 * ks + 8 * hh));
    float dl[16];
#pragma unroll
    for (int i = 0; i < 16; ++i) { const int f = fg * 256 + 32 * wave + (i & 3) + 8 * (i >> 2) + 4 * hh; dl[i] = fabsf(DMIN + (DMAX - DMIN) * ((float)f / 2047.0f)); }
    for (int tb = 0; tb < 8; ++tb) {
        f32x16 acc;
#pragma unroll
        for (int i = 0; i < 16; ++i) acc[i] = 0.f;
#pragma unroll
        for (int ks = 0; ks < 4; ++ks) acc = MFMA32(af[ks], as_bf16x8(*(const LAS v4u*)(Hs + (32 * tb + r) * 72 + 16 * ks + 8 * hh)), acc);
        const float t01 = (float)(tl0 + 32 * tb + r) * frcp((float)(n - 1));
        bf16* o = WSP(bf16, WS_TAPS) + (size_t)(fg * 256 + 32 * wave) * MT + t0 + 32 * tb + r;
#pragma unroll
        for (int i = 0; i < 16; ++i) o[(size_t)((i & 3) + 8 * (i >> 2) + 4 * hh) * MT] = (bf16)f2bf(acc[i] * __expf(-t01 * dl[i]));
    }
    __syncthreads();
}
__device__ __forceinline__ void f_yct_item(KPR p, LAS unsigned char* lds, int idx, int tid) {
    LAS bf16* tile = (LAS bf16*)lds;
    const int t0 = idx * 64;
    { v4u tl[8];
#pragma unroll
      for (int j = 0; j < 8; ++j) { const int q = tid + NTHR * j, row = q >> 3, cc = q & 7; tl[j] = *(const v4u*)(WSP(bf16, WS_YCT) + (size_t)row * MT + t0 + 8 * cc); }
#pragma unroll
      for (int j = 0; j < 8; ++j) { const int q = tid + NTHR * j, row = q >> 3, cc = q & 7; *(LAS v4u*)(tile + row * 72 + 8 * cc) = tl[j]; } }
    __syncthreads();
    for (int q = tid; q < 64 * 64; q += NTHR) { const int tok = q >> 6, cc = q & 63;
        unsigned short e[8];
#pragma unroll
        for (int i = 0; i < 8; ++i) e[i] = tile[(8 * cc + i) * 72 + tok];
        v4u o; o.x = e[0] | ((unsigned)e[1] << 16); o.y = e[2] | ((unsigned)e[3] << 16); o.z = e[4] | ((unsigned)e[5] << 16); o.w = e[6] | ((unsigned)e[7] << 16);
        *(v4u*)(WSP(bf16, WS_Y) + (size_t)(t0 + tok) * YK + YOFF_C + 8 * cc) = o; }
    __syncthreads();
}
constexpr int D_HY_LAT = HY_D, D_SSD_LAT = NCH_LAT * NG, D_SSD_CTX = (NCH - NCH_LAT) * NG, D_SSD = D_SSD_LAT + D_SSD_CTX, D_HY_CTX = HY_D, D_ITEMS = D_HY_LAT + D_SSD + D_HY_CTX;
constexpr int E_ITEMS = 2 * NH * HD * NS / NTHR;
constexpr int F_SSD_LAT = NCH_LAT * NG, F_SSD_CTX = (NCH - NCH_LAT) * NG * HPG, F_YCT = MT / 64, F_ITEMS = F_SSD_LAT + F_SSD_CTX + F_YCT;

#ifndef GEMM1_ALIGN
#define GEMM1_ALIGN true
#endif
#ifndef GEMM1_SP2
#define GEMM1_SP2 true
#endif

#ifndef PROBE_DBL
#define PROBE_DBL 0
#endif

constexpr float DN_ALPHA = (DEPTH == 4) ? 1.681792830507429f : (DEPTH == 2 ? 1.4142135623730951f : (DEPTH == 1 ? 1.189207115002721f : 0.f));
static_assert(DN_ALPHA != 0.f, "add DN_ALPHA for this DEPTH");
__device__ __forceinline__ int tok_per_wg(int G) { return (MT + G - 1) / G; }
template <int NR> __device__ __forceinline__ void phase_r_rows(KPR p, int l, LAS float* rgw_s, LAS float* rew_s, LAS int* hist, const int (&t)[NR], const bool (&ok)[NR], int lane, bool dummy) {
    const bf16* T = WSP(bf16, WS_MG);
    const float* lg = p.in[I_LNG] + (size_t)(l * 2 + 0) * D; const float* lb = p.in[I_LNB] + (size_t)(l * 2 + 0) * D;
    f32x4 x[NR][D / 256]; float s[NR], s2[NR];
#pragma unroll
    for (int r = 0; r < NR; ++r) { s[r] = 0.f; const int which = t[r] < SEQ ? 0 : 1; const float* hr = hrow(p, t[r]); const float* g1 = modv(p, l, which, 2);
#pragma unroll
        for (int j = 0; j < D / 256; ++j) { const int c = 4 * lane + 256 * j; const v2u mx = *(const v2u*)(T + (size_t)t[r] * D + c); x[r][j] = *(const f32x4*)(hr + c) * DN_ALPHA + *(const f32x4*)(g1 + c) * (f32x4){bflo(mx.x), bfhi(mx.x), bflo(mx.y), bfhi(mx.y)}; s[r] += (x[r][j][0] + x[r][j][1]) + (x[r][j][2] + x[r][j][3]); } }
#pragma unroll
    for (int r = 0; r < NR; ++r) s[r] = wave_sum(s[r]) * (1.f / D);
#pragma unroll
    for (int r = 0; r < NR; ++r) { s2[r] = 0.f;
#pragma unroll
        for (int j = 0; j < D / 256; ++j) { x[r][j] = x[r][j] - s[r]; s2[r] += (x[r][j][0] * x[r][j][0] + x[r][j][1] * x[r][j][1]) + (x[r][j][2] * x[r][j][2] + x[r][j][3] * x[r][j][3]); } }
#pragma unroll
    for (int r = 0; r < NR; ++r) s2[r] = frsq(wave_sum(s2[r]) * (1.f / D) + LN_EPS);
    float gl[NR][4]; f32x2 gl2[NR][4];
#pragma unroll
    for (int r = 0; r < NR; ++r) { const int which = t[r] < SEQ ? 0 : 1; const float* sh = modv(p, l, which, 3); const float* sc = modv(p, l, which, 4);
        float* h = dummy ? WSP(float, WS_YS) + (size_t)t[r] * D : hrow(p, t[r]); bf16* u = WSP(bf16, WS_U) + (size_t)t[r] * D;
        gl2[r][0] = (f32x2){0.f, 0.f}; gl2[r][1] = gl2[r][0]; gl2[r][2] = gl2[r][0]; gl2[r][3] = gl2[r][0];
#pragma unroll
        for (int j = 0; j < D / 256; ++j) { const int c = 4 * lane + 256 * j;
            const f32x4 h1 = x[r][j] * s2[r] * *(const f32x4*)(lg + c) + *(const f32x4*)(lb + c);
            const f32x4 q = *(const f32x4*)(sc + c); const f32x4 sv = *(const f32x4*)(sh + c);
            f32x4 u2; u2[0] = h1[0] * (1.f + q[0]) + sv[0]; u2[1] = h1[1] * (1.f + q[1]) + sv[1]; u2[2] = h1[2] * (1.f + q[2]) + sv[2]; u2[3] = h1[3] * (1.f + q[3]) + sv[3];
            x[r][j] = u2;
            if (ok[r]) { *(f32x4*)(h + c) = h1; v2u w; w.x = pk2(u2[0], u2[1]); w.y = pk2(u2[2], u2[3]); *(v2u*)(u + c) = w; }
#pragma unroll
            for (int g = 0; g < 4; ++g) { const f32x4 gw4 = *(const LAS f32x4*)(rgw_s + g * D + c); gl2[r][g] += u2.lo * gw4.lo; gl2[r][g] += u2.hi * gw4.hi; } } }
#pragma unroll
    for (int r = 0; r < NR; ++r)
#pragma unroll
        for (int g = 0; g < 4; ++g) gl[r][g] = wave_sum(gl2[r][g].x + gl2[r][g].y) + p.in[I_RGB][l * 4 + g];
    int gs[NR]; float gprob[NR]; float el[NR][8]; f32x2 el2[NR][8];
#pragma unroll
    for (int r = 0; r < NR; ++r) { gs[r] = 0; float gm = gl[r][0];
#pragma unroll
        for (int g = 1; g < 4; ++g) if (gl[r][g] > gm) { gm = gl[r][g]; gs[r] = g; }
        gprob[r] = frcp(__expf(gl[r][0] - gm) + __expf(gl[r][1] - gm) + __expf(gl[r][2] - gm) + __expf(gl[r][3] - gm));
#pragma unroll
        for (int i = 0; i < 8; ++i) el2[r][i] = (f32x2){0.f, 0.f};
#pragma unroll
        for (int j = 0; j < D / 256; ++j) { const int c = 4 * lane + 256 * j;
#pragma unroll
            for (int i = 0; i < 8; ++i) { const f32x4 w4 = *(const LAS f32x4*)(rew_s + (gs[r] * 8 + i) * D + c); const f32x4 xv = x[r][j];
                el2[r][i] += xv.lo * w4.lo; el2[r][i] += xv.hi * w4.hi; } } }
#pragma unroll
    for (int r = 0; r < NR; ++r)
#pragma unroll
        for (int i = 0; i < 8; ++i) el[r][i] = wave_sum(el2[r][i].x + el2[r][i].y) + p.in[I_REB][l * NE + gs[r] * 8 + i];
#pragma unroll
    for (int r = 0; r < NR; ++r) {
        int i0 = 0; float v0 = el[r][0];
#pragma unroll
        for (int i = 1; i < 8; ++i) if (el[r][i] > v0) { v0 = el[r][i]; i0 = i; }
        int i1 = -1; float v1 = -3.0e38f;
#pragma unroll
        for (int i = 0; i < 8; ++i) if (i != i0 && el[r][i] > v1) { v1 = el[r][i]; i1 = i; }
        const float e1 = __expf(v1 - v0), w0 = gprob[r] * frcp(1.f + e1), w1 = gprob[r] * e1 * frcp(1.f + e1);
        if (lane == 0 && ok[r]) {
            v4u rr; rr.x = (unsigned)(gs[r] * 8 + i0); rr.y = (unsigned)(gs[r] * 8 + i1); rr.z = f2u(w0); rr.w = f2u(w1);
            *(v4u*)(WSP(unsigned, WS_ROUTE) + (size_t)t[r] * 4) = rr;
            atomicAdd((int*)&hist[gs[r] * 8 + i0], 1); atomicAdd((int*)&hist[gs[r] * 8 + i1], 1);
        }
    }
}
__device__ __forceinline__ void phase_r(KPR p, int l, LAS unsigned char* lds, int tid, int bid, int G, int tlim, bool dummy = false) {
    const int lane = tid & 63, wave = tid >> 6;
    LAS float* rew_s = (LAS float*)lds;
    LAS float* rgw_s = (LAS float*)(lds + (size_t)D * NE * 4);
    LAS int* hist = (LAS int*)(lds + (size_t)D * (NE + 4) * 4);
    __syncthreads();
    { const float* rgw = p.in[I_RGW] + (size_t)l * D * 4; const float* rew = p.in[I_REW] + (size_t)l * D * NE;
      constexpr int NQ = D * NE / 4 / NTHR;
#pragma unroll 1
      for (int j0 = 0; j0 < NQ; j0 += 8) { f32x4 tv[8];
#pragma unroll
          for (int j = 0; j < 8; ++j) { const int q = tid + NTHR * (j0 + j), c = q >> 3, e4 = (q & 7) * 4; tv[j] = (j0 + j < NQ) ? *(const f32x4*)(rew + (size_t)c * NE + e4) : (f32x4){0.f, 0.f, 0.f, 0.f}; }
#pragma unroll
          for (int j = 0; j < 8; ++j) if (j0 + j < NQ) { const int q = tid + NTHR * (j0 + j), c = q >> 3, e4 = (q & 7) * 4;
              rew_s[(e4 + 0) * D + c] = tv[j][0]; rew_s[(e4 + 1) * D + c] = tv[j][1]; rew_s[(e4 + 2) * D + c] = tv[j][2]; rew_s[(e4 + 3) * D + c] = tv[j][3]; } }
      for (int q = tid; q < D; q += NTHR) { const f32x4 v = *(const f32x4*)(rgw + 4 * q); rgw_s[q] = v[0]; rgw_s[D + q] = v[1]; rgw_s[2 * D + q] = v[2]; rgw_s[3 * D + q] = v[3]; } }
    if (tid < NE) hist[tid] = 0;
    __syncthreads();
    const int TPW = tok_per_wg(G), tb = bid * TPW, te = (tb + TPW < tlim) ? tb + TPW : tlim;
    constexpr int NR = 3;
    for (int k = tb + wave; k < te; k += NWAVES * NR) {
        int t[NR]; bool ok[NR];
#pragma unroll
        for (int r = 0; r < NR; ++r) { const int tt = k + r * NWAVES; ok[r] = tt < te; t[r] = ok[r] ? tt : k; }
        phase_r_rows<NR>(p, l, rgw_s, rew_s, hist, t, ok, lane, dummy);
    }
    __syncthreads();
    if (tid < NE) WSP(int, WS_HIST)[bid * NE + tid] = hist[tid];
    __syncthreads();
}
__device__ __forceinline__ void phase_g(KPR p, LAS unsigned char* lds, int tid, int bid, int G, int tlim) {
    const int lane = tid & 63, wave = tid >> 6;
    LAS int* cnt = (LAS int*)(lds + 131072);
    LAS int* bef = cnt + 32;
    LAS int* pst = cnt + 64;
    LAS int* base = cnt + 100;
    LAS int* alist = cnt + 160;
    const int TPW = tok_per_wg(G), tb = bid * TPW, te = (tb + TPW < tlim) ? tb + TPW : tlim, na = 2 * (te > tb ? te - tb : 0);
    const unsigned* route = WSP(unsigned, WS_ROUTE);
    { LAS int* part = cnt + 160 + 4096;
      const int e = tid & 31, pt = tid >> 5; int tot = 0, b = 0;
#pragma unroll 1
      for (int w0 = pt; w0 < G; w0 += 16 * 8) { int hv[8];
#pragma unroll
          for (int j = 0; j < 8; ++j) { const int w = w0 + 16 * j; hv[j] = (w < G) ? WSP(int, WS_HIST)[w * NE + e] : 0; }
#pragma unroll
          for (int j = 0; j < 8; ++j) { const int w = w0 + 16 * j; tot += hv[j]; if (w < bid) b += hv[j]; } }
      part[(pt * 2 + 0) * 32 + e] = tot; part[(pt * 2 + 1) * 32 + e] = b;
      __syncthreads();
      if (tid < NE) { int t2 = 0, b2 = 0; for (int q = 0; q < 16; ++q) { t2 += part[(q * 2) * 32 + tid]; b2 += part[(q * 2 + 1) * 32 + tid]; } cnt[tid] = t2; bef[tid] = b2; } }
    for (int a = tid; a < na; a += NTHR) alist[a] = (int)route[(size_t)(tb + (a >> 1)) * 4 + (a & 1)];
    __syncthreads();
    if (tid == 0) { int s = 0; for (int e = 0; e < NE; ++e) { pst[e] = s; s += (cnt[e] + 255) / 256 * 256; } pst[NE] = s; }
    __syncthreads();
    if (tid < NE) base[tid] = pst[tid] + bef[tid];
    __syncthreads();
    { int mypos[(2 * 1024 + NTHR - 1) / NTHR];
#pragma unroll
      for (int q = 0; q < (2 * 1024 + NTHR - 1) / NTHR; ++q) { const int a = tid + q * NTHR; mypos[q] = 0;
          if (q * NTHR < na) { const int e = a < na ? alist[a] : -1; int rank = 0;
#pragma unroll 8
              for (int a2 = 0; a2 < na; ++a2) rank += (a2 < a && alist[a2] == e) ? 1 : 0;
              if (a < na) mypos[q] = base[e] + rank; } }
      __syncthreads();
#pragma unroll
      for (int q = 0; q < (2 * 1024 + NTHR - 1) / NTHR; ++q) { const int a = tid + q * NTHR; if (a < na) alist[a] = mypos[q]; } }
    __syncthreads();
    for (int a = tid; a < na; a += NTHR) WSP(int, WS_POS)[(size_t)(tb + (a >> 1)) * 2 + (a & 1)] = alist[a];
    for (int a0 = wave * 4; a0 < na; a0 += NWAVES * 4) {
        constexpr int NJ = (D / 8 + 63) / 64; v4u buf[4][NJ];
#pragma unroll
        for (int r = 0; r < 4; ++r) { const int a = a0 + r < na ? a0 + r : a0; const bf16* src = WSP(bf16, WS_U) + (size_t)(tb + (a >> 1)) * D;
#pragma unroll
            for (int j = 0; j < NJ; ++j) if (lane + 64 * j < D / 8) buf[r][j] = *(const v4u*)(src + 8 * (lane + 64 * j)); }
#pragma unroll
        for (int r = 0; r < 4; ++r) if (a0 + r < na) { bf16* dst = WSP(bf16, WS_XS) + (size_t)alist[a0 + r] * D;
#pragma unroll
            for (int j = 0; j < NJ; ++j) if (lane + 64 * j < D / 8) *(v4u*)(dst + 8 * (lane + 64 * j)) = buf[r][j]; }
    }
    for (int e = bid; e < NE; e += G) {
        const int r0 = pst[e] + cnt[e], r1 = pst[e + 1]; unsigned zz_ = 0u; OPAQUE_V(zz_); v4u z; z.x = zz_; z.y = zz_; z.z = zz_; z.w = zz_;
        for (int q = tid; q < (r1 - r0) * (D / 8); q += NTHR) *(v4u*)(WSP(bf16, WS_XS) + (size_t)r0 * D + (size_t)q * 8) = z;
    }
    if (bid == 0) {
        const int nt = pst[NE] / 256;
        for (int i = tid; i < nt; i += NTHR) { int e = 0; while (e < NE - 1 && i * 256 >= pst[e + 1]) ++e; WSP(int, WS_TILEE)[i] = e; }
        if (tid == 0) WSP(int, WS_TILEE)[NTMAX] = nt;
    }
    __syncthreads();
}
__device__ __forceinline__ void phase_n(KPR p, int l, int gw, int NGW, int lane, int tlim, bool dummy = false) {
    const bf16* YS = WSP(bf16, WS_YS);
    const float* lg = p.in[I_LNG] + (size_t)(l * 2 + 1) * D; const float* lb = p.in[I_LNB] + (size_t)(l * 2 + 1) * D;
    constexpr int NR = 5;
    for (int k = gw; k < tlim; k += NGW * NR) {
        int t[NR]; bool ok[NR]; f32x4 x[NR][D / 256]; float s[NR], s2[NR];
#pragma unroll
        for (int r = 0; r < NR; ++r) { const int tt = k + r * NGW; ok[r] = tt < tlim; t[r] = ok[r] ? tt : k; }
        v4u rt[NR]; int p0[NR], p1[NR];
#pragma unroll
        for (int r = 0; r < NR; ++r) { rt[r] = *(const v4u*)(WSP(unsigned, WS_ROUTE) + (size_t)t[r] * 4); p0[r] = WSP(int, WS_POS)[(size_t)t[r] * 2]; p1[r] = WSP(int, WS_POS)[(size_t)t[r] * 2 + 1]; }
#pragma unroll
        for (int r = 0; r < NR; ++r) { const int which = t[r] < SEQ ? 0 : 1; const unsigned uz = rt[r].z, uw = rt[r].w; const float w0 = u2f(uz), w1 = u2f(uw);
            const float* g2 = modv(p, l, which, 5); const float* h = hrow(p, t[r]); s[r] = 0.f;
#pragma unroll
            for (int j = 0; j < D / 256; ++j) { const int c = 4 * lane + 256 * j;
                const v2u ya = *(const v2u*)(YS + (size_t)p0[r] * D + c), yb = *(const v2u*)(YS + (size_t)p1[r] * D + c);
                const f32x4 f = (f32x4){bflo(ya.x), bfhi(ya.x), bflo(ya.y), bfhi(ya.y)} * w0 + (f32x4){bflo(yb.x), bfhi(yb.x), bflo(yb.y), bfhi(yb.y)} * w1;
                x[r][j] = *(const f32x4*)(h + c) * DN_ALPHA + *(const f32x4*)(g2 + c) * f; s[r] += (x[r][j][0] + x[r][j][1]) + (x[r][j][2] + x[r][j][3]); } }
#pragma unroll
        for (int r = 0; r < NR; ++r) s[r] = wave_sum(s[r]) * (1.f / D);
#pragma unroll
        for (int r = 0; r < NR; ++r) { s2[r] = 0.f;
#pragma unroll
            for (int j = 0; j < D / 256; ++j) { x[r][j] = x[r][j] - s[r]; s2[r] += (x[r][j][0] * x[r][j][0] + x[r][j][1] * x[r][j][1]) + (x[r][j][2] * x[r][j][2] + x[r][j][3] * x[r][j][3]); } }
#pragma unroll
        for (int r = 0; r < NR; ++r) s2[r] = frsq(wave_sum(s2[r]) * (1.f / D) + LN_EPS);
#pragma unroll
        for (int r = 0; r < NR; ++r) { if (!ok[r]) continue; const int which = t[r] < SEQ ? 0 : 1; float* h = hrow(p, t[r]);
#pragma unroll
            for (int j = 0; j < D / 256; ++j) { const int c = 4 * lane + 256 * j;
                const f32x4 h2 = x[r][j] * s2[r] * *(const f32x4*)(lg + c) + *(const f32x4*)(lb + c);
                *(f32x4*)((dummy ? WSP(float, WS_XS) + (size_t)t[r] * D : h) + c) = h2;
                if (l + 1 < DEPTH) { const f32x4 q = *(const f32x4*)(modv(p, l + 1, which, 1) + c), sv = *(const f32x4*)(modv(p, l + 1, which, 0) + c);
                    v2u w; w.x = pk2(h2[0] * (1.f + q[0]) + sv[0], h2[1] * (1.f + q[1]) + sv[1]); w.y = pk2(h2[2] * (1.f + q[2]) + sv[2], h2[3] * (1.f + q[3]) + sv[3]);
                    *(v2u*)(WSP(bf16, WS_U) + (size_t)t[r] * D + c) = w; } } }
    }
}
__device__ __forceinline__ float ssd_rms_scale(const float* ssq, int row) {
    const float* q = ssq + (size_t)row * 24; float s = 0.f;
#pragma unroll
    for (int j = 0; j < 6; ++j) { const f32x4 v = *(const f32x4*)(q + 4 * j); s += (v[0] + v[1]) + (v[2] + v[3]); }
    return frsq(s * (1.0f / SSD_D) + LN_EPS);
}
constexpr int CTX_TILES = (CTX / 32) * (D / 32);
__device__ __forceinline__ void ctx_reduce_store(LAS unsigned char* lds, const f32x16& tot, int tid, float (&out2)[2]) {
    LAS float* red = (LAS float*)lds; const int lane = tid & 63, wave = tid >> 6;
    __syncthreads();
#pragma unroll
    for (int i = 0; i < 16; ++i) red[(wave * 16 + i) * 64 + lane] = tot[i];
    __syncthreads();
#pragma unroll
    for (int q = 0; q < 2; ++q) { const int e = tid + q * NTHR; float s = 0.f;
#pragma unroll
        for (int w = 0; w < NWAVES; ++w) s += red[w * 1024 + e];
        out2[q] = s; }
}
__device__ __forceinline__ void ctx_h_tile(KPR p, LAS unsigned char* lds, int tile, int tid) {
    const int rb = tile / (D / 32), cb = tile % (D / 32), lane = tid & 63, wave = tid >> 6, r = lane & 31, hh = lane >> 5;
    const int row0 = SEQ + 32 * rb, col0 = 32 * cb;
    const bf16* P = WSP(bf16, WS_P); const float* ssq = WSP(float, WS_SSQ);
    f32x16 tot;
#pragma unroll
    for (int i = 0; i < 16; ++i) tot[i] = 0.f;
    float rsc[16];
#pragma unroll
    for (int i = 0; i < 16; ++i) { rsc[i] = ssd_rms_scale(ssq, row0 + (i & 3) + 8 * (i >> 2) + 4 * hh); if ((i & 3) == 3) CFENCE(); }
#pragma unroll 1
    for (int br = 0; br < 4; ++br) {
        const int K = (br == 1) ? 768 : 512, ksl = K / 8;
        const int koff = br == 0 ? YOFF_A : (br == 1 ? YOFF_B : (br == 2 ? YOFF_C : YOFF_D));
        const bf16* A = WSP(bf16, WS_Y) + (size_t)(row0 + r) * YK + koff + wave * ksl + 8 * hh;
        const bf16* B = WSP(bf16, WS_WCAT) + (size_t)(col0 + r) * YK + koff + wave * ksl + 8 * hh;
        unsigned short g16[16];
#pragma unroll
        for (int i = 0; i < 16; ++i) g16[i] = P[(size_t)(row0 + (i & 3) + 8 * (i >> 2) + 4 * hh) * NP + OFF_G + br * D + col0 + r];
        f32x16 acc;
#pragma unroll
        for (int i = 0; i < 16; ++i) acc[i] = 0.f;
#pragma unroll 6
        for (int ks = 0; ks < ksl / 16; ++ks) acc = MFMA32(as_bf16x8(*(const v4u*)(A + 16 * ks)), as_bf16x8(*(const v4u*)(B + 16 * ks)), acc);
#pragma unroll
        for (int i = 0; i < 16; ++i) { float g = sigmoidf_(bf2f(g16[i]));
            if (br == 1) g *= rsc[i];
            tot[i] += g * acc[i]; }
    }
    float o2[2]; ctx_reduce_store(lds, tot, tid, o2);
#pragma unroll
    for (int q = 0; q < 2; ++q) { const int e = tid + q * NTHR, i = e >> 6, ln = e & 63; const int row = row0 + (i & 3) + 8 * (i >> 2) + 4 * (ln >> 5), col = col0 + (ln & 31);
        WSP(bf16, WS_U)[(size_t)row * D + col] = (bf16)f2bf(o2[q]); }
}
__device__ __forceinline__ void ctx_i_tile(KPR p, int l, LAS unsigned char* lds, int tile, int tid) {
    const int rb = tile / (D / 32), cb = tile % (D / 32), lane = tid & 63, wave = tid >> 6, r = lane & 31, hh = lane >> 5;
    const int row0 = SEQ + 32 * rb, col0 = 32 * cb; constexpr int ksl = D / 8;
    const bf16* A = WSP(bf16, WS_U) + (size_t)(row0 + r) * D + wave * ksl + 8 * hh;
    const bf16* B = WSP(bf16, WS_WOUT) + (size_t)(col0 + r) * D + wave * ksl + 8 * hh;
    f32x16 acc;
#pragma unroll
    for (int i = 0; i < 16; ++i) acc[i] = 0.f;
#pragma unroll
    for (int ks = 0; ks < ksl / 16; ++ks) acc = MFMA32(as_bf16x8(*(const v4u*)(A + 16 * ks)), as_bf16x8(*(const v4u*)(B + 16 * ks)), acc);
    float o2[2]; ctx_reduce_store(lds, acc, tid, o2);
#pragma unroll
    for (int q = 0; q < 2; ++q) { const int e = tid + q * NTHR, i = e >> 6, ln = e & 63; const int row = row0 + (i & 3) + 8 * (i >> 2) + 4 * (ln >> 5), col = col0 + (ln & 31);
        WSP(bf16, WS_MG)[(size_t)row * D + col] = (bf16)f2bf(o2[q]); }
}
__device__ NOINLINE void e_pre0() { ENTRY_BEGIN; phase_mod(p, lds, tid, bid, G); conv_weights(p, 0, lds, gw, NGW, lane, wave); }
__device__ NOINLINE void e_u0() { ENTRY_BEGIN; phase_u0(p, gw, NGW, lane); }
__device__ NOINLINE void e_gemm_b() { ENTRY_BEGIN;
    DenseOrder S; S.init(MT, NP, D, G, bid, WSP(bf16, WS_U), WSP(bf16, WS_WIN)); EpiPG E{WSP(bf16, WS_P), NP};
    pg8::gemm_phase<EpiPG, DenseOrder, GEMM1_ALIGN, GEMM1_SP2>(lds, D, S, E, tid); }
__device__ NOINLINE void e_c1(int l, int idx) { ENTRY_BEGIN; c1_conformer(p, UNI(l), lds, UNI(idx), tid); }
__device__ NOINLINE void e_cw(int l, int nheavy, int last) { ENTRY_BEGIN; __syncthreads();
    if (bid >= nheavy) c_wave_items(p, UNI(l), lds, (bid - nheavy) * NWAVES + wave, (G - nheavy) * NWAVES, lane, wave, UNI(last));
    __syncthreads(); }
__device__ NOINLINE void e_c5(int l) { ENTRY_BEGIN; __syncthreads(); c5_load_weights(p, UNI(l), lds, tid); __syncthreads(); for (int it = bid; it < C5_ITEMS; it += G) c5_item(p, UNI(l), lds, it, tid); __syncthreads(); }
__device__ NOINLINE void e_c6(int l, int idx) { ENTRY_BEGIN; c6_taps_item(p, UNI(l), lds, UNI(idx), tid); }
__device__ NOINLINE void e_hyena(int l, int c, int isctx) { ENTRY_BEGIN;
    f32x4* fscr = WSP(f32x4, WS_FSCR) + (size_t)bid * (SEQ / 2 + 1); f32x2* zscr = WSP(f32x2, WS_ZSCR) + (size_t)bid * (SEQ / 2);
    if (UNI(isctx)) hyena_item<CTX>(p, UNI(l), lds, UNI(c), SEQ, fscr, zscr, tid); else hyena_item<SEQ>(p, UNI(l), lds, UNI(c), 0, fscr, zscr, tid); }
__device__ NOINLINE void e_dssd(int l, int idx, int e_only) { ENTRY_BEGIN; d_ssd_item(p, UNI(l), lds, UNI(idx), UNI(e_only), tid); }
__device__ NOINLINE void e_scan() { ENTRY_BEGIN; for (int it = bid; it < E_ITEMS; it += G) e_scan_item(p, it, tid); }
__device__ NOINLINE void e_fssd(int l, int c, int g, int e0, int e1) { ENTRY_BEGIN; f_ssd_item(p, UNI(l), lds, UNI(c), UNI(g), UNI(e0), UNI(e1), tid); }
__device__ NOINLINE void e_fyct(int idx) { ENTRY_BEGIN; f_yct_item(p, lds, UNI(idx), tid); }
__device__ NOINLINE void e_gemm_h() { ENTRY_BEGIN;
    LAS float* rs = (LAS float*)(lds + 131072);
    { DenseOrder T; T.init(SEQ, D, YK, G, bid, nullptr, nullptr); pg8::Unit u; const float* ssq = WSP(float, WS_SSQ);
      __syncthreads();
      for (int i = 0; i < 8 && T.next(i, u); ++i) if (tid < 256) rs[i * 256 + tid] = ssd_rms_scale(ssq, u.pm * 256 + tid);
      __syncthreads(); }
    DenseOrder S; S.init(SEQ, D, YK, G, bid, WSP(bf16, WS_Y), WSP(bf16, WS_WCAT));
    EpiMerge E{WSP(bf16, WS_P) + OFF_G, WSP(bf16, WS_U), rs};
    int Kq = YK; OPAQUE_S(Kq);
    pg8::gemm_phase<EpiMerge, DenseOrder, true, true>(lds, Kq, S, E, tid); }
__device__ NOINLINE void e_gemm_i() { ENTRY_BEGIN;
    DenseOrder S; S.init(SEQ, D, D, G, bid, WSP(bf16, WS_U), WSP(bf16, WS_WOUT));
    EpiP E{WSP(bf16, WS_MG), D};
    pg8::gemm_phase<EpiP, DenseOrder, true, true>(lds, D, S, E, tid); }
__device__ NOINLINE void e_ctx_h() { ENTRY_BEGIN; for (int t = bid; t < CTX_TILES; t += G) ctx_h_tile(p, lds, t, tid); __syncthreads(); }
__device__ NOINLINE void e_ctx_i(int l) { ENTRY_BEGIN; for (int t = bid; t < CTX_TILES; t += G) ctx_i_tile(p, UNI(l), lds, t, tid); __syncthreads(); }
__device__ NOINLINE void e_r(int l, int tlim) { ENTRY_BEGIN; if (PROBE_DBL & 4194304) phase_r(p, UNI(l), lds, tid, bid, G, UNI(tlim), true); phase_r(p, UNI(l), lds, tid, bid, G, UNI(tlim)); }
__device__ NOINLINE void e_g(int tlim) { ENTRY_BEGIN; phase_g(p, lds, tid, bid, G, UNI(tlim)); }
__device__ NOINLINE void e_gemm_m1() { ENTRY_BEGIN;
    MoeOrder S{WSP(int, WS_TILEE), UNI(WSP(int, WS_TILEE)[NTMAX]), 2 * FF / 256, G, bid, (const char*)WSP(bf16, WS_XS), (const char*)WSP(bf16, WS_WGU), (size_t)256 * D * 2, (size_t)2 * FF * D * 2, (size_t)256 * D * 2};
    EpiSwiGLU E{WSP(bf16, WS_HS)};
    pg8::gemm_phase<EpiSwiGLU, MoeOrder, true, true>(lds, D, S, E, tid); }
__device__ NOINLINE void e_gemm_m2() { ENTRY_BEGIN;
    MoeOrder S{WSP(int, WS_TILEE), UNI(WSP(int, WS_TILEE)[NTMAX]), D / 256, G, bid, (const char*)WSP(bf16, WS_HS), (const char*)WSP(bf16, WS_WDN), (size_t)256 * FF * 2, (size_t)D * FF * 2, (size_t)256 * FF * 2};
    EpiP E{WSP(bf16, WS_YS), D};
    pg8::gemm_phase<EpiP, MoeOrder, true, true>(lds, FF, S, E, tid); }
__device__ NOINLINE void e_n(int l_) { ENTRY_BEGIN; const int l = UNI(l_); const int tlim = (l == DEPTH - 1) ? SEQ : MT; if (PROBE_DBL & 8388608) phase_n(p, l, gw, NGW, lane, tlim, true); phase_n(p, l, gw, NGW, lane, tlim); if (l + 1 < DEPTH) { conv_weights(p, l + 1, lds, gw, NGW, lane, wave); if (PROBE_DBL & 8) conv_weights(p, l + 1, lds, gw, NGW, lane, wave); } }

constexpr int NPH_PRE = 2, NPH_LAYER = 12, NPHASES = NPH_PRE + DEPTH * NPH_LAYER;
__global__ void __launch_bounds__(NTHR, 2) fwd_kernel(KParams kp) {
#ifdef CPU_EMU
    static KParams kp_static; kp_static = kp; g_emu_kp = &kp_static;
    const int lo = kp.ph_lo, hi = kp.ph_hi;
    XcdBarrier bar; bar.dummy = 0;
#else
    KP_DECL; LDS_DECL;
    const int lo = p.ph_lo, hi = p.ph_hi;
    volatile LAS unsigned* misc = (volatile LAS unsigned*)(lds + LDS_BYTES - 256);
    if (threadIdx.x < 64) misc[threadIdx.x] = 0u;
    __syncthreads();
    unsigned* ctl = WSP(unsigned, WS_CTL);
    XcdBarrier bar; bar.bar = ctl + CW_BAR; bar.x = 0; bar.st = misc;
    if (hi - lo > 1) bar = xcd_barrier_post(ctl + CW_BAR, misc);
#endif
    const int bid = blockIdx.x, G = gridDim.x;
#ifndef PH_MASK
#define PH_MASK 0xffffffu
#endif
#define PHON(k) ((PH_MASK >> (k)) & 1u)
#define IN(k) (lo <= (k) && (k) < hi)
#define SEAM(k) do { if (IN(k) && IN((k) + 1)) { xcd_barrier(bar); if (PROBE_DBL & 524288) { xcd_barrier(bar); xcd_barrier(bar); } } } while (0)
    if (PHON(0) && IN(0)) { e_pre0(); e_c5(0); if (PROBE_DBL & 4096) e_c5(0); }
    SEAM(0);
    if (PHON(1) && IN(1)) e_u0();
    SEAM(1);
    for (int l = 0; l < DEPTH; ++l) {
        const int b0 = NPH_PRE + l * NPH_LAYER;
        const int last = (l == DEPTH - 1) ? 1 : 0, tlim = last ? SEQ : MT;
        if (PHON(2) && IN(b0 + 0)) { e_gemm_b(); if (PROBE_DBL & 128) e_gemm_b(); }
        SEAM(b0 + 0);
        if (PHON(3) && IN(b0 + 1)) {
            for (int it = bid; it < C6_ITEMS; it += G) { if (last && (it / 8) * 256 >= SEQ) continue; e_c6(l, it); }
            {
                const int c1n = last ? C1_LAT : C1_ITEMS;
                const int xcd = bid & 7, slot = bid >> 3, per = (c1n + 7) / 8, nslot = (G + 7) / 8;
                int nheavy = 0;
                if ((G & 7) == 0) { for (int j = slot; j < per; j += nslot) { const int it = xcd * per + j; if (it < c1n) e_c1(l, it); }
                    if (nslot < per && per <= 2 * nslot) { for (int x = 0; x < 8; ++x) if (x * per + nslot < c1n) nheavy = x + 1; if (nheavy * 4 > G) nheavy = 0; } }
                else for (int it = bid; it < c1n; it += G) e_c1(l, it);
                e_cw(l, nheavy, last);
            }
            if (PROBE_DBL & 16) { for (int it = bid; it < C_ITEMS; it += G) { if (it < C6_ITEMS) e_c6(l, it); else e_c1(l, it - C6_ITEMS); } e_cw(l, 0, last); }
            if (PROBE_DBL & 65536) for (int it = bid; it < C6_ITEMS; it += G) e_c6(l, it);
            if (PROBE_DBL & 131072) for (int it = bid; it < C1_ITEMS; it += G) e_c1(l, it);
            if (PROBE_DBL & 262144) e_cw(l, 0, last); }
        SEAM(b0 + 1);
        if (PHON(4) && IN(b0 + 2)) for (int it = bid; it < D_ITEMS; it += G) {
            int r = it;
            if (r < D_HY_LAT) { e_hyena(l, r, 0); if (PROBE_DBL & 1) e_hyena(l, r, 0); continue; } r -= D_HY_LAT;
            if (r < D_SSD) { e_dssd(l, r, -1); if (PROBE_DBL & 2) e_dssd(l, r, -1); continue; } r -= D_SSD;
            if (!last) { e_hyena(l, r, 1); if (PROBE_DBL & 8192) e_hyena(l, r, 1); } }
        SEAM(b0 + 2);
        if (PHON(5) && IN(b0 + 3)) { e_scan(); if (PROBE_DBL & 1048576) e_scan(); }
        SEAM(b0 + 3);
        const int fgap = (!last && F_SSD_LAT % G == 0 && G > 2 * F_SSD_CTX) ? F_SSD_CTX : 0;
        if (PHON(6) && IN(b0 + 4)) for (int it = bid; it < F_ITEMS + fgap; it += G) { int r = it;
            if (r < F_SSD_LAT + F_SSD_CTX) { int c_, g_, e0_, e1_;
                if (r >= F_SSD_LAT && last) continue;
                if (r < F_SSD_LAT) { c_ = r / NG; g_ = r % NG; e0_ = 0; e1_ = HPG; } else { const int q = r - F_SSD_LAT, cg = q / HPG; c_ = NCH_LAT + cg / NG; g_ = cg % NG; e0_ = q % HPG; e1_ = e0_ + 1; }
                e_fssd(l, c_, g_, e0_, e1_); if (PROBE_DBL & 4) e_fssd(l, c_, g_, e0_, e1_); continue; }
            r -= F_SSD_LAT + F_SSD_CTX;
            if (fgap) { if (r >= G - fgap && r < G) continue; if (r >= G) r -= fgap; }
            if (last && r >= SEQ / 64) continue;
            e_fyct(r); if (PROBE_DBL & 2097152) e_fyct(r); }
        SEAM(b0 + 4);
        if (PHON(7) && IN(b0 + 5)) { if (!last) e_ctx_h(); if (PROBE_DBL & 16384) e_ctx_h(); e_gemm_h(); if (PROBE_DBL & 256) e_gemm_h(); }
        SEAM(b0 + 5);
        if (PHON(8) && IN(b0 + 6)) { if (!last) e_ctx_i(l); if (PROBE_DBL & 16384) e_ctx_i(l); e_gemm_i(); if (PROBE_DBL & 512) e_gemm_i(); }
        SEAM(b0 + 6);
        if (PHON(9) && IN(b0 + 7)) { e_r(l, tlim); if (PROBE_DBL & 32) e_r(l, tlim); }
        SEAM(b0 + 7);
        if (PHON(10) && IN(b0 + 8)) { e_g(tlim); if (PROBE_DBL & 64) e_g(tlim); }
        SEAM(b0 + 8);
        if (PHON(11) && IN(b0 + 9)) { e_gemm_m1(); if (PROBE_DBL & 1024) e_gemm_m1(); }
        SEAM(b0 + 9);
        if (PHON(12) && IN(b0 + 10)) { e_gemm_m2(); if (PROBE_DBL & 2048) e_gemm_m2(); }
        SEAM(b0 + 10);
        if (PHON(13) && IN(b0 + 11)) { e_n(l); if (l + 1 < DEPTH) { e_c5(l + 1); if (PROBE_DBL & 4096) e_c5(l + 1); } }
        SEAM(b0 + 11);
    }
#undef IN
#undef SEAM
}

#ifndef CPU_EMU
extern "C" void kernel_launch(void* const* d_in, const int* in_sizes, int n_in, void* d_out, int out_size, void* d_ws, size_t ws_size, hipStream_t stream) {
    static int grid = 0;
    if (grid == 0) {
        if (n_in != N_IN || out_size != SEQ * D || ws_size < WS_END) { fprintf(stderr, "kernel_launch: unexpected shapes (n_in %d out %d ws %zu need %zu)\n", n_in, out_size, ws_size, (size_t)WS_END); grid = -1; return; }
        int dev = 0, cus = 0, per_cu = 0;
        if (hipGetDevice(&dev) != hipSuccess || hipDeviceGetAttribute(&cus, hipDeviceAttributeMultiprocessorCount, dev) != hipSuccess) { grid = -1; return; }
        if (hipFuncSetAttribute((const void*)fwd_kernel, hipFuncAttributeMaxDynamicSharedMemorySize, LDS_BYTES) != hipSuccess) { fprintf(stderr, "kernel_launch: hipFuncSetAttribute failed\n"); grid = -1; return; }
        if (hipOccupancyMaxActiveBlocksPerMultiprocessor(&per_cu, (const void*)fwd_kernel, NTHR, LDS_BYTES) != hipSuccess || per_cu < 1) fprintf(stderr, "kernel_launch: occupancy query reports %d\n", per_cu);
        (void)hipGetLastError();
        grid = cus < 256 ? cus : 256;
    }
    if (grid < 0) return;
    if (hipMemsetAsync((char*)d_ws + WS_CTL, 0, CTL_BYTES, stream) != hipSuccess) return;
    KParams a{};
    for (int i = 0; i < N_IN; ++i) a.in[i] = (const float*)d_in[i];
    a.out = (float*)d_out; a.ws = (unsigned char*)d_ws;
#if MK_MULTI
    for (int ph = 0; ph < NPHASES; ++ph) { a.ph_lo = ph; a.ph_hi = ph + 1; hipLaunchKernelGGL(fwd_kernel, dim3(grid), dim3(NTHR), LDS_BYTES, stream, a); }
#else
    a.ph_lo = 0; a.ph_hi = NPHASES; hipLaunchKernelGGL(fwd_kernel, dim3(grid), dim3(NTHR), LDS_BYTES, stream, a);
#endif
}
#endif
```
